# Optimizing an MI355X kernel written in HIP

```python
import math
import jax, jax.numpy as jnp
from jax import lax
import numpy as np

D_MODEL = 1024
BATCH = 8
SEQ = 2048
DEPTH = 1

D_MIX = D_MODEL
DN_WIDTH = D_MIX // 2
DN_HEADS = 4
DN_HEAD_DIM = DN_WIDTH // DN_HEADS
DN_CONV = 4
DN_CHUNK = 64
CF_WIDTH = D_MIX - DN_WIDTH
CF_KERNEL = 31
IN_COLS = 4 * DN_WIDTH + 2 * DN_HEADS + 2 * CF_WIDTH
N_GROUPS = 8
EXPERTS_PER_GROUP = 8
N_EXPERTS = N_GROUPS * EXPERTS_PER_GROUP
TOP_K = 2
D_EXPERT = D_MODEL // 2
MOE_BLOCK = 128
EPS = 1e-6
N_MOD = 6

kernel_name = "hybrid_deltanet_conformer_hmoe_block"

F32 = jnp.float32


def rms_norm(x, w):
    xf = x.astype(F32)
    y = xf * lax.rsqrt(jnp.mean(xf * xf, axis=-1, keepdims=True) + EPS)
    return (y * w.astype(F32)).astype(x.dtype)


def layer_norm(x, w, b):
    xf = x.astype(F32)
    mu = jnp.mean(xf, axis=-1, keepdims=True)
    xc = xf - mu
    var = jnp.mean(xc * xc, axis=-1, keepdims=True)
    return (xc * lax.rsqrt(var + EPS) * w.astype(F32) + b.astype(F32)).astype(x.dtype)


def l2norm(x):
    return x * lax.rsqrt(jnp.sum(x * x, axis=-1, keepdims=True) + EPS)


def causal_depthwise_conv(x, w):
    K, C = w.shape
    return lax.conv_general_dilated(
        x, w[:, None, :].astype(x.dtype), window_strides=(1,), padding=[(K - 1, 0)],
        dimension_numbers=("NWC", "WIO", "NWC"), feature_group_count=C)


def gated_delta_rule(q, k, v, g, beta):
    B, S, H, dk = q.shape
    dv = v.shape[-1]
    C = DN_CHUNK
    N = S // C

    def chunks(t):
        t = jnp.moveaxis(t, 2, 1)
        return t.reshape((B, H, N, C) + t.shape[3:])

    q, k, v, g, beta = chunks(q), chunks(k), chunks(v), chunks(g), chunks(beta)
    q = q * (dk ** -0.5)
    g = jnp.cumsum(g, axis=-1)
    causal = jnp.tril(jnp.ones((C, C), dtype=bool))
    strict = jnp.tril(jnp.ones((C, C), dtype=bool), -1)
    decay = jnp.exp(jnp.where(causal, g[..., :, None] - g[..., None, :], -jnp.inf))
    k_beta = k * beta[..., None]
    a = jnp.where(strict, jnp.einsum("bhncd,bhnsd->bhncs", k_beta, k) * decay, 0.0)
    rhs = jnp.concatenate([v * beta[..., None], k_beta * jnp.exp(g)[..., None]], axis=-1)
    sol = lax.linalg.triangular_solve(a, rhs, left_side=True, lower=True, unit_diagonal=True)
    u, w = sol[..., :dv], sol[..., dv:]
    attn = jnp.einsum("bhncd,bhnsd->bhncs", q, k) * decay
    q_g = q * jnp.exp(g)[..., None]
    g_last = g[..., -1]
    k_dec = k * jnp.exp(g_last[..., None] - g)[..., None]

    def step(state, inp):
        u_c, w_c, attn_c, qg_c, kd_c, gl_c = inp
        v_new = u_c - jnp.einsum("bhcd,bhde->bhce", w_c, state)
        o = jnp.einsum("bhcd,bhde->bhce", qg_c, state) + jnp.einsum("bhcs,bhse->bhce", attn_c, v_new)
        state = state * jnp.exp(gl_c)[..., None, None] + jnp.einsum("bhcd,bhce->bhde", kd_c, v_new)
        return state, o

    xs = tuple(jnp.moveaxis(t, 2, 0) for t in (u, w, attn, q_g, k_dec, g_last))
    state0 = jnp.zeros((B, H, dk, dv), F32)
    _, o = lax.scan(step, state0, xs)
    o = jnp.moveaxis(o, 0, 2).reshape(B, H, S, dv)
    return jnp.moveaxis(o, 1, 2)


def hybrid_mixer(h, w_in, dn_conv_w, dn_a_log, dn_dt_bias, dn_norm_w,
                 cf_pw1_b, cf_dw_w, cf_dw_b, cf_ln_w, cf_ln_b, w_out):
    B, S, _ = h.shape
    proj = jnp.einsum("bsd,de->bse", h, w_in)
    qkv, z, b_logit, a_logit, cf_in = jnp.split(
        proj, [3 * DN_WIDTH, 4 * DN_WIDTH, 4 * DN_WIDTH + DN_HEADS, 4 * DN_WIDTH + 2 * DN_HEADS], axis=-1)

    qkv = jax.nn.silu(causal_depthwise_conv(qkv, dn_conv_w))
    q, k, v = jnp.split(qkv.astype(F32), 3, axis=-1)
    q = l2norm(q.reshape(B, S, DN_HEADS, DN_HEAD_DIM))
    k = l2norm(k.reshape(B, S, DN_HEADS, DN_HEAD_DIM))
    v = v.reshape(B, S, DN_HEADS, DN_HEAD_DIM)
    beta = jax.nn.sigmoid(b_logit.astype(F32))
    g = -jnp.exp(dn_a_log.astype(F32)) * jax.nn.softplus(a_logit.astype(F32) + dn_dt_bias.astype(F32))
    o = gated_delta_rule(q, k, v, g, beta)
    zg = jax.nn.silu(z.astype(F32).reshape(B, S, DN_HEADS, DN_HEAD_DIM))
    o = (rms_norm(o, dn_norm_w) * zg).reshape(B, S, DN_WIDTH).astype(h.dtype)

    cf = jax.nn.glu(cf_in + cf_pw1_b, axis=-1)
    cf = causal_depthwise_conv(cf, cf_dw_w) + cf_dw_b
    cf = jax.nn.silu(layer_norm(cf, cf_ln_w, cf_ln_b))

    mixed = jnp.concatenate([o, cf.astype(h.dtype)], axis=-1)
    return jnp.einsum("bsd,de->bse", mixed, w_out)


def hierarchical_moe(h, w_router_group, b_router_group, w_router_expert, b_router_expert,
                     w_gate, w_up, w_down):
    B, S, D = h.shape
    T = B * S
    xt = h.reshape(T, D)
    grp_prob = jax.nn.softmax(jnp.dot(xt, w_router_group).astype(F32) + b_router_group.astype(F32), axis=-1)
    grp_p, grp_idx = lax.top_k(grp_prob, 1)
    exp_logits = (jnp.dot(xt, w_router_expert).astype(F32) + b_router_expert.astype(F32))
    exp_logits = exp_logits.reshape(T, N_GROUPS, EXPERTS_PER_GROUP)
    sel = jnp.take_along_axis(exp_logits, grp_idx[:, :, None], axis=1)[:, 0]
    top_p, top_local = lax.top_k(jax.nn.softmax(sel, axis=-1), TOP_K)
    top_p = top_p / jnp.sum(top_p, axis=-1, keepdims=True)
    weights = grp_p * top_p
    expert_id = grp_idx * EXPERTS_PER_GROUP + top_local

    n_assign = T * TOP_K
    flat_e = expert_id.reshape(-1)
    flat_w = weights.reshape(-1)
    flat_tok = jnp.arange(n_assign, dtype=jnp.int32) // TOP_K
    order = jnp.argsort(flat_e)
    sorted_e = flat_e[order]
    counts = jnp.bincount(flat_e, length=N_EXPERTS)
    padded = (counts + MOE_BLOCK - 1) // MOE_BLOCK * MOE_BLOCK
    start = jnp.cumsum(counts) - counts
    pend = jnp.cumsum(padded)
    pstart = pend - padded
    dest = pstart[sorted_e] + jnp.arange(n_assign, dtype=jnp.int32) - start[sorted_e]
    n_blocks = -(-n_assign // MOE_BLOCK) + N_EXPERTS
    rows = n_blocks * MOE_BLOCK
    row_tok = jnp.zeros((rows,), jnp.int32).at[dest].set(flat_tok[order])
    row_w = jnp.zeros((rows,), F32).at[dest].set(flat_w[order])
    block_start = jnp.arange(n_blocks, dtype=jnp.int32) * MOE_BLOCK
    block_e = jnp.minimum(jnp.sum(pend[None, :] <= block_start[:, None], axis=1), N_EXPERTS - 1)

    def run_block(args):
        tok, e = args
        xb = xt[tok]
        hid = jax.nn.silu(jnp.dot(xb, w_gate[e])) * jnp.dot(xb, w_up[e])
        return jnp.dot(hid, w_down[e])

    y = lax.map(run_block, (row_tok.reshape(n_blocks, MOE_BLOCK), block_e))
    y = y.reshape(rows, D) * row_w[:, None].astype(y.dtype)
    out = jnp.zeros((T, D), y.dtype).at[row_tok].add(y)
    return out.reshape(B, S, D)


def setup_inputs(seed: int = 0) -> dict:
    key = jax.random.key(seed)
    ks = jax.random.split(key, 32)
    L, D = DEPTH, D_MODEL
    nrm = lambda k, shape, s: jax.random.normal(k, shape, F32) * s
    gain = lambda k, shape: 1.0 + 0.02 * jax.random.normal(k, shape, F32)
    dt = jnp.exp(jax.random.uniform(ks[7], (L, DN_HEADS), F32) * (math.log(0.1) - math.log(1e-3)) + math.log(1e-3))
    return {
        "x": nrm(ks[0], (BATCH, SEQ, D), 1.0),
        "c": nrm(ks[1], (BATCH, D), 1.0),
        "w_ada": nrm(ks[2], (L, D, N_MOD * D), 0.5 * D ** -0.5),
        "b_ada": nrm(ks[3], (L, N_MOD * D), 0.02),
        "norm_pre_mix": gain(ks[4], (L, D)),
        "norm_post_mix": gain(ks[5], (L, D)),
        "w_in": nrm(ks[6], (L, D, IN_COLS), D ** -0.5),
        "dn_conv_w": nrm(ks[8], (L, DN_CONV, 3 * DN_WIDTH), DN_CONV ** -0.5),
        "dn_a_log": jnp.log(jax.random.uniform(ks[9], (L, DN_HEADS), F32, 1.0, 16.0)),
        "dn_dt_bias": dt + jnp.log(-jnp.expm1(-dt)),
        "dn_norm_w": gain(ks[10], (L, DN_HEAD_DIM)),
        "cf_pw1_b": nrm(ks[11], (L, 2 * CF_WIDTH), 0.02),
        "cf_dw_w": nrm(ks[12], (L, CF_KERNEL, CF_WIDTH), CF_KERNEL ** -0.5),
        "cf_dw_b": nrm(ks[13], (L, CF_WIDTH), 0.02),
        "cf_ln_w": gain(ks[14], (L, CF_WIDTH)),
        "cf_ln_b": nrm(ks[15], (L, CF_WIDTH), 0.02),
        "w_out": nrm(ks[16], (L, D_MIX, D), D_MIX ** -0.5),
        "norm_pre_ffn": gain(ks[17], (L, D)),
        "norm_post_ffn": gain(ks[18], (L, D)),
        "w_router_group": nrm(ks[19], (L, D, N_GROUPS), D ** -0.5),
        "b_router_group": nrm(ks[20], (L, N_GROUPS), 0.01),
        "w_router_expert": nrm(ks[21], (L, D, N_EXPERTS), D ** -0.5),
        "b_router_expert": nrm(ks[22], (L, N_EXPERTS), 0.01),
        "w_gate": nrm(ks[23], (L, N_EXPERTS, D, D_EXPERT), D ** -0.5),
        "w_up": nrm(ks[24], (L, N_EXPERTS, D, D_EXPERT), D ** -0.5),
        "w_down": nrm(ks[25], (L, N_EXPERTS, D_EXPERT, D), D_EXPERT ** -0.5),
    }


def reference(x, c, w_ada, b_ada, norm_pre_mix, norm_post_mix, w_in, dn_conv_w, dn_a_log, dn_dt_bias,
              dn_norm_w, cf_pw1_b, cf_dw_w, cf_dw_b, cf_ln_w, cf_ln_b, w_out, norm_pre_ffn, norm_post_ffn,
              w_router_group, b_router_group, w_router_expert, b_router_expert, w_gate, w_up, w_down):
    c_act = jax.nn.silu(c)
    for l in range(DEPTH):
        mod = jnp.einsum("bd,de->be", c_act, w_ada[l]) + b_ada[l]
        shift1, scale1, gate1, shift2, scale2, gate2 = jnp.split(mod[:, None, :], N_MOD, axis=-1)
        h = rms_norm(x, norm_pre_mix[l]) * (1.0 + scale1) + shift1
        h = hybrid_mixer(h, w_in[l], dn_conv_w[l], dn_a_log[l], dn_dt_bias[l], dn_norm_w[l],
                         cf_pw1_b[l], cf_dw_w[l], cf_dw_b[l], cf_ln_w[l], cf_ln_b[l], w_out[l])
        x = x + gate1 * rms_norm(h, norm_post_mix[l])
        h = rms_norm(x, norm_pre_ffn[l]) * (1.0 + scale2) + shift2
        h = hierarchical_moe(h, w_router_group[l], b_router_group[l], w_router_expert[l], b_router_expert[l],
                             w_gate[l], w_up[l], w_down[l])
        x = x + gate2 * rms_norm(h, norm_post_ffn[l])
    return x
```

```cpp
#include <hip/hip_runtime.h>
#include <cstdio>
#include <cstdint>

#define LAS __attribute__((address_space(3)))
typedef unsigned short bf16;
typedef float f32x4 __attribute__((ext_vector_type(4)));

constexpr int NB_ = 8, NS_ = 2048, D_ = 1024, T_ = NB_ * NS_;
constexpr int DNW = 512, NH = 4, HD = 128;
constexpr int CFW = 512, CFK = 31;
constexpr int INC = 3080;
constexpr int PJ = 3072;
constexpr int NE = 64, DE = 512;
constexpr int NTHR = 512;
constexpr float EPS = 1e-6f;
constexpr int TM = 256;
constexpr int MAXROWS = 2 * T_ + NE * TM;

constexpr size_t MiB = 1u << 20;
constexpr size_t WS_CTL = 0;
constexpr size_t WS_MOD = 1 * MiB;
constexpr size_t WS_SMALL = 1 * MiB + 512 * 1024;
constexpr size_t WS_ROUTE = 2 * MiB;
constexpr size_t WS_POS = 2 * MiB + 512 * 1024;
constexpr size_t WS_TOKL = 3 * MiB;
constexpr size_t WS_WL = 7 * MiB;
constexpr size_t WS_BETA = 11 * MiB;
constexpr size_t WS_G = 12 * MiB;
constexpr size_t WS_WINT = 16 * MiB;
constexpr size_t WS_WOUTT = 22 * MiB;
constexpr size_t WS_WGUT = 24 * MiB;
constexpr size_t WS_WDNT = 152 * MiB;
constexpr size_t WS_H = 216 * MiB;
constexpr size_t WS_PROJ = 248 * MiB;
constexpr size_t WS_HMIX = 248 * MiB;
constexpr size_t WS_HID = 248 * MiB;
constexpr size_t WS_DW = 344 * MiB;
constexpr size_t WS_DQG = 360 * MiB;
constexpr size_t WS_DKDT = 376 * MiB;
constexpr size_t WS_DATT = 392 * MiB;
constexpr size_t WS_DU = 400 * MiB;
constexpr size_t WS_DEGL = 432 * MiB;
constexpr size_t WS_Y = 344 * MiB;
constexpr size_t WS_ORAW = 440 * MiB;
constexpr size_t WS_MIXED = 472 * MiB;
constexpr size_t WS_END = 504 * MiB;
constexpr int CW_CNT = 1024;

__device__ __forceinline__ unsigned f2bf(float f) { unsigned u = __builtin_bit_cast(unsigned, f); return (u + 0x7fffu + ((u >> 16) & 1u)) >> 16; }
__device__ __forceinline__ float bf2f(unsigned b) { return __builtin_bit_cast(float, b << 16); }
__device__ __forceinline__ float wave_sum(float v) {
#pragma unroll
    for (int o = 1; o < 64; o <<= 1) v += __shfl_xor(v, o);
    return v;
}
__device__ __forceinline__ float sigmoidf_(float x) { return 1.f / (1.f + __expf(-x)); }
__device__ __forceinline__ float siluf_(float x) { return x / (1.f + __expf(-x)); }

__device__ __forceinline__ int opaque_tid() { int t = threadIdx.x; asm volatile("" : "+v"(t)); return t; }

struct Params {
    const float* in[26];
    float* out;
    unsigned char* ws;
};


namespace pg8 {
#define PG8_LAS __attribute__((address_space(3)))
typedef unsigned short bf16_t;
typedef short bf16x8 __attribute__((ext_vector_type(8)));
typedef float f32x4 __attribute__((ext_vector_type(4)));
typedef unsigned u32x4 __attribute__((ext_vector_type(4)));
typedef unsigned u32x2 __attribute__((ext_vector_type(2)));
constexpr int BM = 256, BK = 64, HALF = 128, HTB = HALF * BK * 2, STAGE_BYTES = 8 * HTB, NXCD = 8, WGM = 8;
__host__ __device__ __forceinline__ int lds_byte(int r, int c) { const int st = (r >> 4) * 2 + (c >> 5), rr = r & 15, cc = c & 31, ob = rr * 64 + cc * 2; return st * 1024 + (ob ^ (((ob >> 9) & 1) << 5)); }
__host__ __device__ __forceinline__ void stage_rc(int b, int& R, int& C) { const int st = b / 1024, sb = b % 1024, swz = sb ^ (((sb >> 9) & 1) << 5); R = (st >> 1) * 16 + swz / 64; C = (st & 1) * 32 + (swz % 64) / 2; }
__host__ __device__ __forceinline__ int perm32(int rho) { const int n = rho >> 4, i = rho & 15; return 8 * (i >> 2) + 4 * n + (i & 3); }
struct Unit { int pm, pn, e, r0; };
__device__ __forceinline__ unsigned cvt_pk_bf16(float lo, float hi) { unsigned r; asm volatile("v_cvt_pk_bf16_f32 %0, %1, %2" : "=v"(r) : "v"(lo), "v"(hi)); return r; }

struct DenseSched {
    const char* A; const char* Bt; int K; int nM, nN, nwg, G, c;
    __device__ void init(const void* A_, const void* Bt_, int M, int N, int K_, int G_, int c_) { A = (const char*)A_; Bt = (const char*)Bt_; K = K_; nM = M / BM; nN = N / BM; nwg = nM * nN; G = G_; c = c_; }
    __device__ bool next(int i, Unit& u) const {
        const long L = (long)i * G + c; if (L >= nwg) return false;
        int wgid = (int)L; { const int q = nwg / NXCD, r = nwg % NXCD, xcd = wgid % NXCD, off = wgid / NXCD; wgid = (xcd < r ? xcd * (q + 1) : r * (q + 1) + (xcd - r) * q) + off; }
        const int nig = WGM * nN, gid = wgid / nig, fm = gid * WGM, gsz = (nM - fm) < WGM ? (nM - fm) : WGM;
        u.pm = fm + ((wgid % nig) % gsz); u.pn = (wgid % nig) / gsz; u.e = 0; u.r0 = 0; return true;
    }
    __device__ __forceinline__ const char* a_base() const { return A; }
    __device__ __forceinline__ const char* b_ptr(const Unit& u) const { return Bt + (size_t)u.pn * BM * K * 2; }
    __device__ __forceinline__ void a_off(const Unit& u, const int (&R)[2], const int (&C)[2], unsigned (&v)[2][2]) const {
#pragma unroll
        for (int h = 0; h < 2; ++h)
#pragma unroll
            for (int i = 0; i < 2; ++i) v[h][i] = (unsigned)(((u.pm * BM + h * HALF + R[i]) * K + C[i]) * 2);
    }
};

struct EpiBf16 {
    static constexpr bool PERM = true;
    bf16_t* O; int ldc;
    __device__ __forceinline__ void operator()(const f32x4 (&acc)[2][2][4][2], const Unit& u, int wr, int wc, int fr, int fq) const {
        const int row0 = u.pm * BM + wr * 64 + fr, col0 = u.pn * BM + wc * 32 + 8 * fq;
#pragma unroll
        for (int ai = 0; ai < 2; ++ai)
#pragma unroll
            for (int m = 0; m < 4; ++m) { bf16_t* rowp = O + (size_t)(row0 + ai * HALF + m * 16) * ldc + col0;
#pragma unroll
                for (int bj = 0; bj < 2; ++bj) { const f32x4 v0 = acc[ai][bj][m][0], v1 = acc[ai][bj][m][1];
                    u32x4 w; w.x = cvt_pk_bf16(v0[0], v0[1]); w.y = cvt_pk_bf16(v0[2], v0[3]); w.z = cvt_pk_bf16(v1[0], v1[1]); w.w = cvt_pk_bf16(v1[2], v1[3]);
                    *(u32x4*)(rowp + bj * HALF) = w; } }
    }
};
struct EpiF32 {
    static constexpr bool PERM = false;
    float* C; int ldc;
    __device__ __forceinline__ void operator()(const f32x4 (&acc)[2][2][4][2], const Unit& u, int wr, int wc, int fr, int fq) const {
        const int row0 = u.pm * BM + wr * 64 + fr, col0 = u.pn * BM + wc * 32 + 4 * fq;
#pragma unroll
        for (int ai = 0; ai < 2; ++ai)
#pragma unroll
            for (int m = 0; m < 4; ++m) { float* rowp = C + (size_t)(row0 + ai * HALF + m * 16) * ldc + col0;
#pragma unroll
                for (int bj = 0; bj < 2; ++bj)
#pragma unroll
                    for (int n = 0; n < 2; ++n) *(f32x4*)(rowp + bj * HALF + n * 16) = acc[ai][bj][m][n]; }
    }
};

struct GroupSched {
    const char* A; const char* Bt; int K; int nN; size_t bstride; LAS int* tstart; LAS int* cnt; int total; int G, c; const int* tokl;
    __device__ __forceinline__ bool next(int i, Unit& u) const {
        const int L = i * G + c; if (L >= total * nN) return false;
        const int tile = L / nN; u.pn = L % nN; int e = 0; while (e < NE - 1 && tstart[e + 1] <= tile) ++e;
        u.e = e; u.pm = tile; u.r0 = (tile - tstart[e]) * BM; return true;
    }
    __device__ __forceinline__ const char* a_base() const { return A; }
    __device__ __forceinline__ const char* b_ptr(const Unit& u) const { return Bt + (size_t)u.e * bstride + (size_t)u.pn * BM * K * 2; }
    __device__ __forceinline__ void a_off(const Unit& u, const int (&R)[2], const int (&C)[2], unsigned (&v)[2][2]) const {
        const int ce = cnt[u.e];
#pragma unroll
        for (int h = 0; h < 2; ++h)
#pragma unroll
            for (int i = 0; i < 2; ++i) {
                const int r = u.r0 + h * HALF + R[i];
                int grow = u.pm * BM + h * HALF + R[i];
                if (tokl) grow = (r < ce) ? tokl[(size_t)u.e * T_ + r] : 0;
                v[h][i] = (unsigned)((grow * K + C[i]) * 2);
            }
    }
};
struct EpiGU {
    static constexpr bool PERM = false;
    bf16_t* HID;
    __device__ __forceinline__ void operator()(const f32x4 (&acc)[2][2][4][2], const Unit& u, int wr, int wc, int fr, int fq) const {
        const int row0 = u.pm * BM + wr * 64 + fr;
#pragma unroll
        for (int ai = 0; ai < 2; ++ai)
#pragma unroll
            for (int m = 0; m < 4; ++m) { bf16_t* rowp = HID + (size_t)(row0 + ai * HALF + m * 16) * DE;
#pragma unroll
                for (int bj = 0; bj < 2; ++bj) { const f32x4 g = acc[ai][bj][m][0], up = acc[ai][bj][m][1];
                    float h[4];
#pragma unroll
                    for (int i = 0; i < 4; ++i) h[i] = g[i] / (1.f + __expf(-g[i])) * up[i];
                    u32x2 w; w.x = cvt_pk_bf16(h[0], h[1]); w.y = cvt_pk_bf16(h[2], h[3]);
                    *(u32x2*)(rowp + 16 * (u.pn * 8 + 4 * bj + wc) + 4 * fq) = w; } }
    }
};
struct EpiDown {
    static constexpr bool PERM = true;
    bf16_t* Y; const float* wl; LAS int* cnt;
    __device__ __forceinline__ void operator()(const f32x4 (&acc)[2][2][4][2], const Unit& u, int wr, int wc, int fr, int fq) const {
        const int rloc = wr * 64 + fr, col0 = u.pn * BM + wc * 32 + 8 * fq, ce = cnt[u.e];
#pragma unroll
        for (int ai = 0; ai < 2; ++ai)
#pragma unroll
            for (int m = 0; m < 4; ++m) { const int r = u.r0 + rloc + ai * HALF + m * 16;
                if (r < ce) {
                    const float w = wl[(size_t)u.e * T_ + r];
                    bf16_t* rowp = Y + (size_t)(u.pm * BM + rloc + ai * HALF + m * 16) * D_ + col0;
#pragma unroll
                    for (int bj = 0; bj < 2; ++bj) { const f32x4 v0 = acc[ai][bj][m][0] * w, v1 = acc[ai][bj][m][1] * w;
                        u32x4 o; o.x = cvt_pk_bf16(v0[0], v0[1]); o.y = cvt_pk_bf16(v0[2], v0[3]); o.z = cvt_pk_bf16(v1[0], v1[1]); o.w = cvt_pk_bf16(v1[2], v1[3]);
                        *(u32x4*)(rowp + bj * HALF) = o; } } }
    }
};

template <class Epi, class Sched>
__device__ __forceinline__ void gemm_phase(PG8_LAS unsigned char* lds, const Sched& S, const Epi& E) {
    int tid_ = threadIdx.x; asm volatile("" : "+v"(tid_));
    const int tid = tid_, wid = __builtin_amdgcn_readfirstlane(tid >> 6), lane = tid & 63, wr = wid >> 2, wc = wid & 3, fr = lane & 15, fq = lane >> 4;
    const int K = S.K, nt = K / BK;
    int sR[2], sC[2]; unsigned voffB[2];
#pragma unroll
    for (int i = 0; i < 2; ++i) { int R, C; stage_rc(tid * 16 + i * 8192, R, C); sR[i] = R; sC[i] = C; const int Rb = Epi::PERM ? ((R & ~31) + perm32(R & 31)) : R; voffB[i] = (unsigned)(Rb * K + C) * 2u; }
    const size_t kstep = (size_t)(BK * 2);
    const size_t hstep = (size_t)HALF * K * 2;
    const unsigned ldsw = (unsigned)wid * 1024u;
    const int aoff = lds_byte(wr * 64 + fr, fq * 8), boff = lds_byte(wc * 32 + fr, fq * 8);
#define PG8_SA(b, h) (((b) * 2 + (h)) * HTB)
#define PG8_SB(b, h) ((4 + (b) * 2 + (h)) * HTB)
#define PG8_STAGE(bufoff, gbase, voff) do { _Pragma("unroll") for (int _i = 0; _i < 2; ++_i) \
        __builtin_amdgcn_global_load_lds((const unsigned*)((const char*)(gbase) + (voff)[_i]), (PG8_LAS unsigned*)(lds + (bufoff) + ldsw + _i * 8192), 16, 0, 0); } while (0)
#define PG8_LDA(dst, b, h) do { _Pragma("unroll") for (int m = 0; m < 4; ++m) _Pragma("unroll") for (int k = 0; k < 2; ++k) dst[m][k] = *(const PG8_LAS bf16x8*)(lds + PG8_SA(b, h) + aoff + m * 2048 + k * 1024); } while (0)
#define PG8_LDB(dst, b, h) do { _Pragma("unroll") for (int n = 0; n < 2; ++n) _Pragma("unroll") for (int k = 0; k < 2; ++k) dst[n][k] = *(const PG8_LAS bf16x8*)(lds + PG8_SB(b, h) + boff + n * 2048 + k * 1024); } while (0)
#define PG8_MMA(ai, bj, At, Bt) do { __builtin_amdgcn_s_setprio(1); _Pragma("unroll") for (int m = 0; m < 4; ++m) _Pragma("unroll") for (int n = 0; n < 2; ++n) _Pragma("unroll") for (int k = 0; k < 2; ++k) \
        acc[ai][bj][m][n] = __builtin_amdgcn_mfma_f32_16x16x32_bf16(Bt[n][k], At[m][k], acc[ai][bj][m][n], 0, 0, 0); __builtin_amdgcn_s_setprio(0); } while (0)
#define PG8_WAIT_V(n) asm volatile("s_waitcnt vmcnt(" #n ")" ::: "memory")
#define PG8_WAIT_L(n) asm volatile("s_waitcnt lgkmcnt(" #n ")" ::: "memory")
#define PG8_BAR __builtin_amdgcn_s_barrier()
#define PG8_SCHED __builtin_amdgcn_sched_barrier(0)
    Unit cur, nxt; int ui = 0;
    if (!S.next(0, cur)) return;
    f32x4 acc[2][2][4][2];
#pragma unroll
    for (int a = 0; a < 2; ++a)
#pragma unroll
        for (int b = 0; b < 2; ++b)
#pragma unroll
            for (int m = 0; m < 4; ++m)
#pragma unroll
                for (int n = 0; n < 2; ++n) acc[a][b][m][n] = (f32x4){0.f, 0.f, 0.f, 0.f};
    bf16x8 At[4][2], B0[2][2], B1[2][2];
    const char* const gA = S.a_base();
    unsigned vC[2][2];
    S.a_off(cur, sR, sC, vC);
    const char* cB = S.b_ptr(cur);
    PG8_STAGE(PG8_SB(0, 0), cB, voffB); PG8_STAGE(PG8_SB(0, 1), cB + hstep, voffB); PG8_STAGE(PG8_SA(0, 0), gA, vC[0]); PG8_STAGE(PG8_SA(0, 1), gA, vC[1]);
    if (wr == 1) PG8_BAR;
    PG8_WAIT_V(2); PG8_BAR;
    PG8_STAGE(PG8_SB(1, 0), cB + kstep, voffB); PG8_STAGE(PG8_SA(1, 0), gA + kstep, vC[0]); PG8_STAGE(PG8_SB(1, 1), cB + hstep + kstep, voffB);
    PG8_WAIT_V(6); PG8_BAR;
    for (;;) {
        const bool has_next = S.next(ui + 1, nxt);
        const char* nB = has_next ? S.b_ptr(nxt) : cB;
        for (int t = 0; t < nt; t += 2) {
            const bool last = (t == nt - 2);
            const char* a1 = gA + (size_t)(t + 1) * kstep;
            const char* a2 = last ? gA : gA + (size_t)(t + 2) * kstep; const char* b2 = last ? nB : cB + (size_t)(t + 2) * kstep;
            const char* a3 = a2 + kstep; const char* b3 = b2 + kstep;
            PG8_LDB(B0, 0, 0); PG8_LDB(B1, 0, 1); PG8_SCHED; PG8_LDA(At, 0, 0); PG8_STAGE(PG8_SA(1, 1), a1, vC[1]);
            PG8_WAIT_V(8); PG8_WAIT_L(0); PG8_BAR; PG8_MMA(0, 0, At, B0); PG8_MMA(0, 1, At, B1); PG8_BAR; PG8_SCHED;
            if (last && has_next) S.a_off(nxt, sR, sC, vC);
            PG8_LDA(At, 0, 1); PG8_STAGE(PG8_SB(0, 0), b2, voffB); PG8_STAGE(PG8_SB(0, 1), b2 + hstep, voffB); PG8_STAGE(PG8_SA(0, 0), a2, vC[0]);
            PG8_WAIT_V(8); PG8_WAIT_L(0); PG8_BAR; PG8_MMA(1, 0, At, B0); PG8_MMA(1, 1, At, B1); PG8_BAR; PG8_SCHED;
            PG8_LDB(B0, 1, 0); PG8_LDB(B1, 1, 1); PG8_SCHED; PG8_LDA(At, 1, 0); PG8_STAGE(PG8_SA(0, 1), a2, vC[1]);
            PG8_WAIT_V(8); PG8_WAIT_L(0); PG8_BAR; PG8_MMA(0, 0, At, B0); PG8_MMA(0, 1, At, B1); PG8_BAR; PG8_SCHED;
            PG8_LDA(At, 1, 1); PG8_STAGE(PG8_SB(1, 0), b3, voffB); PG8_STAGE(PG8_SB(1, 1), b3 + hstep, voffB); PG8_STAGE(PG8_SA(1, 0), a3, vC[0]);
            PG8_WAIT_V(8); PG8_WAIT_L(0); PG8_BAR; PG8_MMA(1, 0, At, B0); PG8_MMA(1, 1, At, B1); PG8_BAR; PG8_SCHED;
        }
        if (wr == 0) PG8_BAR;
        E(acc, cur, wr, wc, fr, fq);
        if (!has_next) break;
#pragma unroll
        for (int a = 0; a < 2; ++a)
#pragma unroll
            for (int b = 0; b < 2; ++b)
#pragma unroll
                for (int m = 0; m < 4; ++m)
#pragma unroll
                    for (int n = 0; n < 2; ++n) acc[a][b][m][n] = (f32x4){0.f, 0.f, 0.f, 0.f};
        cur = nxt; cB = nB; ++ui;
        if (wr == 1) PG8_BAR;
    }
    PG8_WAIT_V(0);
    PG8_BAR;
#undef PG8_SA
#undef PG8_SB
#undef PG8_STAGE
#undef PG8_LDA
#undef PG8_LDB
#undef PG8_MMA
#undef PG8_WAIT_V
#undef PG8_WAIT_L
#undef PG8_BAR
#undef PG8_SCHED
}
}

template <class CM>
__device__ __forceinline__ void transpose_item(const float* W, int ldw, int K, bf16* WT, LAS float* scr, int k0, int n0, int lane, const CM& cmap) {
    const float* src = W + cmap(n0 + 4 * (lane & 7));
    f32x4 v[8];
#pragma unroll
    for (int i = 0; i < 8; ++i) v[i] = *(const f32x4*)(src + (size_t)(k0 + (lane >> 3) + 8 * i) * ldw);
#pragma unroll
    for (int i = 0; i < 8; ++i) { LAS float* d = scr + ((lane >> 3) + 8 * i) * 33 + 4 * (lane & 7); d[0] = v[i][0]; d[1] = v[i][1]; d[2] = v[i][2]; d[3] = v[i][3]; }
    asm volatile("s_waitcnt lgkmcnt(0)" ::: "memory");
    const int c = lane & 7;
#pragma unroll
    for (int j = 0; j < 4; ++j) { const int n = (lane >> 3) + 8 * j; const LAS float* s = scr + (8 * c) * 33 + n;
        uint4 o; o.x = f2bf(s[0 * 33]) | (f2bf(s[1 * 33]) << 16); o.y = f2bf(s[2 * 33]) | (f2bf(s[3 * 33]) << 16); o.z = f2bf(s[4 * 33]) | (f2bf(s[5 * 33]) << 16); o.w = f2bf(s[6 * 33]) | (f2bf(s[7 * 33]) << 16);
        *(uint4*)(WT + (size_t)(n0 + n) * K + k0 + 8 * c) = o; }
    asm volatile("s_waitcnt lgkmcnt(0)" ::: "memory");
}
__device__ void ph_wprep(const Params& p, LAS float* lds, int bid, int nb) {
    const int tid = opaque_tid(), lane = tid & 63, wave = tid >> 6;
    LAS float* scr = lds + wave * 4096;
    bf16* WINT = (bf16*)(p.ws + WS_WINT); bf16* WOUTT = (bf16*)(p.ws + WS_WOUTT);
    bf16* WGUT = (bf16*)(p.ws + WS_WGUT); bf16* WDNT = (bf16*)(p.ws + WS_WDNT);
    constexpr int I_IN = (D_ / 64) * (PJ / 32), I_OUT = (D_ / 64) * (D_ / 32), I_GU = (D_ / 64) * (2 * DE / 32), I_DN = (DE / 64) * (D_ / 32);
    constexpr int I_TOT = I_IN + I_OUT + NE * (I_GU + I_DN);
    for (int it = bid * 8 + wave; it < I_TOT; it += nb * 8) {
        if (it < I_IN) { const int kb = it / (PJ / 32), nbk = it % (PJ / 32); transpose_item(p.in[6], INC, D_, WINT, scr, 64 * kb, 32 * nbk, lane, [](int n) { return n < 2048 ? n : n + 8; }); }
        else if (it < I_IN + I_OUT) { const int r = it - I_IN, kb = r / (D_ / 32), nbk = r % (D_ / 32); transpose_item(p.in[16], D_, D_, WOUTT, scr, 64 * kb, 32 * nbk, lane, [](int n) { return n; }); }
        else {
            int r = it - I_IN - I_OUT; const int e = r / (I_GU + I_DN); r -= e * (I_GU + I_DN);
            if (r < I_GU) { const int kb = r / (2 * DE / 32), nbk = r % (2 * DE / 32);
                const float* wg = p.in[23] + (size_t)e * D_ * DE; const long up_off = (long)(p.in[24] - p.in[23]);
                transpose_item(wg, DE, D_, WGUT + (size_t)e * 2 * DE * D_, scr, 64 * kb, 32 * nbk, lane, [up_off](int n) -> long { const int g = n >> 5, w = n & 31; return w < 16 ? (long)(16 * g + w) : up_off + (long)(16 * g + w - 16); }); }
            else { r -= I_GU; const int kb = r / (D_ / 32), nbk = r % (D_ / 32);
                transpose_item(p.in[25] + (size_t)e * DE * D_, D_, DE, WDNT + (size_t)e * D_ * DE, scr, 64 * kb, 32 * nbk, lane, [](int n) { return n; }); }
        }
    }
}

__device__ void ph_mod(const Params& p, LAS float* lds, int bid, int nb) {
    const int tid = opaque_tid();
    const float* c = p.in[1]; const float* w_ada = p.in[2]; const float* b_ada = p.in[3];
    float* mod = (float*)(p.ws + WS_MOD);
    LAS float* cact = lds;
    LAS float* part = lds + 8192;
    for (int i = tid; i < 8192; i += NTHR) cact[i] = siluf_(c[i]);
    __syncthreads();
    for (int cg = bid; cg < 256; cg += nb) {
        const int n0 = cg * 24;
        const int kq = tid / 6, cq = tid % 6;
        float acc[8][4];
#pragma unroll
        for (int b = 0; b < 8; ++b) { acc[b][0] = acc[b][1] = acc[b][2] = acc[b][3] = 0.f; }
        if (kq < 85) {
            for (int k = kq; k < 1024; k += 85) {
                const float4 w = *(const float4*)(w_ada + (size_t)k * 6144 + n0 + 4 * cq);
#pragma unroll
                for (int b = 0; b < 8; ++b) { const float a = cact[b * 1024 + k]; acc[b][0] += a * w.x; acc[b][1] += a * w.y; acc[b][2] += a * w.z; acc[b][3] += a * w.w; }
            }
#pragma unroll
            for (int b = 0; b < 8; ++b)
#pragma unroll
                for (int j = 0; j < 4; ++j) part[(kq * 8 + b) * 24 + 4 * cq + j] = acc[b][j];
        }
        __syncthreads();
        if (tid < 192) {
            const int b = tid / 24, j = tid % 24; float s = 0.f;
            for (int q = 0; q < 85; ++q) s += part[(q * 8 + b) * 24 + j];
            mod[b * 6144 + n0 + j] = s + b_ada[n0 + j];
        }
        __syncthreads();
    }
}

__device__ void ph_h(const Params& p, int bid, int nb) {
    const int tid = opaque_tid(), lane = tid & 63, wave = tid >> 6;
    const float* x = p.in[0]; const float* npm = p.in[4]; const float* w_in = p.in[6];
    const float* mod = (const float*)(p.ws + WS_MOD);
    bf16* H = (bf16*)(p.ws + WS_H); float* SM = (float*)(p.ws + WS_SMALL);
    for (int t = bid * 8 + wave; t < T_; t += nb * 8) {
        const int b = t / NS_;
        const float* xr = x + (size_t)t * D_;
        float4 v[4]; float ss = 0.f;
#pragma unroll
        for (int j = 0; j < 4; ++j) { v[j] = *(const float4*)(xr + 4 * lane + 256 * j); ss += v[j].x * v[j].x + v[j].y * v[j].y + v[j].z * v[j].z + v[j].w * v[j].w; }
        ss = wave_sum(ss);
        const float rstd = rsqrtf(ss * (1.f / D_) + EPS);
        float sm[8];
#pragma unroll
        for (int j = 0; j < 8; ++j) sm[j] = 0.f;
#pragma unroll
        for (int j = 0; j < 4; ++j) {
            const int c0 = 4 * lane + 256 * j;
            const float4 nw = *(const float4*)(npm + c0);
            const float4 sh = *(const float4*)(mod + b * 6144 + c0);
            const float4 sc = *(const float4*)(mod + b * 6144 + 1024 + c0);
            float h[4];
            h[0] = v[j].x * rstd * nw.x * (1.f + sc.x) + sh.x;
            h[1] = v[j].y * rstd * nw.y * (1.f + sc.y) + sh.y;
            h[2] = v[j].z * rstd * nw.z * (1.f + sc.z) + sh.z;
            h[3] = v[j].w * rstd * nw.w * (1.f + sc.w) + sh.w;
            uint2 o; o.x = f2bf(h[0]) | (f2bf(h[1]) << 16); o.y = f2bf(h[2]) | (f2bf(h[3]) << 16);
            *(uint2*)(H + (size_t)t * D_ + c0) = o;
#pragma unroll
            for (int i = 0; i < 4; ++i) {
                const float4 wa = *(const float4*)(w_in + (size_t)(c0 + i) * INC + 2048);
                const float4 wb = *(const float4*)(w_in + (size_t)(c0 + i) * INC + 2052);
                sm[0] += h[i] * wa.x; sm[1] += h[i] * wa.y; sm[2] += h[i] * wa.z; sm[3] += h[i] * wa.w;
                sm[4] += h[i] * wb.x; sm[5] += h[i] * wb.y; sm[6] += h[i] * wb.z; sm[7] += h[i] * wb.w;
            }
        }
#pragma unroll
        for (int j = 0; j < 8; ++j) sm[j] = wave_sum(sm[j]);
        if (lane == 0) { *(float4*)(SM + (size_t)t * 8) = make_float4(sm[0], sm[1], sm[2], sm[3]); *(float4*)(SM + (size_t)t * 8 + 4) = make_float4(sm[4], sm[5], sm[6], sm[7]); }
    }
}

template <class AF, class BF, class EF>
__device__ __forceinline__ void sgemm_tile(LAS float* lds, int K, const AF& af, const BF& bf, const EF& ef) {
    LAS float* As = lds; LAS float* Bs = lds + 16 * 132;
    const int tid = opaque_tid(), ty = tid >> 4, tx = tid & 15;
    float acc[4][4];
#pragma unroll
    for (int i = 0; i < 4; ++i)
#pragma unroll
        for (int j = 0; j < 4; ++j) acc[i][j] = 0.f;
    const int arow = tid >> 2, akq = tid & 3;
    const bf16* ap = af(arow);
    for (int k0 = 0; k0 < K; k0 += 16) {
        float a4[4] = {0.f, 0.f, 0.f, 0.f};
        if (ap) { const uint2 v = *(const uint2*)(ap + k0 + 4 * akq); a4[0] = bf2f(v.x & 0xffffu); a4[1] = bf2f(v.x >> 16); a4[2] = bf2f(v.y & 0xffffu); a4[3] = bf2f(v.y >> 16); }
        float4 b4 = make_float4(0.f, 0.f, 0.f, 0.f);
        if (tid < 256) b4 = *(const float4*)bf(k0 + (tid >> 4), 4 * (tid & 15));
        __syncthreads();
#pragma unroll
        for (int i = 0; i < 4; ++i) As[(4 * akq + i) * 132 + arow] = a4[i];
        if (tid < 256) { LAS float* bp = Bs + (tid >> 4) * 64 + 4 * (tid & 15); bp[0] = b4.x; bp[1] = b4.y; bp[2] = b4.z; bp[3] = b4.w; }
        __syncthreads();
#pragma unroll
        for (int kk = 0; kk < 16; ++kk) {
            float a[4], b[4];
#pragma unroll
            for (int i = 0; i < 4; ++i) { a[i] = As[kk * 132 + ty * 4 + i]; b[i] = Bs[kk * 64 + tx * 4 + i]; }
#pragma unroll
            for (int i = 0; i < 4; ++i)
#pragma unroll
                for (int j = 0; j < 4; ++j) acc[i][j] += a[i] * b[j];
        }
    }
    __syncthreads();
#pragma unroll
    for (int i = 0; i < 4; ++i) { f32x4 v = {acc[i][0], acc[i][1], acc[i][2], acc[i][3]}; ef(ty * 4 + i, tx * 4, v); }
}

__device__ __forceinline__ void ph_proj(const Params& p, LAS unsigned char* lds, int bid, int nb) {
    pg8::DenseSched S; S.init(p.ws + WS_H, p.ws + WS_WINT, T_, PJ, D_, nb, bid);
    pg8::EpiBf16 E{(bf16*)(p.ws + WS_PROJ), PJ};
    pg8::gemm_phase(lds, S, E);
}

typedef short bf16x8_t __attribute__((ext_vector_type(8)));
typedef unsigned u32x4_t __attribute__((ext_vector_type(4)));
typedef unsigned u32x2_t __attribute__((ext_vector_type(2)));
__device__ __forceinline__ int lds_off16(int row, int ch) { return row * 256 + ((ch ^ (row & 15)) << 4); }
__device__ __forceinline__ int lds_off8(int row, int ch) { return row * 128 + ((ch ^ ((row >> 1) & 7)) << 4); }
__device__ __forceinline__ unsigned pk2bf(float lo, float hi) { return f2bf(lo) | (f2bf(hi) << 16); }
__device__ __forceinline__ bf16x8_t ldfrag(const LAS unsigned char* p) { return *(const LAS bf16x8_t*)p; }

__device__ void ph_dnprep(const Params& p, LAS unsigned char* lds, int bid, int nb) {
    int tid_ = threadIdx.x; asm volatile("" : "+v"(tid_));
    const int tid = tid_, lane = tid & 63, wave = tid >> 6, fr = lane & 15, fq = lane >> 4;
    const bf16* PROJ = (const bf16*)(p.ws + WS_PROJ); const float* cw = p.in[7]; const float* a_log = p.in[8]; const float* dt_bias = p.in[9];
    const float* SM = (const float*)(p.ws + WS_SMALL);
    bf16* DW = (bf16*)(p.ws + WS_DW); bf16* DQG = (bf16*)(p.ws + WS_DQG); bf16* DKDT = (bf16*)(p.ws + WS_DKDT); bf16* DATT = (bf16*)(p.ws + WS_DATT);
    float* DU = (float*)(p.ws + WS_DU); float* DEGL = (float*)(p.ws + WS_DEGL);
    constexpr int O_KN = 0, O_QS = 16384, O_KD = 32768, O_AM = 50176, O_RHS = 66560, O_GC = 132096;
    LAS float* AM = (LAS float*)(lds + O_AM); LAS float* RHS = (LAS float*)(lds + O_RHS); LAS float* GC = (LAS float*)(lds + O_GC);
    LAS unsigned short* KD = (LAS unsigned short*)(lds + O_KD);
    const float qscale = 0.08838834764831845f;
    for (int item = bid; item < 1024; item += nb) {
        const int b = item >> 7, h = (item >> 5) & 3, n = item & 31, t0 = b * NS_ + n * 64, tl0 = n * 64;
        if (wave == 0) {
            const int t = t0 + lane;
            const float bl = SM[(size_t)t * 8 + h], al = SM[(size_t)t * 8 + 4 + h];
            const float beta = sigmoidf_(bl);
            const float xx = al + dt_bias[h];
            const float sp = xx > 20.f ? xx : log1pf(expf(xx));
            float gc = -expf(a_log[h]) * sp;
#pragma unroll
            for (int o = 1; o < 64; o <<= 1) { const float y = __shfl_up(gc, o); if (lane >= o) gc += y; }
            const float glast = __shfl(gc, 63);
            GC[lane] = gc; GC[64 + lane] = beta; GC[128 + lane] = expf(gc); GC[192 + lane] = expf(glast - gc);
            if (lane == 63) DEGL[item] = expf(gc);
        }
        __syncthreads();
        {
            const int r = tid >> 3, seg = tid & 7;
            const float beta = GC[64 + r], egc = GC[128 + r], edec = GC[192 + r];
            float v3[3][16];
#pragma unroll
            for (int part = 0; part < 3; ++part) {
                const int ch = part * 512 + h * 128 + seg * 16;
#pragma unroll
                for (int i = 0; i < 16; ++i) v3[part][i] = 0.f;
#pragma unroll
                for (int j = 0; j < 4; ++j) {
                    if (tl0 + r - 3 + j >= 0) {
                        const u32x4_t x0 = *(const u32x4_t*)(PROJ + (size_t)(t0 + r - 3 + j) * PJ + ch), x1 = *(const u32x4_t*)(PROJ + (size_t)(t0 + r - 3 + j) * PJ + ch + 8);
                        const unsigned xs[8] = {x0.x, x0.y, x0.z, x0.w, x1.x, x1.y, x1.z, x1.w};
#pragma unroll
                        for (int i = 0; i < 8; ++i) { const float2 w = *(const float2*)(cw + j * 1536 + ch + 2 * i); v3[part][2 * i] += w.x * bf2f(xs[i] & 0xffffu); v3[part][2 * i + 1] += w.y * bf2f(xs[i] >> 16); }
                    }
                }
                float ss = 0.f;
#pragma unroll
                for (int i = 0; i < 16; ++i) { v3[part][i] = siluf_(v3[part][i]); ss += v3[part][i] * v3[part][i]; }
                if (part < 2) {
                    ss += __shfl_xor(ss, 1); ss += __shfl_xor(ss, 2); ss += __shfl_xor(ss, 4);
                    const float rn = rsqrtf(ss + EPS);
#pragma unroll
                    for (int i = 0; i < 16; ++i) v3[part][i] *= rn;
                }
            }
            {
                u32x4_t a0, a1, g0, g1; const float* q = v3[0]; const float s = qscale, sg = qscale * egc;
                a0.x = pk2bf(q[0] * s, q[1] * s); a0.y = pk2bf(q[2] * s, q[3] * s); a0.z = pk2bf(q[4] * s, q[5] * s); a0.w = pk2bf(q[6] * s, q[7] * s);
                a1.x = pk2bf(q[8] * s, q[9] * s); a1.y = pk2bf(q[10] * s, q[11] * s); a1.z = pk2bf(q[12] * s, q[13] * s); a1.w = pk2bf(q[14] * s, q[15] * s);
                g0.x = pk2bf(q[0] * sg, q[1] * sg); g0.y = pk2bf(q[2] * sg, q[3] * sg); g0.z = pk2bf(q[4] * sg, q[5] * sg); g0.w = pk2bf(q[6] * sg, q[7] * sg);
                g1.x = pk2bf(q[8] * sg, q[9] * sg); g1.y = pk2bf(q[10] * sg, q[11] * sg); g1.z = pk2bf(q[12] * sg, q[13] * sg); g1.w = pk2bf(q[14] * sg, q[15] * sg);
                *(LAS u32x4_t*)(lds + O_QS + lds_off16(r, 2 * seg)) = a0; *(LAS u32x4_t*)(lds + O_QS + lds_off16(r, 2 * seg + 1)) = a1;
                bf16* dst = DQG + (size_t)item * 8192 + r * 128 + seg * 16; *(u32x4_t*)dst = g0; *(u32x4_t*)(dst + 8) = g1;
            }
            {
                u32x4_t a0, a1; const float* k = v3[1];
                a0.x = pk2bf(k[0], k[1]); a0.y = pk2bf(k[2], k[3]); a0.z = pk2bf(k[4], k[5]); a0.w = pk2bf(k[6], k[7]);
                a1.x = pk2bf(k[8], k[9]); a1.y = pk2bf(k[10], k[11]); a1.z = pk2bf(k[12], k[13]); a1.w = pk2bf(k[14], k[15]);
                *(LAS u32x4_t*)(lds + O_KN + lds_off16(r, 2 * seg)) = a0; *(LAS u32x4_t*)(lds + O_KN + lds_off16(r, 2 * seg + 1)) = a1;
                u32x4_t d0, d1;
                d0.x = pk2bf(k[0] * edec, k[1] * edec); d0.y = pk2bf(k[2] * edec, k[3] * edec); d0.z = pk2bf(k[4] * edec, k[5] * edec); d0.w = pk2bf(k[6] * edec, k[7] * edec);
                d1.x = pk2bf(k[8] * edec, k[9] * edec); d1.y = pk2bf(k[10] * edec, k[11] * edec); d1.z = pk2bf(k[12] * edec, k[13] * edec); d1.w = pk2bf(k[14] * edec, k[15] * edec);
                *(LAS u32x4_t*)(KD + r * 136 + seg * 16) = d0; *(LAS u32x4_t*)(KD + r * 136 + seg * 16 + 8) = d1;
                const float bw = beta * egc;
#pragma unroll
                for (int i = 0; i < 4; ++i) *(LAS f32x4*)(RHS + r * 256 + 128 + seg * 16 + 4 * i) = (f32x4){k[4 * i] * bw, k[4 * i + 1] * bw, k[4 * i + 2] * bw, k[4 * i + 3] * bw};
            }
            {
                const float* v = v3[2];
#pragma unroll
                for (int i = 0; i < 4; ++i) *(LAS f32x4*)(RHS + r * 256 + seg * 16 + 4 * i) = (f32x4){v[4 * i] * beta, v[4 * i + 1] * beta, v[4 * i + 2] * beta, v[4 * i + 3] * beta};
            }
        }
        __syncthreads();
        {
            const int rb = wave & 3;
            bf16x8_t xf[4];
#pragma unroll
            for (int s4 = 0; s4 < 4; ++s4) xf[s4] = ldfrag(lds + O_KN + lds_off16(16 * rb + fr, 4 * s4 + fq));
#pragma unroll
            for (int cb = 0; cb < 4; ++cb) {
                f32x4 acc = {0.f, 0.f, 0.f, 0.f};
                const int yoff = (wave < 4) ? O_KN : O_QS;
#pragma unroll
                for (int s4 = 0; s4 < 4; ++s4) { const bf16x8_t yf = ldfrag(lds + yoff + lds_off16(16 * cb + fr, 4 * s4 + fq)); acc = __builtin_amdgcn_mfma_f32_16x16x32_bf16(xf[s4], yf, acc, 0, 0, 0); }
                if (wave < 4) {
                    const int j = 16 * cb + fr; const float gj = GC[j];
#pragma unroll
                    for (int r = 0; r < 4; ++r) { const int i = 16 * rb + 4 * fq + r; const bool m = i > j; const float dec = __expf(m ? GC[i] - gj : 0.f); AM[i * 64 + j] = m ? GC[64 + i] * acc[r] * dec : 0.f; }
                } else {
                    const int c = 16 * cb + fr; const float gcv = GC[c]; float o[4];
#pragma unroll
                    for (int r = 0; r < 4; ++r) { const int sidx = 16 * rb + 4 * fq + r; const bool m = c >= sidx; const float dec = __expf(m ? gcv - GC[sidx] : 0.f); o[r] = m ? acc[r] * dec : 0.f; }
                    u32x2_t w; w.x = pk2bf(o[0], o[1]); w.y = pk2bf(o[2], o[3]);
                    *(u32x2_t*)(DATT + (size_t)item * 4096 + c * 64 + 16 * rb + 4 * fq) = w;
                }
            }
        }
        __syncthreads();
        if (tid < 256) {
            const int c = tid;
            float x[64];
#pragma unroll
            for (int i = 0; i < 64; ++i) {
                float s0 = RHS[i * 256 + c], s1 = 0.f;
#pragma unroll
                for (int j4 = 0; j4 < (i + 3) / 4; ++j4) {
                    const f32x4 a = *(const LAS f32x4*)(AM + i * 64 + 4 * j4);
                    if (4 * j4 + 0 < i) s0 -= a.x * x[4 * j4 + 0];
                    if (4 * j4 + 1 < i) s1 -= a.y * x[4 * j4 + 1];
                    if (4 * j4 + 2 < i) s0 -= a.z * x[4 * j4 + 2];
                    if (4 * j4 + 3 < i) s1 -= a.w * x[4 * j4 + 3];
                }
                x[i] = s0 + s1;
            }
            if (c < 128) {
#pragma unroll
                for (int i = 0; i < 64; ++i) DU[(size_t)item * 8192 + i * 128 + c] = x[i];
            } else {
#pragma unroll
                for (int i = 0; i < 64; ++i) DW[(size_t)item * 8192 + i * 128 + (c - 128)] = (bf16)f2bf(x[i]);
            }
        } else {
            const int tt = tid - 256, d = tt >> 1, c0 = (tt & 1) * 32;
            unsigned w[16];
#pragma unroll
            for (int i = 0; i < 16; ++i) w[i] = (unsigned)KD[(c0 + 2 * i) * 136 + d] | ((unsigned)KD[(c0 + 2 * i + 1) * 136 + d] << 16);
            bf16* dst = DKDT + (size_t)item * 8192 + d * 64 + c0;
#pragma unroll
            for (int i = 0; i < 4; ++i) *(u32x4_t*)(dst + 8 * i) = (u32x4_t){w[4 * i], w[4 * i + 1], w[4 * i + 2], w[4 * i + 3]};
        }
        __syncthreads();
    }
}

__device__ void ph_dnscan(const Params& p, LAS unsigned char* lds, int sbid, int nsb) {
    int tid_ = threadIdx.x; asm volatile("" : "+v"(tid_));
    const int tid = tid_, lane = tid & 63, wave = __builtin_amdgcn_readfirstlane(tid >> 6), fr = lane & 15, fq = lane >> 4;
    const bf16* DW = (const bf16*)(p.ws + WS_DW); const bf16* DQG = (const bf16*)(p.ws + WS_DQG); const bf16* DKDT = (const bf16*)(p.ws + WS_DKDT); const bf16* DATT = (const bf16*)(p.ws + WS_DATT);
    const float* DU = (const float*)(p.ws + WS_DU); const float* DEGL = (const float*)(p.ws + WS_DEGL);
    float* ORAW = (float*)(p.ws + WS_ORAW);
    constexpr int BUF = 57344, O_W = 0, O_QG = 16384, O_KDT = 32768, O_ATT = 49152, O_SB = 114688, O_VNT = 131072;
    const int cb = wave >> 1, eb = wave & 1;
    for (int it = sbid; it < 128; it += nsb) {
        const int bh = (it & 7) * 4 + (it >> 5), es = (it >> 3) & 3, b = bh >> 2, h = bh & 3, e0 = es * 32, item0 = bh * 32;
        f32x4 st[2] = {{0.f, 0.f, 0.f, 0.f}, {0.f, 0.f, 0.f, 0.f}};
        *(LAS u32x4_t*)(lds + O_SB + tid * 16) = (u32x4_t){0u, 0u, 0u, 0u};
        u32x4_t rg[7]; float un[4]; float egl_n;
#define DN_LOAD(itm) do { const size_t _o = (size_t)(itm) * 8192; \
            rg[0] = *(const u32x4_t*)(DW + _o + (size_t)tid * 8); rg[1] = *(const u32x4_t*)(DW + _o + (size_t)(tid + 512) * 8); \
            rg[2] = *(const u32x4_t*)(DQG + _o + (size_t)tid * 8); rg[3] = *(const u32x4_t*)(DQG + _o + (size_t)(tid + 512) * 8); \
            rg[4] = *(const u32x4_t*)(DKDT + _o + (size_t)tid * 8); rg[5] = *(const u32x4_t*)(DKDT + _o + (size_t)(tid + 512) * 8); \
            rg[6] = *(const u32x4_t*)(DATT + (size_t)(itm) * 4096 + (size_t)tid * 8); \
            _Pragma("unroll") for (int _r = 0; _r < 4; ++_r) un[_r] = DU[_o + (size_t)(16 * cb + 4 * fq + _r) * 128 + e0 + 16 * eb + fr]; \
            egl_n = DEGL[(itm)]; } while (0)
#define DN_STORE(bufo) do { LAS unsigned char* _b = lds + (bufo); \
            *(LAS u32x4_t*)(_b + O_W + lds_off16(tid >> 4, tid & 15)) = rg[0]; *(LAS u32x4_t*)(_b + O_W + lds_off16((tid + 512) >> 4, tid & 15)) = rg[1]; \
            *(LAS u32x4_t*)(_b + O_QG + lds_off16(tid >> 4, tid & 15)) = rg[2]; *(LAS u32x4_t*)(_b + O_QG + lds_off16((tid + 512) >> 4, tid & 15)) = rg[3]; \
            *(LAS u32x4_t*)(_b + O_KDT + lds_off8(tid >> 3, tid & 7)) = rg[4]; *(LAS u32x4_t*)(_b + O_KDT + lds_off8((tid + 512) >> 3, tid & 7)) = rg[5]; \
            *(LAS u32x4_t*)(_b + O_ATT + lds_off8(tid >> 3, tid & 7)) = rg[6]; } while (0)
        DN_LOAD(item0);
        DN_STORE(0);
        float u[4] = {un[0], un[1], un[2], un[3]}; float egl = egl_n;
        __syncthreads();
        for (int n = 0; n < 32; ++n) {
            const int bufo = (n & 1) * BUF, sbo = O_SB + (n & 1) * 8192, sbn = O_SB + ((n + 1) & 1) * 8192;
            if (n < 31) DN_LOAD(item0 + n + 1);
            f32x4 acc = {0.f, 0.f, 0.f, 0.f};
            bf16x8_t sf[4];
#pragma unroll
            for (int s4 = 0; s4 < 4; ++s4) sf[s4] = ldfrag(lds + sbo + lds_off16(16 * eb + fr, 4 * s4 + fq));
#pragma unroll
            for (int s4 = 0; s4 < 4; ++s4) acc = __builtin_amdgcn_mfma_f32_16x16x32_bf16(ldfrag(lds + bufo + O_W + lds_off16(16 * cb + fr, 4 * s4 + fq)), sf[s4], acc, 0, 0, 0);
            {
                const float v0 = u[0] - acc[0], v1 = u[1] - acc[1], v2 = u[2] - acc[2], v3 = u[3] - acc[3];
                u32x2_t w; w.x = pk2bf(v0, v1); w.y = pk2bf(v2, v3);
                *(LAS u32x2_t*)(lds + O_VNT + lds_off8(16 * eb + fr, 2 * cb + (fq >> 1)) + 8 * (fq & 1)) = w;
            }
            __syncthreads();
            f32x4 oacc = {0.f, 0.f, 0.f, 0.f};
#pragma unroll
            for (int s4 = 0; s4 < 4; ++s4) oacc = __builtin_amdgcn_mfma_f32_16x16x32_bf16(ldfrag(lds + bufo + O_QG + lds_off16(16 * cb + fr, 4 * s4 + fq)), sf[s4], oacc, 0, 0, 0);
            bf16x8_t vf[2][2];
#pragma unroll
            for (int e2 = 0; e2 < 2; ++e2)
#pragma unroll
                for (int s2 = 0; s2 < 2; ++s2) vf[e2][s2] = ldfrag(lds + O_VNT + lds_off8(16 * e2 + fr, 4 * s2 + fq));
#pragma unroll
            for (int s2 = 0; s2 < 2; ++s2) oacc = __builtin_amdgcn_mfma_f32_16x16x32_bf16(ldfrag(lds + bufo + O_ATT + lds_off8(16 * cb + fr, 4 * s2 + fq)), ldfrag(lds + O_VNT + lds_off8(16 * eb + fr, 4 * s2 + fq)), oacc, 0, 0, 0);
            {
                const size_t t0 = (size_t)b * NS_ + n * 64;
#pragma unroll
                for (int r = 0; r < 4; ++r) ORAW[(t0 + 16 * cb + 4 * fq + r) * 512 + h * 128 + e0 + 16 * eb + fr] = oacc[r];
            }
#pragma unroll
            for (int e2 = 0; e2 < 2; ++e2) {
                st[e2] = st[e2] * egl;
#pragma unroll
                for (int s2 = 0; s2 < 2; ++s2) st[e2] = __builtin_amdgcn_mfma_f32_16x16x32_bf16(ldfrag(lds + bufo + O_KDT + lds_off8(16 * wave + fr, 4 * s2 + fq)), vf[e2][s2], st[e2], 0, 0, 0);
                u32x2_t w; w.x = pk2bf(st[e2][0], st[e2][1]); w.y = pk2bf(st[e2][2], st[e2][3]);
                *(LAS u32x2_t*)(lds + sbn + lds_off16(16 * e2 + fr, 2 * wave + (fq >> 1)) + 8 * (fq & 1)) = w;
            }
            if (n < 31) { DN_STORE(((n + 1) & 1) * BUF); u[0] = un[0]; u[1] = un[1]; u[2] = un[2]; u[3] = un[3]; egl = egl_n; }
            __syncthreads();
        }
#undef DN_LOAD
#undef DN_STORE
    }
}

__device__ void ph_mixed(const Params& p, int bid, int nb) {
    const int tid = opaque_tid(), lane = tid & 63, wave = tid >> 6;
    const float* ORAW = (const float*)(p.ws + WS_ORAW); const bf16* PROJ = (const bf16*)(p.ws + WS_PROJ); const float* nw = p.in[10];
    bf16* MIXED = (bf16*)(p.ws + WS_MIXED);
    for (int t = bid * 8 + wave; t < T_; t += nb * 8) {
#pragma unroll
        for (int hh = 0; hh < 4; ++hh) {
            const float2 o = *(const float2*)(ORAW + (size_t)t * 512 + hh * 128 + 2 * lane);
            const float ss = wave_sum(o.x * o.x + o.y * o.y);
            const float r = rsqrtf(ss * (1.f / 128.f) + EPS);
            const unsigned zz = *(const unsigned*)(PROJ + (size_t)t * PJ + 1536 + hh * 128 + 2 * lane);
            const float m0 = o.x * r * nw[2 * lane] * siluf_(bf2f(zz & 0xffffu)), m1 = o.y * r * nw[2 * lane + 1] * siluf_(bf2f(zz >> 16));
            *(unsigned*)(MIXED + (size_t)t * D_ + hh * 128 + 2 * lane) = f2bf(m0) | (f2bf(m1) << 16);
        }
    }
}

__device__ void ph_cf(const Params& p, LAS float* lds, int bid, int nb) {
    const int tid = opaque_tid(), lane = tid & 63, wave = tid >> 6;
    const bf16* PROJ = (const bf16*)(p.ws + WS_PROJ);
    const float* pwb = p.in[11]; const float* dww = p.in[12]; const float* dwb = p.in[13]; const float* lnw = p.in[14]; const float* lnb = p.in[15];
    bf16* MIXED = (bf16*)(p.ws + WS_MIXED);
    constexpr int TT = 32;
    const int c = tid;
    float w[CFK];
#pragma unroll
    for (int j = 0; j < CFK; ++j) w[j] = dww[j * CFW + c];
    const float ba = pwb[c], bg = pwb[512 + c], cb = dwb[c];
    for (int it = bid; it < T_ / TT; it += nb) {
        const int t0 = it * TT, tl0 = t0 % NS_;
        float xg[TT + CFK - 1];
#pragma unroll
        for (int i = 0; i < TT + CFK - 1; ++i) {
            const int tl = tl0 - (CFK - 1) + i;
            float g = 0.f;
            if (tl >= 0) {
                const size_t row = (size_t)(t0 - (CFK - 1) + i);
                const float a = bf2f(PROJ[row * PJ + 2048 + c]) + ba, gt = bf2f(PROJ[row * PJ + 2560 + c]) + bg;
                g = a * sigmoidf_(gt);
            }
            xg[i] = g;
        }
        __syncthreads();
#pragma unroll
        for (int r = 0; r < TT; ++r) {
            float s = cb;
#pragma unroll
            for (int j = 0; j < CFK; ++j) s += w[j] * xg[r + j];
            lds[r * 512 + c] = s;
        }
        __syncthreads();
#pragma unroll
        for (int rr = 0; rr < 4; ++rr) {
            const int r = wave * 4 + rr;
            float v[8]; float s = 0.f;
#pragma unroll
            for (int j = 0; j < 8; ++j) { v[j] = lds[r * 512 + lane + 64 * j]; s += v[j]; }
            const float mu = wave_sum(s) * (1.f / 512.f);
            float q = 0.f;
#pragma unroll
            for (int j = 0; j < 8; ++j) { v[j] -= mu; q += v[j] * v[j]; }
            const float rstd = rsqrtf(wave_sum(q) * (1.f / 512.f) + EPS);
#pragma unroll
            for (int j = 0; j < 8; ++j) { const int cc = lane + 64 * j; const float y = v[j] * rstd * lnw[cc] + lnb[cc]; MIXED[(size_t)(t0 + r) * D_ + 512 + cc] = (bf16)f2bf(siluf_(y)); }
        }
    }
}

__device__ __forceinline__ void ph_outproj(const Params& p, LAS unsigned char* lds, int bid, int nb) {
    pg8::DenseSched S; S.init(p.ws + WS_MIXED, p.ws + WS_WOUTT, T_, D_, D_, nb, bid);
    pg8::EpiF32 E{(float*)(p.ws + WS_HMIX), D_};
    pg8::gemm_phase(lds, S, E);
}

__device__ void ph_row2(const Params& p, int bid, int nb) {
    const int tid = opaque_tid(), lane = tid & 63, wave = tid >> 6;
    const float* x = p.in[0]; const float* npost = p.in[5]; const float* npre = p.in[17];
    const float* wrg = p.in[19]; const float* brg = p.in[20]; const float* wre = p.in[21]; const float* bre = p.in[22];
    const float* mod = (const float*)(p.ws + WS_MOD); const float* HMIX = (const float*)(p.ws + WS_HMIX);
    bf16* H2 = (bf16*)(p.ws + WS_H);
    int* ROUTE = (int*)(p.ws + WS_ROUTE); int* POS = (int*)(p.ws + WS_POS); int* TOKL = (int*)(p.ws + WS_TOKL); float* WL = (float*)(p.ws + WS_WL);
    unsigned* cnt = (unsigned*)(p.ws + WS_CTL) + CW_CNT;
    for (int t = bid * 8 + wave; t < T_; t += nb * 8) {
        const int b = t / NS_;
        float hm[16], xv[16];
        float ss = 0.f;
#pragma unroll
        for (int j = 0; j < 4; ++j) {
            const float4 a = *(const float4*)(HMIX + (size_t)t * D_ + 4 * lane + 256 * j);
            const float4 xx = *(const float4*)(x + (size_t)t * D_ + 4 * lane + 256 * j);
            hm[4 * j] = a.x; hm[4 * j + 1] = a.y; hm[4 * j + 2] = a.z; hm[4 * j + 3] = a.w;
            xv[4 * j] = xx.x; xv[4 * j + 1] = xx.y; xv[4 * j + 2] = xx.z; xv[4 * j + 3] = xx.w;
            ss += a.x * a.x + a.y * a.y + a.z * a.z + a.w * a.w;
        }
        ss = wave_sum(ss);
        const float r1 = rsqrtf(ss * (1.f / D_) + EPS);
        float s2 = 0.f;
#pragma unroll
        for (int j = 0; j < 4; ++j)
#pragma unroll
            for (int i = 0; i < 4; ++i) {
                const int c = 4 * lane + 256 * j + i;
                const float x1 = xv[4 * j + i] + mod[b * 6144 + 2048 + c] * (hm[4 * j + i] * r1 * npost[c]);
                xv[4 * j + i] = x1; s2 += x1 * x1;
            }
        s2 = wave_sum(s2);
        const float r2 = rsqrtf(s2 * (1.f / D_) + EPS);
        float h2[16];
#pragma unroll
        for (int j = 0; j < 4; ++j) {
            const int c0 = 4 * lane + 256 * j;
            *(float4*)(p.out + (size_t)t * D_ + c0) = make_float4(xv[4 * j], xv[4 * j + 1], xv[4 * j + 2], xv[4 * j + 3]);
#pragma unroll
            for (int i = 0; i < 4; ++i) { const int c = c0 + i; h2[4 * j + i] = xv[4 * j + i] * r2 * npre[c] * (1.f + mod[b * 6144 + 4096 + c]) + mod[b * 6144 + 3072 + c]; }
            uint2 o; o.x = f2bf(h2[4 * j]) | (f2bf(h2[4 * j + 1]) << 16); o.y = f2bf(h2[4 * j + 2]) | (f2bf(h2[4 * j + 3]) << 16);
            *(uint2*)(H2 + (size_t)t * D_ + c0) = o;
        }
        float gl[8];
#pragma unroll
        for (int o = 0; o < 8; ++o) gl[o] = 0.f;
#pragma unroll
        for (int j = 0; j < 4; ++j)
#pragma unroll
            for (int i = 0; i < 4; ++i) {
                const int c = 4 * lane + 256 * j + i;
                const float4 wa = *(const float4*)(wrg + (size_t)c * 8), wb = *(const float4*)(wrg + (size_t)c * 8 + 4);
                const float hv = h2[4 * j + i];
                gl[0] += hv * wa.x; gl[1] += hv * wa.y; gl[2] += hv * wa.z; gl[3] += hv * wa.w; gl[4] += hv * wb.x; gl[5] += hv * wb.y; gl[6] += hv * wb.z; gl[7] += hv * wb.w;
            }
        float gmax = -3.0e38f; int gi = 0;
#pragma unroll
        for (int o = 0; o < 8; ++o) { gl[o] = wave_sum(gl[o]) + brg[o]; if (gl[o] > gmax) { gmax = gl[o]; gi = o; } }
        float gden = 0.f;
#pragma unroll
        for (int o = 0; o < 8; ++o) gden += __expf(gl[o] - gmax);
        const float gp = 1.f / gden;
        float el[8];
#pragma unroll
        for (int o = 0; o < 8; ++o) el[o] = 0.f;
#pragma unroll
        for (int j = 0; j < 4; ++j)
#pragma unroll
            for (int i = 0; i < 4; ++i) {
                const int c = 4 * lane + 256 * j + i;
                const float4 wa = *(const float4*)(wre + (size_t)c * 64 + gi * 8), wb = *(const float4*)(wre + (size_t)c * 64 + gi * 8 + 4);
                const float hv = h2[4 * j + i];
                el[0] += hv * wa.x; el[1] += hv * wa.y; el[2] += hv * wa.z; el[3] += hv * wa.w; el[4] += hv * wb.x; el[5] += hv * wb.y; el[6] += hv * wb.z; el[7] += hv * wb.w;
            }
        float m1 = -3.0e38f, m2 = -3.0e38f; int i1 = 0, i2 = 0;
#pragma unroll
        for (int o = 0; o < 8; ++o) el[o] = wave_sum(el[o]) + bre[gi * 8 + o];
#pragma unroll
        for (int o = 0; o < 8; ++o) { if (el[o] > m1) { m1 = el[o]; i1 = o; } }
#pragma unroll
        for (int o = 0; o < 8; ++o) { if (o != i1 && el[o] > m2) { m2 = el[o]; i2 = o; } }
        const float e2 = __expf(m2 - m1);
        const float w1 = gp * (1.f / (1.f + e2)), w2 = gp * (e2 / (1.f + e2));
        if (lane == 0) {
            const int ea = gi * 8 + i1, eb = gi * 8 + i2;
            const unsigned pa = atomicAdd(cnt + ea, 1u), pb = atomicAdd(cnt + eb, 1u);
            ROUTE[(size_t)t * 4 + 0] = ea; ROUTE[(size_t)t * 4 + 1] = eb;
            POS[(size_t)t * 2 + 0] = (int)pa; POS[(size_t)t * 2 + 1] = (int)pb;
            TOKL[(size_t)ea * T_ + pa] = t; TOKL[(size_t)eb * T_ + pb] = t;
            WL[(size_t)ea * T_ + pa] = w1; WL[(size_t)eb * T_ + pb] = w2;
        }
    }
}

struct MoeMap { LAS int* tstart; LAS int* cnt; int total_tiles; };
__device__ __forceinline__ MoeMap moe_map(const Params& p, LAS int* l) {
    const unsigned* cnt = (const unsigned*)(p.ws + WS_CTL) + CW_CNT;
    __syncthreads();
    if (threadIdx.x == 0) { int s = 0; for (int e = 0; e < NE; ++e) { const int c = (int)__hip_atomic_load(cnt + e, __ATOMIC_RELAXED, __HIP_MEMORY_SCOPE_AGENT); l[e] = s; l[128 + e] = c; s += (c + TM - 1) / TM; } l[NE] = s; }
    __syncthreads();
    MoeMap m; m.tstart = l; m.cnt = l + 128; m.total_tiles = l[NE];
    return m;
}
__device__ __forceinline__ int moe_find(const MoeMap& m, int tile) { int e = 0; while (e < NE - 1 && m.tstart[e + 1] <= tile) ++e; return e; }

__device__ __forceinline__ void ph_moe_gu(const Params& p, LAS unsigned char* lds, int bid, int nb) {
    MoeMap mm = moe_map(p, (LAS int*)(lds + pg8::STAGE_BYTES));
    pg8::GroupSched S{(const char*)(p.ws + WS_H), (const char*)(p.ws + WS_WGUT), D_, 4, (size_t)2 * DE * D_ * 2, mm.tstart, mm.cnt, mm.total_tiles, nb, bid, (const int*)(p.ws + WS_TOKL)};
    pg8::EpiGU E{(bf16*)(p.ws + WS_HID)};
    pg8::gemm_phase(lds, S, E);
}
__device__ __forceinline__ void ph_moe_down(const Params& p, LAS unsigned char* lds, int bid, int nb) {
    MoeMap mm = moe_map(p, (LAS int*)(lds + pg8::STAGE_BYTES));
    pg8::GroupSched S{(const char*)(p.ws + WS_HID), (const char*)(p.ws + WS_WDNT), DE, 4, (size_t)D_ * DE * 2, mm.tstart, mm.cnt, mm.total_tiles, nb, bid, nullptr};
    pg8::EpiDown E{(bf16*)(p.ws + WS_Y), (const float*)(p.ws + WS_WL), mm.cnt};
    pg8::gemm_phase(lds, S, E);
}

__device__ void ph_final(const Params& p, LAS float* lds, int bid, int nb) {
    const int tid = opaque_tid(), lane = tid & 63, wave = tid >> 6;
    const float* npf = p.in[18]; const float* mod = (const float*)(p.ws + WS_MOD);
    const bf16* Y = (const bf16*)(p.ws + WS_Y); const int* ROUTE = (const int*)(p.ws + WS_ROUTE); const int* POS = (const int*)(p.ws + WS_POS);
    MoeMap mm = moe_map(p, (LAS int*)lds);
    for (int t = bid * 8 + wave; t < T_; t += nb * 8) {
        const int b = t / NS_;
        const int ea = ROUTE[(size_t)t * 4], eb = ROUTE[(size_t)t * 4 + 1];
        const size_t ga = (size_t)mm.tstart[ea] * TM + POS[(size_t)t * 2], gb = (size_t)mm.tstart[eb] * TM + POS[(size_t)t * 2 + 1];
        float m[16]; float ss = 0.f;
#pragma unroll
        for (int j = 0; j < 4; ++j) {
            const uint2 a = *(const uint2*)(Y + ga * D_ + 4 * lane + 256 * j), bb = *(const uint2*)(Y + gb * D_ + 4 * lane + 256 * j);
            m[4 * j] = bf2f(a.x & 0xffffu) + bf2f(bb.x & 0xffffu); m[4 * j + 1] = bf2f(a.x >> 16) + bf2f(bb.x >> 16);
            m[4 * j + 2] = bf2f(a.y & 0xffffu) + bf2f(bb.y & 0xffffu); m[4 * j + 3] = bf2f(a.y >> 16) + bf2f(bb.y >> 16);
#pragma unroll
            for (int i = 0; i < 4; ++i) ss += m[4 * j + i] * m[4 * j + i];
        }
        ss = wave_sum(ss);
        const float r = rsqrtf(ss * (1.f / D_) + EPS);
#pragma unroll
        for (int j = 0; j < 4; ++j) {
            const int c0 = 4 * lane + 256 * j;
            float4 o = *(float4*)(p.out + (size_t)t * D_ + c0);
            o.x += mod[b * 6144 + 5120 + c0] * (m[4 * j] * r * npf[c0]);
            o.y += mod[b * 6144 + 5120 + c0 + 1] * (m[4 * j + 1] * r * npf[c0 + 1]);
            o.z += mod[b * 6144 + 5120 + c0 + 2] * (m[4 * j + 2] * r * npf[c0 + 2]);
            o.w += mod[b * 6144 + 5120 + c0 + 3] * (m[4 * j + 3] * r * npf[c0 + 3]);
            *(float4*)(p.out + (size_t)t * D_ + c0) = o;
        }
    }
}

constexpr int LDS_BYTES = 147456;
#define XB_TMO      128
#define XB_XCNT(j)  (256  + 64 * (j))
#define XB_XSUB(j)  (1280 + 64 * (j))
#define XB_XGEN(j)  (2304 + 64 * (j))
#define XB_TOP      3328
#define XB_TOPGEN   3392
#define XCD_BAR_WORDS 3456
#define XB_SPIN_CAP (1u << 22)
__device__ __forceinline__ unsigned xb_ld(unsigned* p)              { return __hip_atomic_load(p, __ATOMIC_RELAXED, __HIP_MEMORY_SCOPE_AGENT); }
__device__ __forceinline__ unsigned xb_add(unsigned* p, unsigned v) { return __hip_atomic_fetch_add(p, v, __ATOMIC_RELAXED, __HIP_MEMORY_SCOPE_AGENT); }
__device__ __forceinline__ unsigned xb_xcc_id() { return (unsigned)__builtin_amdgcn_s_getreg((3 << 11) | 20) & 0xFu; }
#define XB_SPIN(cond, bar) do { unsigned _sp = 0; while (cond) { __builtin_amdgcn_s_sleep(1); \
    if ((++_sp & 255u) == 0u) { if (xb_ld(&(bar)[XB_TMO])) break; if (_sp > XB_SPIN_CAP) { atomicAdd(&(bar)[XB_TMO], 1u); break; } } } } while (0)
struct XcdBarrier { unsigned* bar; unsigned x; volatile LAS unsigned* st; };
__device__ __forceinline__ XcdBarrier xcd_barrier_post(unsigned* bar, volatile LAS unsigned* st) {
    XcdBarrier b; b.bar = bar; b.x = xb_xcc_id(); b.st = st;
    if (threadIdx.x == 0) (void)xb_add(&bar[XB_XCNT(b.x)], 1u);
    return b;
}
__device__ __forceinline__ void xcd_barrier_complete(unsigned* bar, unsigned x, unsigned& nloc, unsigned& nx) {
    const unsigned G = gridDim.x * gridDim.y * gridDim.z;
    unsigned sum, cnt, mine, sp = 0u;
    for (;;) {
        sum = 0u; cnt = 0u; mine = 0u;
#pragma unroll
        for (unsigned j = 0; j < 16; ++j) { const unsigned c = xb_ld(&bar[XB_XCNT(j)]); sum += c; cnt += (c > 0u) ? 1u : 0u; mine = (j == x) ? c : mine; }
        if (sum == G) break;
        __builtin_amdgcn_s_sleep(1);
        if ((++sp & 255u) == 0u) { if (xb_ld(&bar[XB_TMO])) break; if (sp > XB_SPIN_CAP) { atomicAdd(&bar[XB_TMO], 1u); break; } }
    }
    nloc = mine > 0u ? mine : 1u; nx = cnt > 0u ? cnt : 1u;
}
__device__ __forceinline__ void xcd_barrier(unsigned char* ws, volatile LAS unsigned* st) {
    XcdBarrier b; b.bar = (unsigned*)(ws + WS_CTL) + 4096; b.x = xb_xcc_id(); b.st = st;
    asm volatile("s_waitcnt vmcnt(0)" ::: "memory");
    __syncthreads();
    if (threadIdx.x == 0) {
        unsigned* bar = b.bar;
        __builtin_amdgcn_s_waitcnt(0);
        unsigned nloc = b.st[0], nx = b.st[1];
        if (nloc == 0u) { xcd_barrier_complete(bar, b.x, nloc, nx); b.st[0] = nloc; b.st[1] = nx; }
        const unsigned old = xb_add(&bar[XB_XSUB(b.x)], 1u);
        const unsigned gen = old / nloc;
        if (old + 1u == (gen + 1u) * nloc) {
            __builtin_amdgcn_fence(__ATOMIC_RELEASE, "agent");
            asm volatile("s_waitcnt vmcnt(0)" ::: "memory");
            const unsigned og = xb_add(&bar[XB_TOP], 1u);
            const unsigned tg = og / nx;
            if (og + 1u == (tg + 1u) * nx) xb_add(&bar[XB_TOPGEN], 1u);
            else XB_SPIN(xb_ld(&bar[XB_TOPGEN]) == tg, bar);
            __builtin_amdgcn_fence(__ATOMIC_ACQUIRE, "agent");
            xb_add(&bar[XB_XGEN(b.x)], 1u);
            asm volatile("s_waitcnt vmcnt(0)" ::: "memory");
        } else {
            XB_SPIN(xb_ld(&bar[XB_XGEN(b.x)]) == gen, bar);
            __builtin_amdgcn_fence(__ATOMIC_ACQUIRE, "agent");
            asm volatile("s_waitcnt vmcnt(0)" ::: "memory");
        }
    }
    __syncthreads();
}
constexpr int CW_BAR = 4096;
constexpr int LDS_ST_OFF = LDS_BYTES - 64;

__global__ void __launch_bounds__(NTHR, 2) mk_all(Params p) {
    extern __shared__ __attribute__((aligned(16))) unsigned char lds_raw[];
    LAS float* lds = (LAS float*)lds_raw;
    const int bid = blockIdx.x, nb = gridDim.x;
    volatile LAS unsigned* st = (volatile LAS unsigned*)((LAS unsigned char*)lds_raw + LDS_ST_OFF);
    if (threadIdx.x < 16) st[threadIdx.x] = 0u;
    __syncthreads();
    (void)xcd_barrier_post((unsigned*)(p.ws + WS_CTL) + CW_BAR, st);
    ph_wprep(p, lds, bid, nb); __syncthreads();
    ph_mod(p, lds, bid, nb);            xcd_barrier(p.ws, st);
    ph_h(p, bid, nb);                   xcd_barrier(p.ws, st);
    ph_proj(p, (LAS unsigned char*)lds_raw, bid, nb);           xcd_barrier(p.ws, st);
    ph_dnprep(p, (LAS unsigned char*)lds_raw, bid, nb);    xcd_barrier(p.ws, st);
    if (bid < nb / 2) ph_dnscan(p, (LAS unsigned char*)lds_raw, bid, nb / 2); else ph_cf(p, lds, bid - nb / 2, nb - nb / 2);
    xcd_barrier(p.ws, st);
    ph_mixed(p, bid, nb);               xcd_barrier(p.ws, st);
    ph_outproj(p, (LAS unsigned char*)lds_raw, bid, nb);        xcd_barrier(p.ws, st);
    ph_row2(p, bid, nb);                xcd_barrier(p.ws, st);
    ph_moe_gu(p, (LAS unsigned char*)lds_raw, bid, nb);      xcd_barrier(p.ws, st);
    ph_moe_down(p, (LAS unsigned char*)lds_raw, bid, nb);    xcd_barrier(p.ws, st);
    ph_final(p, lds, bid, nb);
}

extern "C" void kernel_launch(void* const* d_in, const int* in_sizes, int n_in, void* d_out, int out_size, void* d_ws, size_t ws_size, hipStream_t stream) {
    static int inited = 0;
    if (!inited) {
        if (n_in != 26 || out_size != T_ * D_ || ws_size < WS_END) { fprintf(stderr, "kernel_launch: unexpected shapes n_in %d out %d ws %zu\n", n_in, out_size, ws_size); inited = -1; return; }
        if (hipFuncSetAttribute((const void*)mk_all, hipFuncAttributeMaxDynamicSharedMemorySize, LDS_BYTES) != hipSuccess) { fprintf(stderr, "hipFuncSetAttribute failed\n"); inited = -1; return; }
        inited = 1;
    }
    if (inited < 0) return;
    (void)hipMemsetAsync((char*)d_ws + WS_CTL, 0, 1 * MiB, stream);
    Params p{};
    for (int i = 0; i < 26; ++i) p.in[i] = (const float*)d_in[i];
    p.out = (float*)d_out; p.ws = (unsigned char*)d_ws;
    hipLaunchKernelGGL(mk_all, dim3(256), dim3(NTHR), LDS_BYTES, stream, p);
}
```

```cpp
#include <hip/hip_runtime.h>
#include <cstdio>
#include <cstdint>

#define LAS __attribute__((address_space(3)))
typedef unsigned short bf16;
typedef float f32x4 __attribute__((ext_vector_type(4)));

constexpr int NB_ = 8, NS_ = 2048, D_ = 1024, T_ = NB_ * NS_;
constexpr int DNW = 512, NH = 4, HD = 128;
constexpr int CFW = 512, CFK = 31;
constexpr int INC = 3080;
constexpr int PJ = 3072;
constexpr int NE = 64, DE = 512;
constexpr int NTHR = 512;
constexpr float EPS = 1e-6f;
constexpr int TM = 256;
constexpr int MAXROWS = 2 * T_ + NE * TM;

constexpr size_t MiB = 1u << 20;
constexpr size_t WS_CTL = 0;
constexpr size_t WS_MOD = 1 * MiB;
constexpr size_t WS_SMALL = 1 * MiB + 512 * 1024;
constexpr size_t WS_ROUTE = 2 * MiB;
constexpr size_t WS_POS = 2 * MiB + 512 * 1024;
constexpr size_t WS_TOKL = 3 * MiB;
constexpr size_t WS_WL = 7 * MiB;
constexpr size_t WS_W8T = 11 * MiB;
constexpr size_t WS_WRET = 12 * MiB;
constexpr size_t WS_WINT = 16 * MiB;
constexpr size_t WS_WOUTT = 22 * MiB;
constexpr size_t WS_WGUT = 24 * MiB;
constexpr size_t WS_WDNT = 152 * MiB;
constexpr size_t WS_H = 216 * MiB;
constexpr size_t WS_PROJ = 248 * MiB;
constexpr size_t WS_HMIX = 248 * MiB;
constexpr size_t WS_HID = 248 * MiB;
constexpr size_t WS_DW = 344 * MiB;
constexpr size_t WS_DQG = 360 * MiB;
constexpr size_t WS_DKDT = 376 * MiB;
constexpr size_t WS_DATT = 392 * MiB;
constexpr size_t WS_DU = 400 * MiB;
constexpr size_t WS_DEGL = 432 * MiB;
constexpr size_t WS_Y = 344 * MiB;
constexpr size_t WS_ORAW = 440 * MiB;
constexpr size_t WS_MIXED = 472 * MiB;
constexpr size_t WS_END = 504 * MiB;
constexpr int CW_CNT = 1024;

__device__ __forceinline__ unsigned f2bf(float f) { unsigned u = __builtin_bit_cast(unsigned, f); return (u + 0x7fffu + ((u >> 16) & 1u)) >> 16; }
__device__ __forceinline__ float bf2f(unsigned b) { return __builtin_bit_cast(float, b << 16); }
template <int CTRL, int ROWMASK> __device__ __forceinline__ float dpp_f(float v) {
    return __builtin_bit_cast(float, __builtin_amdgcn_update_dpp(0, __builtin_bit_cast(int, v), CTRL, ROWMASK, 0xF, true));
}
__device__ __forceinline__ float wave_sum(float v) {
    v += dpp_f<0xB1, 0xF>(v);
    v += dpp_f<0x4E, 0xF>(v);
    v += dpp_f<0x141, 0xF>(v);
    v += dpp_f<0x140, 0xF>(v);
    v += dpp_f<0x142, 0xA>(v);
    v += dpp_f<0x143, 0xC>(v);
    return __builtin_bit_cast(float, __builtin_amdgcn_readlane(__builtin_bit_cast(int, v), 63));
}
__device__ __forceinline__ float sigmoidf_(float x) { return 1.f / (1.f + __expf(-x)); }
__device__ __forceinline__ float siluf_(float x) { return x / (1.f + __expf(-x)); }

__device__ __forceinline__ int opaque_tid() { int t = threadIdx.x; asm volatile("" : "+v"(t)); return t; }

struct Params {
    const float* in[26];
    float* out;
    unsigned char* ws;
};


namespace pg8 {
#define PG8_LAS __attribute__((address_space(3)))
typedef unsigned short bf16_t;
typedef short bf16x8 __attribute__((ext_vector_type(8)));
typedef float f32x4 __attribute__((ext_vector_type(4)));
typedef unsigned u32x4 __attribute__((ext_vector_type(4)));
typedef unsigned u32x2 __attribute__((ext_vector_type(2)));
constexpr int BM = 256, BK = 64, HALF = 128, HTB = HALF * BK * 2, STAGE_BYTES = 8 * HTB, NXCD = 8, WGM = 8;
__host__ __device__ __forceinline__ int lds_byte(int r, int c) { const int st = (r >> 4) * 2 + (c >> 5), rr = r & 15, cc = c & 31, ob = rr * 64 + cc * 2; return st * 1024 + (ob ^ (((ob >> 9) & 1) << 5)); }
__host__ __device__ __forceinline__ void stage_rc(int b, int& R, int& C) { const int st = b / 1024, sb = b % 1024, swz = sb ^ (((sb >> 9) & 1) << 5); R = (st >> 1) * 16 + swz / 64; C = (st & 1) * 32 + (swz % 64) / 2; }
__host__ __device__ __forceinline__ int perm32(int rho) { const int n = rho >> 4, i = rho & 15; return 8 * (i >> 2) + 4 * n + (i & 3); }
struct Unit { int pm, pn, e, r0; };
__device__ __forceinline__ unsigned cvt_pk_bf16(float lo, float hi) { unsigned r; asm volatile("v_cvt_pk_bf16_f32 %0, %1, %2" : "=v"(r) : "v"(lo), "v"(hi)); return r; }

struct DenseSched {
    const char* A; const char* Bt; int K; int nM, nN, nwg, G, c;
    __device__ void init(const void* A_, const void* Bt_, int M, int N, int K_, int G_, int c_) { A = (const char*)A_; Bt = (const char*)Bt_; K = K_; nM = M / BM; nN = N / BM; nwg = nM * nN; G = G_; c = c_; }
    __device__ bool next(int i, Unit& u) const {
        const long L = (long)i * G + c; if (L >= nwg) return false;
        int wgid = (int)L; { const int q = nwg / NXCD, r = nwg % NXCD, xcd = wgid % NXCD, off = wgid / NXCD; wgid = (xcd < r ? xcd * (q + 1) : r * (q + 1) + (xcd - r) * q) + off; }
        const int nig = WGM * nN, gid = wgid / nig, fm = gid * WGM, gsz = (nM - fm) < WGM ? (nM - fm) : WGM;
        u.pm = fm + ((wgid % nig) % gsz); u.pn = (wgid % nig) / gsz; u.e = 0; u.r0 = 0; return true;
    }
    __device__ __forceinline__ const char* a_base() const { return A; }
    __device__ __forceinline__ const char* b_ptr(const Unit& u) const { return Bt + (size_t)u.pn * BM * K * 2; }
    __device__ __forceinline__ void a_off(const Unit& u, const int (&R)[2], const int (&C)[2], unsigned (&v)[2][2]) const {
#pragma unroll
        for (int h = 0; h < 2; ++h)
#pragma unroll
            for (int i = 0; i < 2; ++i) v[h][i] = (unsigned)(((u.pm * BM + h * HALF + R[i]) * K + C[i]) * 2);
    }
};

struct EpiBf16 {
    static constexpr bool PERM = true;
    bf16_t* O; int ldc;
    __device__ __forceinline__ void operator()(const f32x4 (&acc)[2][2][4][2], const Unit& u, int wr, int wc, int fr, int fq) const {
        const int row0 = u.pm * BM + wr * 64 + fr, col0 = u.pn * BM + wc * 32 + 8 * fq;
#pragma unroll
        for (int ai = 0; ai < 2; ++ai)
#pragma unroll
            for (int m = 0; m < 4; ++m) { bf16_t* rowp = O + (size_t)(row0 + ai * HALF + m * 16) * ldc + col0;
#pragma unroll
                for (int bj = 0; bj < 2; ++bj) { const f32x4 v0 = acc[ai][bj][m][0], v1 = acc[ai][bj][m][1];
                    u32x4 w; w.x = cvt_pk_bf16(v0[0], v0[1]); w.y = cvt_pk_bf16(v0[2], v0[3]); w.z = cvt_pk_bf16(v1[0], v1[1]); w.w = cvt_pk_bf16(v1[2], v1[3]);
                    *(u32x4*)(rowp + bj * HALF) = w; } }
    }
};
struct EpiF32 {
    static constexpr bool PERM = false;
    float* C; int ldc;
    __device__ __forceinline__ void operator()(const f32x4 (&acc)[2][2][4][2], const Unit& u, int wr, int wc, int fr, int fq) const {
        const int row0 = u.pm * BM + wr * 64 + fr, col0 = u.pn * BM + wc * 32 + 4 * fq;
#pragma unroll
        for (int ai = 0; ai < 2; ++ai)
#pragma unroll
            for (int m = 0; m < 4; ++m) { float* rowp = C + (size_t)(row0 + ai * HALF + m * 16) * ldc + col0;
#pragma unroll
                for (int bj = 0; bj < 2; ++bj)
#pragma unroll
                    for (int n = 0; n < 2; ++n) *(f32x4*)(rowp + bj * HALF + n * 16) = acc[ai][bj][m][n]; }
    }
};

struct GroupSched {
    const char* A; const char* Bt; int K; int nN; size_t bstride; LAS int* tstart; LAS int* cnt; int total; int G, c; const int* tokl;
    __device__ __forceinline__ bool next(int i, Unit& u) const {
        const int L = i * G + c; if (L >= total * nN) return false;
        const int tile = L / nN; u.pn = L % nN; int e = 0; while (e < NE - 1 && tstart[e + 1] <= tile) ++e;
        u.e = e; u.pm = tile; u.r0 = (tile - tstart[e]) * BM; return true;
    }
    __device__ __forceinline__ const char* a_base() const { return A; }
    __device__ __forceinline__ const char* b_ptr(const Unit& u) const { return Bt + (size_t)u.e * bstride + (size_t)u.pn * BM * K * 2; }
    __device__ __forceinline__ void a_off(const Unit& u, const int (&R)[2], const int (&C)[2], unsigned (&v)[2][2]) const {
        const int ce = cnt[u.e];
#pragma unroll
        for (int h = 0; h < 2; ++h)
#pragma unroll
            for (int i = 0; i < 2; ++i) {
                const int r = u.r0 + h * HALF + R[i];
                int grow = u.pm * BM + h * HALF + R[i];
                if (tokl) grow = (r < ce) ? tokl[(size_t)u.e * T_ + r] : 0;
                v[h][i] = (unsigned)((grow * K + C[i]) * 2);
            }
    }
};
struct EpiGU {
    static constexpr bool PERM = false;
    bf16_t* HID;
    __device__ __forceinline__ void operator()(const f32x4 (&acc)[2][2][4][2], const Unit& u, int wr, int wc, int fr, int fq) const {
        const int row0 = u.pm * BM + wr * 64 + fr;
#pragma unroll
        for (int ai = 0; ai < 2; ++ai)
#pragma unroll
            for (int m = 0; m < 4; ++m) { bf16_t* rowp = HID + (size_t)(row0 + ai * HALF + m * 16) * DE;
#pragma unroll
                for (int bj = 0; bj < 2; ++bj) { const f32x4 g = acc[ai][bj][m][0], up = acc[ai][bj][m][1];
                    float h[4];
#pragma unroll
                    for (int i = 0; i < 4; ++i) h[i] = g[i] / (1.f + __expf(-g[i])) * up[i];
                    u32x2 w; w.x = cvt_pk_bf16(h[0], h[1]); w.y = cvt_pk_bf16(h[2], h[3]);
                    *(u32x2*)(rowp + 16 * (u.pn * 8 + 4 * bj + wc) + 4 * fq) = w; } }
    }
};
struct EpiDown {
    static constexpr bool PERM = true;
    bf16_t* Y; const float* wl; LAS int* cnt;
    __device__ __forceinline__ void operator()(const f32x4 (&acc)[2][2][4][2], const Unit& u, int wr, int wc, int fr, int fq) const {
        const int rloc = wr * 64 + fr, col0 = u.pn * BM + wc * 32 + 8 * fq, ce = cnt[u.e];
#pragma unroll
        for (int ai = 0; ai < 2; ++ai)
#pragma unroll
            for (int m = 0; m < 4; ++m) { const int r = u.r0 + rloc + ai * HALF + m * 16;
                if (r < ce) {
                    const float w = wl[(size_t)u.e * T_ + r];
                    bf16_t* rowp = Y + (size_t)(u.pm * BM + rloc + ai * HALF + m * 16) * D_ + col0;
#pragma unroll
                    for (int bj = 0; bj < 2; ++bj) { const f32x4 v0 = acc[ai][bj][m][0] * w, v1 = acc[ai][bj][m][1] * w;
                        u32x4 o; o.x = cvt_pk_bf16(v0[0], v0[1]); o.y = cvt_pk_bf16(v0[2], v0[3]); o.z = cvt_pk_bf16(v1[0], v1[1]); o.w = cvt_pk_bf16(v1[2], v1[3]);
                        *(u32x4*)(rowp + bj * HALF) = o; } } }
    }
};

template <class Epi, class Sched>
__device__ __forceinline__ void gemm_phase(PG8_LAS unsigned char* lds, const Sched& S, const Epi& E) {
    int tid_ = threadIdx.x; asm volatile("" : "+v"(tid_));
    const int tid = tid_, wid = __builtin_amdgcn_readfirstlane(tid >> 6), lane = tid & 63, wr = wid >> 2, wc = wid & 3, fr = lane & 15, fq = lane >> 4;
    const int K = S.K, nt = K / BK;
    int sR[2], sC[2]; unsigned voffB[2];
#pragma unroll
    for (int i = 0; i < 2; ++i) { int R, C; stage_rc(tid * 16 + i * 8192, R, C); sR[i] = R; sC[i] = C; const int Rb = Epi::PERM ? ((R & ~31) + perm32(R & 31)) : R; voffB[i] = (unsigned)(Rb * K + C) * 2u; }
    const size_t kstep = (size_t)(BK * 2);
    const size_t hstep = (size_t)HALF * K * 2;
    const unsigned ldsw = (unsigned)wid * 1024u;
    const int aoff = lds_byte(wr * 64 + fr, fq * 8), boff = lds_byte(wc * 32 + fr, fq * 8);
#define PG8_SA(b, h) (((b) * 2 + (h)) * HTB)
#define PG8_SB(b, h) ((4 + (b) * 2 + (h)) * HTB)
#define PG8_STAGE(bufoff, gbase, voff) do { _Pragma("unroll") for (int _i = 0; _i < 2; ++_i) \
        __builtin_amdgcn_global_load_lds((const unsigned*)((const char*)(gbase) + (voff)[_i]), (PG8_LAS unsigned*)(lds + (bufoff) + ldsw + _i * 8192), 16, 0, 0); } while (0)
#define PG8_LDA(dst, b, h) do { _Pragma("unroll") for (int m = 0; m < 4; ++m) _Pragma("unroll") for (int k = 0; k < 2; ++k) dst[m][k] = *(const PG8_LAS bf16x8*)(lds + PG8_SA(b, h) + aoff + m * 2048 + k * 1024); } while (0)
#define PG8_LDB(dst, b, h) do { _Pragma("unroll") for (int n = 0; n < 2; ++n) _Pragma("unroll") for (int k = 0; k < 2; ++k) dst[n][k] = *(const PG8_LAS bf16x8*)(lds + PG8_SB(b, h) + boff + n * 2048 + k * 1024); } while (0)
#define PG8_MMA(ai, bj, At, Bt) do { __builtin_amdgcn_s_setprio(1); _Pragma("unroll") for (int m = 0; m < 4; ++m) _Pragma("unroll") for (int n = 0; n < 2; ++n) _Pragma("unroll") for (int k = 0; k < 2; ++k) \
        acc[ai][bj][m][n] = __builtin_amdgcn_mfma_f32_16x16x32_bf16(Bt[n][k], At[m][k], acc[ai][bj][m][n], 0, 0, 0); __builtin_amdgcn_s_setprio(0); } while (0)
#define PG8_WAIT_V(n) asm volatile("s_waitcnt vmcnt(" #n ")" ::: "memory")
#define PG8_WAIT_L(n) asm volatile("s_waitcnt lgkmcnt(" #n ")" ::: "memory")
#define PG8_BAR __builtin_amdgcn_s_barrier()
#define PG8_SCHED __builtin_amdgcn_sched_barrier(0)
    Unit cur, nxt; int ui = 0;
    if (!S.next(0, cur)) return;
    f32x4 acc[2][2][4][2];
#pragma unroll
    for (int a = 0; a < 2; ++a)
#pragma unroll
        for (int b = 0; b < 2; ++b)
#pragma unroll
            for (int m = 0; m < 4; ++m)
#pragma unroll
                for (int n = 0; n < 2; ++n) acc[a][b][m][n] = (f32x4){0.f, 0.f, 0.f, 0.f};
    bf16x8 At[4][2], B0[2][2], B1[2][2];
    const char* const gA = S.a_base();
    unsigned vC[2][2];
    S.a_off(cur, sR, sC, vC);
    const char* cB = S.b_ptr(cur);
    PG8_STAGE(PG8_SB(0, 0), cB, voffB); PG8_STAGE(PG8_SB(0, 1), cB + hstep, voffB); PG8_STAGE(PG8_SA(0, 0), gA, vC[0]); PG8_STAGE(PG8_SA(0, 1), gA, vC[1]);
    if (wr == 1) PG8_BAR;
    PG8_WAIT_V(2); PG8_BAR;
    PG8_STAGE(PG8_SB(1, 0), cB + kstep, voffB); PG8_STAGE(PG8_SA(1, 0), gA + kstep, vC[0]); PG8_STAGE(PG8_SB(1, 1), cB + hstep + kstep, voffB);
    PG8_WAIT_V(6); PG8_BAR;
    for (;;) {
        const bool has_next = S.next(ui + 1, nxt);
        const char* nB = has_next ? S.b_ptr(nxt) : cB;
        for (int t = 0; t < nt; t += 2) {
            const bool last = (t == nt - 2);
            const char* a1 = gA + (size_t)(t + 1) * kstep;
            const char* a2 = last ? gA : gA + (size_t)(t + 2) * kstep; const char* b2 = last ? nB : cB + (size_t)(t + 2) * kstep;
            const char* a3 = a2 + kstep; const char* b3 = b2 + kstep;
            PG8_LDB(B0, 0, 0); PG8_LDB(B1, 0, 1); PG8_SCHED; PG8_LDA(At, 0, 0); PG8_STAGE(PG8_SA(1, 1), a1, vC[1]);
            PG8_WAIT_V(8); PG8_WAIT_L(0); PG8_BAR; PG8_MMA(0, 0, At, B0); PG8_MMA(0, 1, At, B1); PG8_BAR; PG8_SCHED;
            if (last && has_next) S.a_off(nxt, sR, sC, vC);
            PG8_LDA(At, 0, 1); PG8_STAGE(PG8_SB(0, 0), b2, voffB); PG8_STAGE(PG8_SB(0, 1), b2 + hstep, voffB); PG8_STAGE(PG8_SA(0, 0), a2, vC[0]);
            PG8_WAIT_V(8); PG8_WAIT_L(0); PG8_BAR; PG8_MMA(1, 0, At, B0); PG8_MMA(1, 1, At, B1); PG8_BAR; PG8_SCHED;
            PG8_LDB(B0, 1, 0); PG8_LDB(B1, 1, 1); PG8_SCHED; PG8_LDA(At, 1, 0); PG8_STAGE(PG8_SA(0, 1), a2, vC[1]);
            PG8_WAIT_V(8); PG8_WAIT_L(0); PG8_BAR; PG8_MMA(0, 0, At, B0); PG8_MMA(0, 1, At, B1); PG8_BAR; PG8_SCHED;
            PG8_LDA(At, 1, 1); PG8_STAGE(PG8_SB(1, 0), b3, voffB); PG8_STAGE(PG8_SB(1, 1), b3 + hstep, voffB); PG8_STAGE(PG8_SA(1, 0), a3, vC[0]);
            PG8_WAIT_V(8); PG8_WAIT_L(0); PG8_BAR; PG8_MMA(1, 0, At, B0); PG8_MMA(1, 1, At, B1); PG8_BAR; PG8_SCHED;
        }
        if (wr == 0) PG8_BAR;
        E(acc, cur, wr, wc, fr, fq);
        if (!has_next) break;
#pragma unroll
        for (int a = 0; a < 2; ++a)
#pragma unroll
            for (int b = 0; b < 2; ++b)
#pragma unroll
                for (int m = 0; m < 4; ++m)
#pragma unroll
                    for (int n = 0; n < 2; ++n) acc[a][b][m][n] = (f32x4){0.f, 0.f, 0.f, 0.f};
        cur = nxt; cB = nB; ++ui;
        if (wr == 1) PG8_BAR;
    }
    PG8_WAIT_V(0);
    PG8_BAR;
#undef PG8_SA
#undef PG8_SB
#undef PG8_STAGE
#undef PG8_LDA
#undef PG8_LDB
#undef PG8_MMA
#undef PG8_WAIT_V
#undef PG8_WAIT_L
#undef PG8_BAR
#undef PG8_SCHED
}
}

template <class CM>
__device__ __forceinline__ void transpose_item(const float* W, int ldw, int K, bf16* WT, LAS float* scr, int k0, int n0, int lane, const CM& cmap) {
    const int kb = lane >> 3, ng = lane & 7;
    const float* src = W + cmap(n0 + 4 * ng) + (size_t)(k0 + 8 * kb) * ldw;
    f32x4 v[8];
#pragma unroll
    for (int i = 0; i < 8; ++i) v[i] = *(const f32x4*)(src + (size_t)i * ldw);
#pragma unroll
    for (int q = 0; q < 4; ++q) {
        uint4 o; o.x = f2bf(v[0][q]) | (f2bf(v[1][q]) << 16); o.y = f2bf(v[2][q]) | (f2bf(v[3][q]) << 16); o.z = f2bf(v[4][q]) | (f2bf(v[5][q]) << 16); o.w = f2bf(v[6][q]) | (f2bf(v[7][q]) << 16);
        *(uint4*)(WT + (size_t)(n0 + 4 * ng + q) * K + k0 + 8 * kb) = o;
    }
}
__device__ void ph_wprep(const Params& p, LAS float* lds, int bid, int nb) {
    const int tid = opaque_tid(), lane = tid & 63, wave = tid >> 6;
    LAS float* scr = lds + wave * 4096;
    bf16* WINT = (bf16*)(p.ws + WS_WINT); bf16* WOUTT = (bf16*)(p.ws + WS_WOUTT);
    constexpr int I_IN = (D_ / 64) * (PJ / 32), I_OUT = (D_ / 64) * (D_ / 32);
    for (int it = bid * 8 + wave; it < I_IN + I_OUT; it += nb * 8) {
        if (it < I_IN) { const int kb = it / (PJ / 32), nbk = it % (PJ / 32); transpose_item(p.in[6], INC, D_, WINT, scr, 64 * kb, 32 * nbk, lane, [](int n) { return n < 2048 ? n : n + 8; }); }
        else { const int r = it - I_IN, kb = r / (D_ / 32), nbk = r % (D_ / 32); transpose_item(p.in[16], D_, D_, WOUTT, scr, 64 * kb, 32 * nbk, lane, [](int n) { return n; }); }
    }
    float* W8T = (float*)(p.ws + WS_W8T); float* WRET = (float*)(p.ws + WS_WRET);
    for (int i = bid * NTHR + tid; i < 8 * 1024 + 64 * 1024; i += nb * NTHR) {
        if (i < 8192) { const int j = i >> 10, c = i & 1023; W8T[i] = p.in[6][(size_t)c * INC + 2048 + j]; }
        else { const int q = i - 8192, o = q >> 10, c = q & 1023; WRET[q] = p.in[21][(size_t)c * NE + o]; }
    }
}
template <class CM>
__device__ __forceinline__ void transpose_item4(const float* W, int ldw, int K, bf16* WT, int k0, int n0, int lane, const CM& cmap) {
    const int kb = lane >> 3, ng = lane & 7;
    f32x4 v[4][8];
#pragma unroll
    for (int t = 0; t < 4; ++t) { const float* src = W + cmap(n0 + 32 * t + 4 * ng) + (size_t)(k0 + 8 * kb) * ldw;
#pragma unroll
        for (int i = 0; i < 8; ++i) v[t][i] = *(const f32x4*)(src + (size_t)i * ldw); }
#pragma unroll
    for (int t = 0; t < 4; ++t)
#pragma unroll
        for (int q = 0; q < 4; ++q) {
            uint4 o; o.x = f2bf(v[t][0][q]) | (f2bf(v[t][1][q]) << 16); o.y = f2bf(v[t][2][q]) | (f2bf(v[t][3][q]) << 16); o.z = f2bf(v[t][4][q]) | (f2bf(v[t][5][q]) << 16); o.w = f2bf(v[t][6][q]) | (f2bf(v[t][7][q]) << 16);
            *(uint4*)(WT + (size_t)(n0 + 32 * t + 4 * ng + q) * K + k0 + 8 * kb) = o;
        }
}
__device__ void ph_wprep_experts(const Params& p, int bid, int nb, int lo, int hi) {
    const int tid = opaque_tid(), lane = tid & 63, wave = tid >> 6;
    bf16* WGUT = (bf16*)(p.ws + WS_WGUT); bf16* WDNT = (bf16*)(p.ws + WS_WDNT);
    constexpr int I_GU = (D_ / 64) * (2 * DE / 128), I_DN = (DE / 64) * (D_ / 128);
    for (int it = lo + bid * 8 + wave; it < hi; it += nb * 8) {
        int r = it; const int e = r / (I_GU + I_DN); r -= e * (I_GU + I_DN);
        if (r < I_GU) { const int kb = r / (2 * DE / 128), nbk = r % (2 * DE / 128);
            const float* wg = p.in[23] + (size_t)e * D_ * DE; const long up_off = (long)(p.in[24] - p.in[23]);
            transpose_item4(wg, DE, D_, WGUT + (size_t)e * 2 * DE * D_, 64 * kb, 128 * nbk, lane, [up_off](int n) -> long { const int g = n >> 5, w = n & 31; return w < 16 ? (long)(16 * g + w) : up_off + (long)(16 * g + w - 16); }); }
        else { r -= I_GU; const int kb = r / (D_ / 128), nbk = r % (D_ / 128);
            transpose_item4(p.in[25] + (size_t)e * DE * D_, D_, DE, WDNT + (size_t)e * D_ * DE, 64 * kb, 128 * nbk, lane, [](int n) { return n; }); }
    }
}

__device__ void ph_mod(const Params& p, LAS float* lds, int bid, int nb) {
    const int tid = opaque_tid();
    const float* c = p.in[1]; const float* w_ada = p.in[2]; const float* b_ada = p.in[3];
    float* mod = (float*)(p.ws + WS_MOD);
    LAS float* cact = lds;
    LAS float* part = lds + 8192;
    for (int i = tid; i < 8192; i += NTHR) cact[i] = siluf_(c[i]);
    __syncthreads();
    for (int cg = bid; cg < 256; cg += nb) {
        const int n0 = cg * 24;
        const int kq = tid / 6, cq = tid % 6;
        float acc[8][4];
#pragma unroll
        for (int b = 0; b < 8; ++b) { acc[b][0] = acc[b][1] = acc[b][2] = acc[b][3] = 0.f; }
        if (kq < 85) {
            for (int k = kq; k < 1024; k += 85) {
                const float4 w = *(const float4*)(w_ada + (size_t)k * 6144 + n0 + 4 * cq);
#pragma unroll
                for (int b = 0; b < 8; ++b) { const float a = cact[b * 1024 + k]; acc[b][0] += a * w.x; acc[b][1] += a * w.y; acc[b][2] += a * w.z; acc[b][3] += a * w.w; }
            }
#pragma unroll
            for (int b = 0; b < 8; ++b)
#pragma unroll
                for (int j = 0; j < 4; ++j) part[(kq * 8 + b) * 24 + 4 * cq + j] = acc[b][j];
        }
        __syncthreads();
        if (tid < 192) {
            const int b = tid / 24, j = tid % 24; float s = 0.f;
            for (int q = 0; q < 85; ++q) s += part[(q * 8 + b) * 24 + j];
            mod[b * 6144 + n0 + j] = s + b_ada[n0 + j];
        }
        __syncthreads();
    }
}

__device__ void ph_h(const Params& p, LAS float* lds, int bid, int nb) {
    const int tid = opaque_tid(), lane = tid & 63, wave = tid >> 6;
    const float* x = p.in[0]; const float* npm = p.in[4];
    const float* mod = (const float*)(p.ws + WS_MOD); const float* W8T = (const float*)(p.ws + WS_W8T);
    bf16* H = (bf16*)(p.ws + WS_H); float* SM = (float*)(p.ws + WS_SMALL);
    for (int i = tid; i < 2048; i += NTHR) *(LAS f32x4*)(lds + 4 * i) = *(const f32x4*)(W8T + 4 * i);
    __syncthreads();
    for (int t = bid * 8 + wave; t < T_; t += nb * 8) {
        const int b = t / NS_;
        const float* xr = x + (size_t)t * D_;
        f32x4 v[4]; float ss = 0.f;
#pragma unroll
        for (int j = 0; j < 4; ++j) { v[j] = *(const f32x4*)(xr + 4 * lane + 256 * j); ss += v[j][0] * v[j][0] + v[j][1] * v[j][1] + v[j][2] * v[j][2] + v[j][3] * v[j][3]; }
        ss = wave_sum(ss);
        const float rstd = rsqrtf(ss * (1.f / D_) + EPS);
        float sm[8];
#pragma unroll
        for (int j = 0; j < 8; ++j) sm[j] = 0.f;
#pragma unroll
        for (int j = 0; j < 4; ++j) {
            const int c0 = 4 * lane + 256 * j;
            const f32x4 nw = *(const f32x4*)(npm + c0);
            const f32x4 sh = *(const f32x4*)(mod + b * 6144 + c0);
            const f32x4 sc = *(const f32x4*)(mod + b * 6144 + 1024 + c0);
            const f32x4 h = v[j] * rstd * nw * (sc + 1.f) + sh;
            uint2 o; o.x = f2bf(h[0]) | (f2bf(h[1]) << 16); o.y = f2bf(h[2]) | (f2bf(h[3]) << 16);
            *(uint2*)(H + (size_t)t * D_ + c0) = o;
#pragma unroll
            for (int q = 0; q < 8; ++q) { const f32x4 w = *(const LAS f32x4*)(lds + q * 1024 + c0); sm[q] += h[0] * w[0] + h[1] * w[1] + h[2] * w[2] + h[3] * w[3]; }
        }
#pragma unroll
        for (int j = 0; j < 8; ++j) sm[j] = wave_sum(sm[j]);
        if (lane == 0) { *(float4*)(SM + (size_t)t * 8) = make_float4(sm[0], sm[1], sm[2], sm[3]); *(float4*)(SM + (size_t)t * 8 + 4) = make_float4(sm[4], sm[5], sm[6], sm[7]); }
    }
}

template <class AF, class BF, class EF>
__device__ __forceinline__ void sgemm_tile(LAS float* lds, int K, const AF& af, const BF& bf, const EF& ef) {
    LAS float* As = lds; LAS float* Bs = lds + 16 * 132;
    const int tid = opaque_tid(), ty = tid >> 4, tx = tid & 15;
    float acc[4][4];
#pragma unroll
    for (int i = 0; i < 4; ++i)
#pragma unroll
        for (int j = 0; j < 4; ++j) acc[i][j] = 0.f;
    const int arow = tid >> 2, akq = tid & 3;
    const bf16* ap = af(arow);
    for (int k0 = 0; k0 < K; k0 += 16) {
        float a4[4] = {0.f, 0.f, 0.f, 0.f};
        if (ap) { const uint2 v = *(const uint2*)(ap + k0 + 4 * akq); a4[0] = bf2f(v.x & 0xffffu); a4[1] = bf2f(v.x >> 16); a4[2] = bf2f(v.y & 0xffffu); a4[3] = bf2f(v.y >> 16); }
        float4 b4 = make_float4(0.f, 0.f, 0.f, 0.f);
        if (tid < 256) b4 = *(const float4*)bf(k0 + (tid >> 4), 4 * (tid & 15));
        __syncthreads();
#pragma unroll
        for (int i = 0; i < 4; ++i) As[(4 * akq + i) * 132 + arow] = a4[i];
        if (tid < 256) { LAS float* bp = Bs + (tid >> 4) * 64 + 4 * (tid & 15); bp[0] = b4.x; bp[1] = b4.y; bp[2] = b4.z; bp[3] = b4.w; }
        __syncthreads();
#pragma unroll
        for (int kk = 0; kk < 16; ++kk) {
            float a[4], b[4];
#pragma unroll
            for (int i = 0; i < 4; ++i) { a[i] = As[kk * 132 + ty * 4 + i]; b[i] = Bs[kk * 64 + tx * 4 + i]; }
#pragma unroll
            for (int i = 0; i < 4; ++i)
#pragma unroll
                for (int j = 0; j < 4; ++j) acc[i][j] += a[i] * b[j];
        }
    }
    __syncthreads();
#pragma unroll
    for (int i = 0; i < 4; ++i) { f32x4 v = {acc[i][0], acc[i][1], acc[i][2], acc[i][3]}; ef(ty * 4 + i, tx * 4, v); }
}

__device__ __forceinline__ void ph_proj(const Params& p, LAS unsigned char* lds, int bid, int nb) {
    pg8::DenseSched S; S.init(p.ws + WS_H, p.ws + WS_WINT, T_, PJ, D_, nb, bid);
    pg8::EpiBf16 E{(bf16*)(p.ws + WS_PROJ), PJ};
    pg8::gemm_phase(lds, S, E);
}

typedef short bf16x8_t __attribute__((ext_vector_type(8)));
typedef unsigned u32x4_t __attribute__((ext_vector_type(4)));
typedef unsigned u32x2_t __attribute__((ext_vector_type(2)));
__device__ __forceinline__ int lds_off16(int row, int ch) { return row * 256 + ((ch ^ (row & 15)) << 4); }
__device__ __forceinline__ int lds_off8(int row, int ch) { return row * 128 + ((ch ^ ((row >> 1) & 7)) << 4); }
__device__ __forceinline__ unsigned pk2bf(float lo, float hi) { return f2bf(lo) | (f2bf(hi) << 16); }
__device__ __forceinline__ bf16x8_t ldfrag(const LAS unsigned char* p) { return *(const LAS bf16x8_t*)p; }

__device__ void ph_dnprep(const Params& p, LAS unsigned char* lds, int bid, int nb) {
    int tid_ = threadIdx.x; asm volatile("" : "+v"(tid_));
    const int tid = tid_, lane = tid & 63, wave = tid >> 6, fr = lane & 15, fq = lane >> 4;
    const bf16* PROJ = (const bf16*)(p.ws + WS_PROJ); const float* cw = p.in[7]; const float* a_log = p.in[8]; const float* dt_bias = p.in[9];
    const float* SM = (const float*)(p.ws + WS_SMALL);
    bf16* DW = (bf16*)(p.ws + WS_DW); bf16* DQG = (bf16*)(p.ws + WS_DQG); bf16* DKDT = (bf16*)(p.ws + WS_DKDT); bf16* DATT = (bf16*)(p.ws + WS_DATT);
    float* DU = (float*)(p.ws + WS_DU); float* DEGL = (float*)(p.ws + WS_DEGL);
    constexpr int O_KN = 0, O_QS = 16384, O_KD = 32768, O_AM = 50176, O_RHS = 66560, O_GC = 132096;
    LAS float* AM = (LAS float*)(lds + O_AM); LAS float* RHS = (LAS float*)(lds + O_RHS); LAS float* GC = (LAS float*)(lds + O_GC);
    LAS unsigned short* KD = (LAS unsigned short*)(lds + O_KD);
    const float qscale = 0.08838834764831845f;
    for (int item = bid; item < 1024; item += nb) {
        const int b = item >> 7, h = (item >> 5) & 3, n = item & 31, t0 = b * NS_ + n * 64, tl0 = n * 64;
        if (wave == 0) {
            const int t = t0 + lane;
            const float bl = SM[(size_t)t * 8 + h], al = SM[(size_t)t * 8 + 4 + h];
            const float beta = sigmoidf_(bl);
            const float xx = al + dt_bias[h];
            const float sp = xx > 20.f ? xx : log1pf(expf(xx));
            float gc = -expf(a_log[h]) * sp;
#pragma unroll
            for (int o = 1; o < 64; o <<= 1) { const float y = __shfl_up(gc, o); if (lane >= o) gc += y; }
            const float glast = __shfl(gc, 63);
            GC[lane] = gc; GC[64 + lane] = beta; GC[128 + lane] = expf(gc); GC[192 + lane] = expf(glast - gc);
            if (lane == 63) DEGL[item] = expf(gc);
        }
        __syncthreads();
        {
            const int r = tid >> 3, seg = tid & 7;
            const float beta = GC[64 + r], egc = GC[128 + r], edec = GC[192 + r];
            float v3[3][16];
#pragma unroll
            for (int part = 0; part < 3; ++part) {
                const int ch = part * 512 + h * 128 + seg * 16;
#pragma unroll
                for (int i = 0; i < 16; ++i) v3[part][i] = 0.f;
#pragma unroll
                for (int j = 0; j < 4; ++j) {
                    if (tl0 + r - 3 + j >= 0) {
                        const u32x4_t x0 = *(const u32x4_t*)(PROJ + (size_t)(t0 + r - 3 + j) * PJ + ch), x1 = *(const u32x4_t*)(PROJ + (size_t)(t0 + r - 3 + j) * PJ + ch + 8);
                        const unsigned xs[8] = {x0.x, x0.y, x0.z, x0.w, x1.x, x1.y, x1.z, x1.w};
#pragma unroll
                        for (int i = 0; i < 8; ++i) { const float2 w = *(const float2*)(cw + j * 1536 + ch + 2 * i); v3[part][2 * i] += w.x * bf2f(xs[i] & 0xffffu); v3[part][2 * i + 1] += w.y * bf2f(xs[i] >> 16); }
                    }
                }
                float ss = 0.f;
#pragma unroll
                for (int i = 0; i < 16; ++i) { v3[part][i] = siluf_(v3[part][i]); ss += v3[part][i] * v3[part][i]; }
                if (part < 2) {
                    ss += __shfl_xor(ss, 1); ss += __shfl_xor(ss, 2); ss += __shfl_xor(ss, 4);
                    const float rn = rsqrtf(ss + EPS);
#pragma unroll
                    for (int i = 0; i < 16; ++i) v3[part][i] *= rn;
                }
            }
            {
                u32x4_t a0, a1, g0, g1; const float* q = v3[0]; const float s = qscale, sg = qscale * egc;
                a0.x = pk2bf(q[0] * s, q[1] * s); a0.y = pk2bf(q[2] * s, q[3] * s); a0.z = pk2bf(q[4] * s, q[5] * s); a0.w = pk2bf(q[6] * s, q[7] * s);
                a1.x = pk2bf(q[8] * s, q[9] * s); a1.y = pk2bf(q[10] * s, q[11] * s); a1.z = pk2bf(q[12] * s, q[13] * s); a1.w = pk2bf(q[14] * s, q[15] * s);
                g0.x = pk2bf(q[0] * sg, q[1] * sg); g0.y = pk2bf(q[2] * sg, q[3] * sg); g0.z = pk2bf(q[4] * sg, q[5] * sg); g0.w = pk2bf(q[6] * sg, q[7] * sg);
                g1.x = pk2bf(q[8] * sg, q[9] * sg); g1.y = pk2bf(q[10] * sg, q[11] * sg); g1.z = pk2bf(q[12] * sg, q[13] * sg); g1.w = pk2bf(q[14] * sg, q[15] * sg);
                *(LAS u32x4_t*)(lds + O_QS + lds_off16(r, 2 * seg)) = a0; *(LAS u32x4_t*)(lds + O_QS + lds_off16(r, 2 * seg + 1)) = a1;
                bf16* dst = DQG + (size_t)item * 8192 + r * 128 + seg * 16; *(u32x4_t*)dst = g0; *(u32x4_t*)(dst + 8) = g1;
            }
            {
                u32x4_t a0, a1; const float* k = v3[1];
                a0.x = pk2bf(k[0], k[1]); a0.y = pk2bf(k[2], k[3]); a0.z = pk2bf(k[4], k[5]); a0.w = pk2bf(k[6], k[7]);
                a1.x = pk2bf(k[8], k[9]); a1.y = pk2bf(k[10], k[11]); a1.z = pk2bf(k[12], k[13]); a1.w = pk2bf(k[14], k[15]);
                *(LAS u32x4_t*)(lds + O_KN + lds_off16(r, 2 * seg)) = a0; *(LAS u32x4_t*)(lds + O_KN + lds_off16(r, 2 * seg + 1)) = a1;
                u32x4_t d0, d1;
                d0.x = pk2bf(k[0] * edec, k[1] * edec); d0.y = pk2bf(k[2] * edec, k[3] * edec); d0.z = pk2bf(k[4] * edec, k[5] * edec); d0.w = pk2bf(k[6] * edec, k[7] * edec);
                d1.x = pk2bf(k[8] * edec, k[9] * edec); d1.y = pk2bf(k[10] * edec, k[11] * edec); d1.z = pk2bf(k[12] * edec, k[13] * edec); d1.w = pk2bf(k[14] * edec, k[15] * edec);
                *(LAS u32x4_t*)(KD + r * 136 + seg * 16) = d0; *(LAS u32x4_t*)(KD + r * 136 + seg * 16 + 8) = d1;
                const float bw = beta * egc;
#pragma unroll
                for (int i = 0; i < 4; ++i) *(LAS f32x4*)(RHS + r * 256 + 128 + seg * 16 + 4 * i) = (f32x4){k[4 * i] * bw, k[4 * i + 1] * bw, k[4 * i + 2] * bw, k[4 * i + 3] * bw};
            }
            {
                const float* v = v3[2];
#pragma unroll
                for (int i = 0; i < 4; ++i) *(LAS f32x4*)(RHS + r * 256 + seg * 16 + 4 * i) = (f32x4){v[4 * i] * beta, v[4 * i + 1] * beta, v[4 * i + 2] * beta, v[4 * i + 3] * beta};
            }
        }
        __syncthreads();
        {
            const int rb = wave & 3;
            bf16x8_t xf[4];
#pragma unroll
            for (int s4 = 0; s4 < 4; ++s4) xf[s4] = ldfrag(lds + O_KN + lds_off16(16 * rb + fr, 4 * s4 + fq));
#pragma unroll
            for (int cb = 0; cb < 4; ++cb) {
                f32x4 acc = {0.f, 0.f, 0.f, 0.f};
                const int yoff = (wave < 4) ? O_KN : O_QS;
#pragma unroll
                for (int s4 = 0; s4 < 4; ++s4) { const bf16x8_t yf = ldfrag(lds + yoff + lds_off16(16 * cb + fr, 4 * s4 + fq)); acc = __builtin_amdgcn_mfma_f32_16x16x32_bf16(xf[s4], yf, acc, 0, 0, 0); }
                if (wave < 4) {
                    const int j = 16 * cb + fr; const float gj = GC[j];
#pragma unroll
                    for (int r = 0; r < 4; ++r) { const int i = 16 * rb + 4 * fq + r; const bool m = i > j; const float dec = __expf(m ? GC[i] - gj : 0.f); AM[i * 64 + j] = m ? GC[64 + i] * acc[r] * dec : 0.f; }
                } else {
                    const int c = 16 * cb + fr; const float gcv = GC[c]; float o[4];
#pragma unroll
                    for (int r = 0; r < 4; ++r) { const int sidx = 16 * rb + 4 * fq + r; const bool m = c >= sidx; const float dec = __expf(m ? gcv - GC[sidx] : 0.f); o[r] = m ? acc[r] * dec : 0.f; }
                    u32x2_t w; w.x = pk2bf(o[0], o[1]); w.y = pk2bf(o[2], o[3]);
                    *(u32x2_t*)(DATT + (size_t)item * 4096 + c * 64 + 16 * rb + 4 * fq) = w;
                }
            }
        }
        __syncthreads();
        if (tid < 256) {
            const int c = tid;
            float x[64];
#pragma unroll
            for (int i = 0; i < 64; ++i) {
                float s0 = RHS[i * 256 + c], s1 = 0.f;
#pragma unroll
                for (int j4 = 0; j4 < (i + 3) / 4; ++j4) {
                    const f32x4 a = *(const LAS f32x4*)(AM + i * 64 + 4 * j4);
                    if (4 * j4 + 0 < i) s0 -= a.x * x[4 * j4 + 0];
                    if (4 * j4 + 1 < i) s1 -= a.y * x[4 * j4 + 1];
                    if (4 * j4 + 2 < i) s0 -= a.z * x[4 * j4 + 2];
                    if (4 * j4 + 3 < i) s1 -= a.w * x[4 * j4 + 3];
                }
                x[i] = s0 + s1;
            }
            if (c < 128) {
#pragma unroll
                for (int i = 0; i < 64; ++i) DU[(size_t)item * 8192 + i * 128 + c] = x[i];
            } else {
#pragma unroll
                for (int i = 0; i < 64; ++i) DW[(size_t)item * 8192 + i * 128 + (c - 128)] = (bf16)f2bf(x[i]);
            }
        } else {
            const int tt = tid - 256, d = tt >> 1, c0 = (tt & 1) * 32;
            unsigned w[16];
#pragma unroll
            for (int i = 0; i < 16; ++i) w[i] = (unsigned)KD[(c0 + 2 * i) * 136 + d] | ((unsigned)KD[(c0 + 2 * i + 1) * 136 + d] << 16);
            bf16* dst = DKDT + (size_t)item * 8192 + d * 64 + c0;
#pragma unroll
            for (int i = 0; i < 4; ++i) *(u32x4_t*)(dst + 8 * i) = (u32x4_t){w[4 * i], w[4 * i + 1], w[4 * i + 2], w[4 * i + 3]};
        }
        __syncthreads();
    }
}

__device__ void ph_dnscan(const Params& p, LAS unsigned char* lds, int sbid, int nsb) {
    int tid_ = threadIdx.x; asm volatile("" : "+v"(tid_));
    const int tid = tid_, lane = tid & 63, wave = __builtin_amdgcn_readfirstlane(tid >> 6), fr = lane & 15, fq = lane >> 4;
    const bf16* DW = (const bf16*)(p.ws + WS_DW); const bf16* DQG = (const bf16*)(p.ws + WS_DQG); const bf16* DKDT = (const bf16*)(p.ws + WS_DKDT); const bf16* DATT = (const bf16*)(p.ws + WS_DATT);
    const float* DU = (const float*)(p.ws + WS_DU); const float* DEGL = (const float*)(p.ws + WS_DEGL);
    float* ORAW = (float*)(p.ws + WS_ORAW);
    constexpr int BUF = 57344, O_W = 0, O_QG = 16384, O_KDT = 32768, O_ATT = 49152, O_SB = 114688, O_VNT = 131072;
    const int cb = wave >> 1, eb = wave & 1;
    for (int it = sbid; it < 128; it += nsb) {
        const int bh = (it & 7) * 4 + (it >> 5), es = (it >> 3) & 3, b = bh >> 2, h = bh & 3, e0 = es * 32, item0 = bh * 32;
        f32x4 st[2] = {{0.f, 0.f, 0.f, 0.f}, {0.f, 0.f, 0.f, 0.f}};
        *(LAS u32x4_t*)(lds + O_SB + tid * 16) = (u32x4_t){0u, 0u, 0u, 0u};
        u32x4_t rg[7]; float un[4]; float egl_n;
#define DN_LOAD(itm) do { const size_t _o = (size_t)(itm) * 8192; \
            rg[0] = *(const u32x4_t*)(DW + _o + (size_t)tid * 8); rg[1] = *(const u32x4_t*)(DW + _o + (size_t)(tid + 512) * 8); \
            rg[2] = *(const u32x4_t*)(DQG + _o + (size_t)tid * 8); rg[3] = *(const u32x4_t*)(DQG + _o + (size_t)(tid + 512) * 8); \
            rg[4] = *(const u32x4_t*)(DKDT + _o + (size_t)tid * 8); rg[5] = *(const u32x4_t*)(DKDT + _o + (size_t)(tid + 512) * 8); \
            rg[6] = *(const u32x4_t*)(DATT + (size_t)(itm) * 4096 + (size_t)tid * 8); \
            _Pragma("unroll") for (int _r = 0; _r < 4; ++_r) un[_r] = DU[_o + (size_t)(16 * cb + 4 * fq + _r) * 128 + e0 + 16 * eb + fr]; \
            egl_n = DEGL[(itm)]; } while (0)
#define DN_STORE(bufo) do { LAS unsigned char* _b = lds + (bufo); \
            *(LAS u32x4_t*)(_b + O_W + lds_off16(tid >> 4, tid & 15)) = rg[0]; *(LAS u32x4_t*)(_b + O_W + lds_off16((tid + 512) >> 4, tid & 15)) = rg[1]; \
            *(LAS u32x4_t*)(_b + O_QG + lds_off16(tid >> 4, tid & 15)) = rg[2]; *(LAS u32x4_t*)(_b + O_QG + lds_off16((tid + 512) >> 4, tid & 15)) = rg[3]; \
            *(LAS u32x4_t*)(_b + O_KDT + lds_off8(tid >> 3, tid & 7)) = rg[4]; *(LAS u32x4_t*)(_b + O_KDT + lds_off8((tid + 512) >> 3, tid & 7)) = rg[5]; \
            *(LAS u32x4_t*)(_b + O_ATT + lds_off8(tid >> 3, tid & 7)) = rg[6]; } while (0)
        DN_LOAD(item0);
        DN_STORE(0);
        float u[4] = {un[0], un[1], un[2], un[3]}; float egl = egl_n;
        __syncthreads();
        for (int n = 0; n < 32; ++n) {
            const int bufo = (n & 1) * BUF, sbo = O_SB + (n & 1) * 8192, sbn = O_SB + ((n + 1) & 1) * 8192;
            if (n < 31) DN_LOAD(item0 + n + 1);
            f32x4 acc = {0.f, 0.f, 0.f, 0.f};
            bf16x8_t sf[4];
#pragma unroll
            for (int s4 = 0; s4 < 4; ++s4) sf[s4] = ldfrag(lds + sbo + lds_off16(16 * eb + fr, 4 * s4 + fq));
#pragma unroll
            for (int s4 = 0; s4 < 4; ++s4) acc = __builtin_amdgcn_mfma_f32_16x16x32_bf16(ldfrag(lds + bufo + O_W + lds_off16(16 * cb + fr, 4 * s4 + fq)), sf[s4], acc, 0, 0, 0);
            {
                const float v0 = u[0] - acc[0], v1 = u[1] - acc[1], v2 = u[2] - acc[2], v3 = u[3] - acc[3];
                u32x2_t w; w.x = pk2bf(v0, v1); w.y = pk2bf(v2, v3);
                *(LAS u32x2_t*)(lds + O_VNT + lds_off8(16 * eb + fr, 2 * cb + (fq >> 1)) + 8 * (fq & 1)) = w;
            }
            __syncthreads();
            f32x4 oacc = {0.f, 0.f, 0.f, 0.f};
#pragma unroll
            for (int s4 = 0; s4 < 4; ++s4) oacc = __builtin_amdgcn_mfma_f32_16x16x32_bf16(ldfrag(lds + bufo + O_QG + lds_off16(16 * cb + fr, 4 * s4 + fq)), sf[s4], oacc, 0, 0, 0);
            bf16x8_t vf[2][2];
#pragma unroll
            for (int e2 = 0; e2 < 2; ++e2)
#pragma unroll
                for (int s2 = 0; s2 < 2; ++s2) vf[e2][s2] = ldfrag(lds + O_VNT + lds_off8(16 * e2 + fr, 4 * s2 + fq));
#pragma unroll
            for (int s2 = 0; s2 < 2; ++s2) oacc = __builtin_amdgcn_mfma_f32_16x16x32_bf16(ldfrag(lds + bufo + O_ATT + lds_off8(16 * cb + fr, 4 * s2 + fq)), ldfrag(lds + O_VNT + lds_off8(16 * eb + fr, 4 * s2 + fq)), oacc, 0, 0, 0);
            {
                const size_t t0 = (size_t)b * NS_ + n * 64;
#pragma unroll
                for (int r = 0; r < 4; ++r) ORAW[(t0 + 16 * cb + 4 * fq + r) * 512 + h * 128 + e0 + 16 * eb + fr] = oacc[r];
            }
#pragma unroll
            for (int e2 = 0; e2 < 2; ++e2) {
                st[e2] = st[e2] * egl;
#pragma unroll
                for (int s2 = 0; s2 < 2; ++s2) st[e2] = __builtin_amdgcn_mfma_f32_16x16x32_bf16(ldfrag(lds + bufo + O_KDT + lds_off8(16 * wave + fr, 4 * s2 + fq)), vf[e2][s2], st[e2], 0, 0, 0);
                u32x2_t w; w.x = pk2bf(st[e2][0], st[e2][1]); w.y = pk2bf(st[e2][2], st[e2][3]);
                *(LAS u32x2_t*)(lds + sbn + lds_off16(16 * e2 + fr, 2 * wave + (fq >> 1)) + 8 * (fq & 1)) = w;
            }
            if (n < 31) { DN_STORE(((n + 1) & 1) * BUF); u[0] = un[0]; u[1] = un[1]; u[2] = un[2]; u[3] = un[3]; egl = egl_n; }
            __syncthreads();
        }
#undef DN_LOAD
#undef DN_STORE
    }
}

__device__ void ph_mixed(const Params& p, int bid, int nb) {
    const int tid = opaque_tid(), lane = tid & 63, wave = tid >> 6;
    const float* ORAW = (const float*)(p.ws + WS_ORAW); const bf16* PROJ = (const bf16*)(p.ws + WS_PROJ); const float* nw = p.in[10];
    bf16* MIXED = (bf16*)(p.ws + WS_MIXED);
    for (int t = bid * 8 + wave; t < T_; t += nb * 8) {
#pragma unroll
        for (int hh = 0; hh < 4; ++hh) {
            const float2 o = *(const float2*)(ORAW + (size_t)t * 512 + hh * 128 + 2 * lane);
            const float ss = wave_sum(o.x * o.x + o.y * o.y);
            const float r = rsqrtf(ss * (1.f / 128.f) + EPS);
            const unsigned zz = *(const unsigned*)(PROJ + (size_t)t * PJ + 1536 + hh * 128 + 2 * lane);
            const float m0 = o.x * r * nw[2 * lane] * siluf_(bf2f(zz & 0xffffu)), m1 = o.y * r * nw[2 * lane + 1] * siluf_(bf2f(zz >> 16));
            *(unsigned*)(MIXED + (size_t)t * D_ + hh * 128 + 2 * lane) = f2bf(m0) | (f2bf(m1) << 16);
        }
    }
}

__device__ void ph_cf(const Params& p, LAS float* lds, int bid, int nb) {
    const int tid = opaque_tid(), lane = tid & 63, wave = tid >> 6;
    const bf16* PROJ = (const bf16*)(p.ws + WS_PROJ);
    const float* pwb = p.in[11]; const float* dww = p.in[12]; const float* dwb = p.in[13]; const float* lnw = p.in[14]; const float* lnb = p.in[15];
    bf16* MIXED = (bf16*)(p.ws + WS_MIXED);
    constexpr int TT = 32;
    const int c = tid;
    float w[CFK];
#pragma unroll
    for (int j = 0; j < CFK; ++j) w[j] = dww[j * CFW + c];
    const float ba = pwb[c], bg = pwb[512 + c], cb = dwb[c];
    for (int it = bid; it < T_ / TT; it += nb) {
        const int t0 = it * TT, tl0 = t0 % NS_;
        float xg[TT + CFK - 1];
#pragma unroll
        for (int i = 0; i < TT + CFK - 1; ++i) {
            const int tl = tl0 - (CFK - 1) + i;
            float g = 0.f;
            if (tl >= 0) {
                const size_t row = (size_t)(t0 - (CFK - 1) + i);
                const float a = bf2f(PROJ[row * PJ + 2048 + c]) + ba, gt = bf2f(PROJ[row * PJ + 2560 + c]) + bg;
                g = a * sigmoidf_(gt);
            }
            xg[i] = g;
        }
        __syncthreads();
#pragma unroll
        for (int r = 0; r < TT; ++r) {
            float s = cb;
#pragma unroll
            for (int j = 0; j < CFK; ++j) s += w[j] * xg[r + j];
            lds[r * 512 + c] = s;
        }
        __syncthreads();
#pragma unroll
        for (int rr = 0; rr < 4; ++rr) {
            const int r = wave * 4 + rr;
            float v[8]; float s = 0.f;
#pragma unroll
            for (int j = 0; j < 8; ++j) { v[j] = lds[r * 512 + lane + 64 * j]; s += v[j]; }
            const float mu = wave_sum(s) * (1.f / 512.f);
            float q = 0.f;
#pragma unroll
            for (int j = 0; j < 8; ++j) { v[j] -= mu; q += v[j] * v[j]; }
            const float rstd = rsqrtf(wave_sum(q) * (1.f / 512.f) + EPS);
#pragma unroll
            for (int j = 0; j < 8; ++j) { const int cc = lane + 64 * j; const float y = v[j] * rstd * lnw[cc] + lnb[cc]; MIXED[(size_t)(t0 + r) * D_ + 512 + cc] = (bf16)f2bf(siluf_(y)); }
        }
    }
}

__device__ __forceinline__ void ph_outproj(const Params& p, LAS unsigned char* lds, int bid, int nb) {
    pg8::DenseSched S; S.init(p.ws + WS_MIXED, p.ws + WS_WOUTT, T_, D_, D_, nb, bid);
    pg8::EpiF32 E{(float*)(p.ws + WS_HMIX), D_};
    pg8::gemm_phase(lds, S, E);
}

struct Row2 { float h2[16]; int gi; float gp; };
__device__ __forceinline__ void row2_front(const Params& p, const LAS float* tab, int t, int lane, const f32x4 (&hm)[4], const f32x4 (&xv)[4], Row2& R) {
    const float* npost = p.in[5]; const float* npre = p.in[17]; const float* brg = p.in[20];
    const float* mod = (const float*)(p.ws + WS_MOD) + (t / NS_) * 6144; bf16* H2 = (bf16*)(p.ws + WS_H);
    float ss = 0.f;
#pragma unroll
    for (int j = 0; j < 4; ++j) ss += hm[j][0] * hm[j][0] + hm[j][1] * hm[j][1] + hm[j][2] * hm[j][2] + hm[j][3] * hm[j][3];
    ss = wave_sum(ss);
    const float r1 = rsqrtf(ss * (1.f / D_) + EPS);
    f32x4 x1[4]; float s2 = 0.f;
#pragma unroll
    for (int j = 0; j < 4; ++j) {
        const int c0 = 4 * lane + 256 * j;
        x1[j] = xv[j] + *(const f32x4*)(mod + 2048 + c0) * (hm[j] * r1 * *(const f32x4*)(npost + c0));
        s2 += x1[j][0] * x1[j][0] + x1[j][1] * x1[j][1] + x1[j][2] * x1[j][2] + x1[j][3] * x1[j][3];
        *(f32x4*)(p.out + (size_t)t * D_ + c0) = x1[j];
    }
    s2 = wave_sum(s2);
    const float r2 = rsqrtf(s2 * (1.f / D_) + EPS);
    float gl[8];
#pragma unroll
    for (int o = 0; o < 8; ++o) gl[o] = 0.f;
#pragma unroll
    for (int j = 0; j < 4; ++j) {
        const int c0 = 4 * lane + 256 * j;
        const f32x4 h = x1[j] * r2 * *(const f32x4*)(npre + c0) * (*(const f32x4*)(mod + 4096 + c0) + 1.f) + *(const f32x4*)(mod + 3072 + c0);
        R.h2[4 * j] = h[0]; R.h2[4 * j + 1] = h[1]; R.h2[4 * j + 2] = h[2]; R.h2[4 * j + 3] = h[3];
        uint2 o2; o2.x = f2bf(h[0]) | (f2bf(h[1]) << 16); o2.y = f2bf(h[2]) | (f2bf(h[3]) << 16);
        *(uint2*)(H2 + (size_t)t * D_ + c0) = o2;
#pragma unroll
        for (int o = 0; o < 8; ++o) { const f32x4 w = *(const LAS f32x4*)(tab + o * 1024 + c0); gl[o] += h[0] * w[0] + h[1] * w[1] + h[2] * w[2] + h[3] * w[3]; }
    }
    float gmax = -3.0e38f; int gi = 0;
#pragma unroll
    for (int o = 0; o < 8; ++o) { gl[o] = wave_sum(gl[o]) + brg[o]; if (gl[o] > gmax) { gmax = gl[o]; gi = o; } }
    float gden = 0.f;
#pragma unroll
    for (int o = 0; o < 8; ++o) gden += __expf(gl[o] - gmax);
    R.gi = gi; R.gp = 1.f / gden;
}
__device__ __forceinline__ void row2_back(const Params& p, int lr, int lane, const Row2& R, LAS int* rte, LAS int* rtr, LAS float* rtw, LAS int* lcnt) {
    const float* bre = p.in[22];
    const float* WRET = (const float*)(p.ws + WS_WRET) + (size_t)R.gi * 8 * 1024;
    float el[8];
#pragma unroll
    for (int o = 0; o < 8; ++o) {
        float a = 0.f;
#pragma unroll
        for (int j = 0; j < 4; ++j) { const f32x4 w = *(const f32x4*)(WRET + o * 1024 + 4 * lane + 256 * j); a += R.h2[4 * j] * w[0] + R.h2[4 * j + 1] * w[1] + R.h2[4 * j + 2] * w[2] + R.h2[4 * j + 3] * w[3]; }
        el[o] = a;
        if ((o & 3) == 3) asm volatile("" ::: "memory");
    }
    float m1 = -3.0e38f, m2 = -3.0e38f; int i1 = 0, i2 = 0;
#pragma unroll
    for (int o = 0; o < 8; ++o) el[o] = wave_sum(el[o]) + bre[R.gi * 8 + o];
#pragma unroll
    for (int o = 0; o < 8; ++o) { if (el[o] > m1) { m1 = el[o]; i1 = o; } }
#pragma unroll
    for (int o = 0; o < 8; ++o) { if (o != i1 && el[o] > m2) { m2 = el[o]; i2 = o; } }
    const float e2 = __expf(m2 - m1);
    if (lane == 0) {
        const int ea = R.gi * 8 + i1, eb = R.gi * 8 + i2;
        rte[2 * lr] = ea; rte[2 * lr + 1] = eb;
        rtw[2 * lr] = R.gp * (1.f / (1.f + e2)); rtw[2 * lr + 1] = R.gp * (e2 / (1.f + e2));
        rtr[2 * lr] = __hip_atomic_fetch_add(lcnt + ea, 1, __ATOMIC_RELAXED, __HIP_MEMORY_SCOPE_WORKGROUP); rtr[2 * lr + 1] = __hip_atomic_fetch_add(lcnt + eb, 1, __ATOMIC_RELAXED, __HIP_MEMORY_SCOPE_WORKGROUP);
    }
}
__device__ void ph_row2(const Params& p, LAS float* lds, int bid, int nb) {
    const int tid = opaque_tid(), lane = tid & 63, wave = tid >> 6;
    const float* x = p.in[0]; const float* wrg = p.in[19];
    const float* HMIX = (const float*)(p.ws + WS_HMIX);
    int* ROUTE = (int*)(p.ws + WS_ROUTE); int* POS = (int*)(p.ws + WS_POS); int* TOKL = (int*)(p.ws + WS_TOKL); float* WL = (float*)(p.ws + WS_WL);
    unsigned* cnt = (unsigned*)(p.ws + WS_CTL) + CW_CNT;
    LAS float* tab = lds;
    LAS int* rte = (LAS int*)(lds + 8192); LAS int* rtr = rte + 128; LAS float* rtw = (LAS float*)(rtr + 128); LAS int* lcnt = (LAS int*)(rtw + 128); LAS int* lbase = lcnt + 64;
    for (int i = tid; i < 8192; i += NTHR) tab[(i & 7) * 1024 + (i >> 3)] = wrg[i];
    if (tid < 64) lcnt[tid] = 0;
    __syncthreads();
    for (int chunk = bid; chunk < T_ / 64; chunk += nb) {
        const int tb = chunk * 64 + wave * 8;
        f32x4 hmA[4], xvA[4], hmB[4], xvB[4];
#define R2_LOAD(hm, xv, t) do { _Pragma("unroll") for (int j = 0; j < 4; ++j) { hm[j] = *(const f32x4*)(HMIX + (size_t)(t) * D_ + 4 * lane + 256 * j); xv[j] = *(const f32x4*)(x + (size_t)(t) * D_ + 4 * lane + 256 * j); } } while (0)
        R2_LOAD(hmA, xvA, tb);
#pragma unroll 1
        for (int pr = 0; pr < 4; ++pr) {
            const int ta = tb + 2 * pr;
            R2_LOAD(hmB, xvB, ta + 1);
            { Row2 RA; row2_front(p, tab, ta, lane, hmA, xvA, RA); row2_back(p, wave * 8 + 2 * pr, lane, RA, rte, rtr, rtw, lcnt); }
            asm volatile("" ::: "memory");
            if (pr < 3) R2_LOAD(hmA, xvA, ta + 2);
            { Row2 RB; row2_front(p, tab, ta + 1, lane, hmB, xvB, RB); row2_back(p, wave * 8 + 2 * pr + 1, lane, RB, rte, rtr, rtw, lcnt); }
            asm volatile("" ::: "memory");
        }
#undef R2_LOAD
        __syncthreads();
        if (tid < 64) { const int c = lcnt[tid]; lbase[tid] = c > 0 ? (int)atomicAdd(cnt + tid, (unsigned)c) : 0; }
        __syncthreads();
        if (tid < 128) {
            const int e = rte[tid], pos = lbase[e] + rtr[tid], t = chunk * 64 + (tid >> 1);
            ROUTE[(size_t)t * 4 + (tid & 1)] = e; POS[(size_t)t * 2 + (tid & 1)] = pos;
            TOKL[(size_t)e * T_ + pos] = t; WL[(size_t)e * T_ + pos] = rtw[tid];
        }
        __syncthreads();
        if (tid < 64) lcnt[tid] = 0;
        __syncthreads();
    }
}

struct MoeMap { LAS int* tstart; LAS int* cnt; int total_tiles; };
__device__ __forceinline__ MoeMap moe_map(const Params& p, LAS int* l) {
    const unsigned* cnt = (const unsigned*)(p.ws + WS_CTL) + CW_CNT;
    __syncthreads();
    if (threadIdx.x == 0) { int s = 0; for (int e = 0; e < NE; ++e) { const int c = (int)__hip_atomic_load(cnt + e, __ATOMIC_RELAXED, __HIP_MEMORY_SCOPE_AGENT); l[e] = s; l[128 + e] = c; s += (c + TM - 1) / TM; } l[NE] = s; }
    __syncthreads();
    MoeMap m; m.tstart = l; m.cnt = l + 128; m.total_tiles = l[NE];
    return m;
}
__device__ __forceinline__ int moe_find(const MoeMap& m, int tile) { int e = 0; while (e < NE - 1 && m.tstart[e + 1] <= tile) ++e; return e; }

__device__ __forceinline__ void ph_moe_gu(const Params& p, LAS unsigned char* lds, int bid, int nb) {
    MoeMap mm = moe_map(p, (LAS int*)(lds + pg8::STAGE_BYTES));
    pg8::GroupSched S{(const char*)(p.ws + WS_H), (const char*)(p.ws + WS_WGUT), D_, 4, (size_t)2 * DE * D_ * 2, mm.tstart, mm.cnt, mm.total_tiles, nb, bid, (const int*)(p.ws + WS_TOKL)};
    pg8::EpiGU E{(bf16*)(p.ws + WS_HID)};
    pg8::gemm_phase(lds, S, E);
}
__device__ __forceinline__ void ph_moe_down(const Params& p, LAS unsigned char* lds, int bid, int nb) {
    MoeMap mm = moe_map(p, (LAS int*)(lds + pg8::STAGE_BYTES));
    pg8::GroupSched S{(const char*)(p.ws + WS_HID), (const char*)(p.ws + WS_WDNT), DE, 4, (size_t)D_ * DE * 2, mm.tstart, mm.cnt, mm.total_tiles, nb, bid, nullptr};
    pg8::EpiDown E{(bf16*)(p.ws + WS_Y), (const float*)(p.ws + WS_WL), mm.cnt};
    pg8::gemm_phase(lds, S, E);
}

__device__ void ph_final(const Params& p, LAS float* lds, int bid, int nb) {
    const int tid = opaque_tid(), lane = tid & 63, wave = tid >> 6;
    const float* npf = p.in[18]; const float* mod = (const float*)(p.ws + WS_MOD);
    const bf16* Y = (const bf16*)(p.ws + WS_Y); const int* ROUTE = (const int*)(p.ws + WS_ROUTE); const int* POS = (const int*)(p.ws + WS_POS);
    MoeMap mm = moe_map(p, (LAS int*)lds);
    for (int t = bid * 8 + wave; t < T_; t += nb * 8) {
        const int b = t / NS_;
        const int ea = ROUTE[(size_t)t * 4], eb = ROUTE[(size_t)t * 4 + 1];
        const size_t ga = (size_t)mm.tstart[ea] * TM + POS[(size_t)t * 2], gb = (size_t)mm.tstart[eb] * TM + POS[(size_t)t * 2 + 1];
        float m[16]; float ss = 0.f;
#pragma unroll
        for (int j = 0; j < 4; ++j) {
            const uint2 a = *(const uint2*)(Y + ga * D_ + 4 * lane + 256 * j), bb = *(const uint2*)(Y + gb * D_ + 4 * lane + 256 * j);
            m[4 * j] = bf2f(a.x & 0xffffu) + bf2f(bb.x & 0xffffu); m[4 * j + 1] = bf2f(a.x >> 16) + bf2f(bb.x >> 16);
            m[4 * j + 2] = bf2f(a.y & 0xffffu) + bf2f(bb.y & 0xffffu); m[4 * j + 3] = bf2f(a.y >> 16) + bf2f(bb.y >> 16);
#pragma unroll
            for (int i = 0; i < 4; ++i) ss += m[4 * j + i] * m[4 * j + i];
        }
        ss = wave_sum(ss);
        const float r = rsqrtf(ss * (1.f / D_) + EPS);
#pragma unroll
        for (int j = 0; j < 4; ++j) {
            const int c0 = 4 * lane + 256 * j;
            float4 o = *(float4*)(p.out + (size_t)t * D_ + c0);
            o.x += mod[b * 6144 + 5120 + c0] * (m[4 * j] * r * npf[c0]);
            o.y += mod[b * 6144 + 5120 + c0 + 1] * (m[4 * j + 1] * r * npf[c0 + 1]);
            o.z += mod[b * 6144 + 5120 + c0 + 2] * (m[4 * j + 2] * r * npf[c0 + 2]);
            o.w += mod[b * 6144 + 5120 + c0 + 3] * (m[4 * j + 3] * r * npf[c0 + 3]);
            *(float4*)(p.out + (size_t)t * D_ + c0) = o;
        }
    }
}

constexpr int LDS_BYTES = 147456;
#define XB_TMO      128
#define XB_XCNT(j)  (256  + 64 * (j))
#define XB_XSUB(j)  (1280 + 64 * (j))
#define XB_XGEN(j)  (2304 + 64 * (j))
#define XB_TOP      3328
#define XB_TOPGEN   3392
#define XCD_BAR_WORDS 3456
#define XB_SPIN_CAP (1u << 22)
__device__ __forceinline__ unsigned xb_ld(unsigned* p)              { return __hip_atomic_load(p, __ATOMIC_RELAXED, __HIP_MEMORY_SCOPE_AGENT); }
__device__ __forceinline__ unsigned xb_add(unsigned* p, unsigned v) { return __hip_atomic_fetch_add(p, v, __ATOMIC_RELAXED, __HIP_MEMORY_SCOPE_AGENT); }
__device__ __forceinline__ unsigned xb_xcc_id() { return (unsigned)__builtin_amdgcn_s_getreg((3 << 11) | 20) & 0xFu; }
#define XB_SPIN(cond, bar) do { unsigned _sp = 0; while (cond) { __builtin_amdgcn_s_sleep(1); \
    if ((++_sp & 255u) == 0u) { if (xb_ld(&(bar)[XB_TMO])) break; if (_sp > XB_SPIN_CAP) { atomicAdd(&(bar)[XB_TMO], 1u); break; } } } } while (0)
struct XcdBarrier { unsigned* bar; unsigned x; volatile LAS unsigned* st; };
__device__ __forceinline__ XcdBarrier xcd_barrier_post(unsigned* bar, volatile LAS unsigned* st) {
    XcdBarrier b; b.bar = bar; b.x = xb_xcc_id(); b.st = st;
    if (threadIdx.x == 0) (void)xb_add(&bar[XB_XCNT(b.x)], 1u);
    return b;
}
__device__ __forceinline__ void xcd_barrier_complete(unsigned* bar, unsigned x, unsigned& nloc, unsigned& nx) {
    const unsigned G = gridDim.x * gridDim.y * gridDim.z;
    unsigned sum, cnt, mine, sp = 0u;
    for (;;) {
        sum = 0u; cnt = 0u; mine = 0u;
#pragma unroll
        for (unsigned j = 0; j < 16; ++j) { const unsigned c = xb_ld(&bar[XB_XCNT(j)]); sum += c; cnt += (c > 0u) ? 1u : 0u; mine = (j == x) ? c : mine; }
        if (sum == G) break;
        __builtin_amdgcn_s_sleep(1);
        if ((++sp & 255u) == 0u) { if (xb_ld(&bar[XB_TMO])) break; if (sp > XB_SPIN_CAP) { atomicAdd(&bar[XB_TMO], 1u); break; } }
    }
    nloc = mine > 0u ? mine : 1u; nx = cnt > 0u ? cnt : 1u;
}
__device__ __forceinline__ void xcd_barrier(unsigned char* ws, volatile LAS unsigned* st) {
    XcdBarrier b; b.bar = (unsigned*)(ws + WS_CTL) + 4096; b.x = xb_xcc_id(); b.st = st;
    asm volatile("s_waitcnt vmcnt(0)" ::: "memory");
    __syncthreads();
    if (threadIdx.x == 0) {
        unsigned* bar = b.bar;
        __builtin_amdgcn_s_waitcnt(0);
        unsigned nloc = b.st[0], nx = b.st[1];
        if (nloc == 0u) { xcd_barrier_complete(bar, b.x, nloc, nx); b.st[0] = nloc; b.st[1] = nx; }
        const unsigned old = xb_add(&bar[XB_XSUB(b.x)], 1u);
        const unsigned gen = old / nloc;
        if (old + 1u == (gen + 1u) * nloc) {
            __builtin_amdgcn_fence(__ATOMIC_RELEASE, "agent");
            asm volatile("s_waitcnt vmcnt(0)" ::: "memory");
            const unsigned og = xb_add(&bar[XB_TOP], 1u);
            const unsigned tg = og / nx;
            if (og + 1u == (tg + 1u) * nx) xb_add(&bar[XB_TOPGEN], 1u);
            else XB_SPIN(xb_ld(&bar[XB_TOPGEN]) == tg, bar);
            __builtin_amdgcn_fence(__ATOMIC_ACQUIRE, "agent");
            xb_add(&bar[XB_XGEN(b.x)], 1u);
            asm volatile("s_waitcnt vmcnt(0)" ::: "memory");
        } else {
            XB_SPIN(xb_ld(&bar[XB_XGEN(b.x)]) == gen, bar);
            __builtin_amdgcn_fence(__ATOMIC_ACQUIRE, "agent");
            asm volatile("s_waitcnt vmcnt(0)" ::: "memory");
        }
    }
    __syncthreads();
}
constexpr int CW_BAR = 4096;
constexpr int LDS_ST_OFF = LDS_BYTES - 64;

__global__ void __launch_bounds__(NTHR, 2) mk_all(Params p) {
    extern __shared__ __attribute__((aligned(16))) unsigned char lds_raw[];
    LAS float* lds = (LAS float*)lds_raw;
    const int bid = blockIdx.x, nb = gridDim.x;
    volatile LAS unsigned* st = (volatile LAS unsigned*)((LAS unsigned char*)lds_raw + LDS_ST_OFF);
    if (threadIdx.x < 16) st[threadIdx.x] = 0u;
    __syncthreads();
    (void)xcd_barrier_post((unsigned*)(p.ws + WS_CTL) + CW_BAR, st);
#ifndef STAMP_SEL
#define STAMP_SEL -1
#endif
    unsigned long long t_prev = 0, dt_sel = 0;
    if (STAMP_SEL >= 0) t_prev = __builtin_amdgcn_s_memrealtime();
#define STAMP(k) do { if (STAMP_SEL >= 0) { const unsigned long long now_ = __builtin_amdgcn_s_memrealtime(); if ((k) == STAMP_SEL && bid == 0) dt_sel = now_ - t_prev; t_prev = now_; } } while (0)
    ph_wprep(p, lds, bid, nb); __syncthreads();
    ph_mod(p, lds, bid, nb);            xcd_barrier(p.ws, st); STAMP(0);
    ph_h(p, lds, bid, nb);              xcd_barrier(p.ws, st); STAMP(1);
    ph_proj(p, (LAS unsigned char*)lds_raw, bid, nb);           xcd_barrier(p.ws, st); STAMP(2);
    ph_dnprep(p, (LAS unsigned char*)lds_raw, bid, nb);    xcd_barrier(p.ws, st); STAMP(3);
    {
        constexpr int CONV_ITEMS = NE * ((D_ / 64) * (2 * DE / 128) + (DE / 64) * (D_ / 128)), CONV_SPLIT = (CONV_ITEMS * 6 / 10) & ~7;
        if (bid < nb / 2) { ph_dnscan(p, (LAS unsigned char*)lds_raw, bid, nb / 2); ph_wprep_experts(p, bid, nb / 2, 0, CONV_SPLIT); }
        else { ph_cf(p, lds, bid - nb / 2, nb - nb / 2); ph_wprep_experts(p, bid - nb / 2, nb - nb / 2, CONV_SPLIT, CONV_ITEMS); }
    }
    if (STAMP_SEL == 40 && bid == 0) { const unsigned long long now_ = __builtin_amdgcn_s_memrealtime(); dt_sel = now_ - t_prev; }
    xcd_barrier(p.ws, st); STAMP(4);
    ph_mixed(p, bid, nb);               xcd_barrier(p.ws, st); STAMP(5);
    ph_outproj(p, (LAS unsigned char*)lds_raw, bid, nb);        xcd_barrier(p.ws, st); STAMP(6);
    ph_row2(p, lds, bid, nb);           xcd_barrier(p.ws, st); STAMP(7);
    ph_moe_gu(p, (LAS unsigned char*)lds_raw, bid, nb);      xcd_barrier(p.ws, st); STAMP(8);
    ph_moe_down(p, (LAS unsigned char*)lds_raw, bid, nb);    xcd_barrier(p.ws, st); STAMP(9);
    ph_final(p, lds, bid, nb);
    if (STAMP_SEL >= 0) {
        __syncthreads(); STAMP(10);
        { const unsigned long long t0 = __builtin_amdgcn_s_memrealtime(); while (__builtin_amdgcn_s_memrealtime() - t0 < 8ull * dt_sel) __builtin_amdgcn_s_sleep(8); }
    }
}

extern "C" void kernel_launch(void* const* d_in, const int* in_sizes, int n_in, void* d_out, int out_size, void* d_ws, size_t ws_size, hipStream_t stream) {
    static int inited = 0;
    if (!inited) {
        if (n_in != 26 || out_size != T_ * D_ || ws_size < WS_END) { fprintf(stderr, "kernel_launch: unexpected shapes n_in %d out %d ws %zu\n", n_in, out_size, ws_size); inited = -1; return; }
        if (hipFuncSetAttribute((const void*)mk_all, hipFuncAttributeMaxDynamicSharedMemorySize, LDS_BYTES) != hipSuccess) { fprintf(stderr, "hipFuncSetAttribute failed\n"); inited = -1; return; }
        inited = 1;
    }
    if (inited < 0) return;
    (void)hipMemsetAsync((char*)d_ws + WS_CTL, 0, 1 * MiB, stream);
    Params p{};
    for (int i = 0; i < 26; ++i) p.in[i] = (const float*)d_in[i];
    p.out = (float*)d_out; p.ws = (unsigned char*)d_ws;
    hipLaunchKernelGGL(mk_all, dim3(256), dim3(NTHR), LDS_BYTES, stream, p);
}
```

```cpp
#include <hip/hip_runtime.h>
#include <cstdio>
#include <cstdint>

#define LAS __attribute__((address_space(3)))
typedef unsigned short bf16;
typedef float f32x4 __attribute__((ext_vector_type(4)));

constexpr int NB_ = 8, NS_ = 2048, D_ = 1024, T_ = NB_ * NS_;
constexpr int DNW = 512, NH = 4, HD = 128;
constexpr int CFW = 512, CFK = 31;
constexpr int INC = 3080;
constexpr int PJ = 3072;
constexpr int NE = 64, DE = 512;
constexpr int NTHR = 512;
constexpr float EPS = 1e-6f;
constexpr int TM = 256;
constexpr int MAXROWS = 2 * T_ + NE * TM;

constexpr size_t MiB = 1u << 20;
constexpr size_t WS_CTL = 0;
constexpr size_t WS_MOD = 1 * MiB;
constexpr size_t WS_SMALL = 1 * MiB + 512 * 1024;
constexpr size_t WS_ROUTE = 2 * MiB;
constexpr size_t WS_POS = 2 * MiB + 512 * 1024;
constexpr size_t WS_TOKL = 3 * MiB;
constexpr size_t WS_WL = 7 * MiB;
constexpr size_t WS_W8T = 11 * MiB;
constexpr size_t WS_WRTH = 12 * MiB;
constexpr size_t WS_WRTL = 12 * MiB + 256 * 1024;
constexpr size_t WS_WINT = 16 * MiB;
constexpr size_t WS_WOUTT = 22 * MiB;
constexpr size_t WS_WGUT = 24 * MiB;
constexpr size_t WS_WDNT = 152 * MiB;
constexpr size_t WS_H = 216 * MiB;
constexpr size_t WS_PROJ = 248 * MiB;
constexpr size_t WS_HMIX = 248 * MiB;
constexpr size_t WS_HID = 248 * MiB;
constexpr size_t WS_DW = 344 * MiB;
constexpr size_t WS_DQG = 360 * MiB;
constexpr size_t WS_DKDT = 376 * MiB;
constexpr size_t WS_DATT = 392 * MiB;
constexpr size_t WS_DU = 400 * MiB;
constexpr size_t WS_DEGL = 432 * MiB;
constexpr size_t WS_Y = 344 * MiB;
constexpr size_t WS_ORAW = 440 * MiB;
constexpr size_t WS_MIXED = 472 * MiB;
constexpr size_t WS_END = 504 * MiB;
constexpr int CW_CNT = 1024;

__device__ __forceinline__ unsigned f2bf(float f) { unsigned u = __builtin_bit_cast(unsigned, f); return (u + 0x7fffu + ((u >> 16) & 1u)) >> 16; }
__device__ __forceinline__ float bf2f(unsigned b) { return __builtin_bit_cast(float, b << 16); }
template <int CTRL, int ROWMASK> __device__ __forceinline__ float dpp_f(float v) {
    return __builtin_bit_cast(float, __builtin_amdgcn_update_dpp(0, __builtin_bit_cast(int, v), CTRL, ROWMASK, 0xF, true));
}
__device__ __forceinline__ float wave_sum(float v) {
    v += dpp_f<0xB1, 0xF>(v);
    v += dpp_f<0x4E, 0xF>(v);
    v += dpp_f<0x141, 0xF>(v);
    v += dpp_f<0x140, 0xF>(v);
    v += dpp_f<0x142, 0xA>(v);
    v += dpp_f<0x143, 0xC>(v);
    return __builtin_bit_cast(float, __builtin_amdgcn_readlane(__builtin_bit_cast(int, v), 63));
}
__device__ __forceinline__ float sigmoidf_(float x) { return 1.f / (1.f + __expf(-x)); }
__device__ __forceinline__ float siluf_(float x) { return x / (1.f + __expf(-x)); }

__device__ __forceinline__ int opaque_tid() { int t = threadIdx.x; asm volatile("" : "+v"(t)); return t; }

struct Params {
    const float* in[26];
    float* out;
    unsigned char* ws;
};


namespace pg8 {
#define PG8_LAS __attribute__((address_space(3)))
typedef unsigned short bf16_t;
typedef short bf16x8 __attribute__((ext_vector_type(8)));
typedef float f32x4 __attribute__((ext_vector_type(4)));
typedef unsigned u32x4 __attribute__((ext_vector_type(4)));
typedef unsigned u32x2 __attribute__((ext_vector_type(2)));
constexpr int BM = 256, BK = 64, HALF = 128, HTB = HALF * BK * 2, STAGE_BYTES = 8 * HTB, NXCD = 8, WGM = 8;
__host__ __device__ __forceinline__ int lds_byte(int r, int c) { const int st = (r >> 4) * 2 + (c >> 5), rr = r & 15, cc = c & 31, ob = rr * 64 + cc * 2; return st * 1024 + (ob ^ (((ob >> 9) & 1) << 5)); }
__host__ __device__ __forceinline__ void stage_rc(int b, int& R, int& C) { const int st = b / 1024, sb = b % 1024, swz = sb ^ (((sb >> 9) & 1) << 5); R = (st >> 1) * 16 + swz / 64; C = (st & 1) * 32 + (swz % 64) / 2; }
__host__ __device__ __forceinline__ int perm32(int rho) { const int n = rho >> 4, i = rho & 15; return 8 * (i >> 2) + 4 * n + (i & 3); }
struct Unit { int pm, pn, e, r0; };
__device__ __forceinline__ unsigned cvt_pk_bf16(float lo, float hi) { unsigned r; asm volatile("v_cvt_pk_bf16_f32 %0, %1, %2" : "=v"(r) : "v"(lo), "v"(hi)); return r; }

struct DenseSched {
    const char* A; const char* Bt; int K; int nM, nN, nwg, G, c;
    __device__ void init(const void* A_, const void* Bt_, int M, int N, int K_, int G_, int c_) { A = (const char*)A_; Bt = (const char*)Bt_; K = K_; nM = M / BM; nN = N / BM; nwg = nM * nN; G = G_; c = c_; }
    __device__ bool next(int i, Unit& u) const {
        const long L = (long)i * G + c; if (L >= nwg) return false;
        int wgid = (int)L; { const int q = nwg / NXCD, r = nwg % NXCD, xcd = wgid % NXCD, off = wgid / NXCD; wgid = (xcd < r ? xcd * (q + 1) : r * (q + 1) + (xcd - r) * q) + off; }
        const int nig = WGM * nN, gid = wgid / nig, fm = gid * WGM, gsz = (nM - fm) < WGM ? (nM - fm) : WGM;
        u.pm = fm + ((wgid % nig) % gsz); u.pn = (wgid % nig) / gsz; u.e = 0; u.r0 = 0; return true;
    }
    __device__ __forceinline__ const char* a_base() const { return A; }
    __device__ __forceinline__ const char* b_ptr(const Unit& u) const { return Bt + (size_t)u.pn * BM * K * 2; }
    __device__ __forceinline__ void a_off(const Unit& u, const int (&R)[2], const int (&C)[2], unsigned (&v)[2][2]) const {
#pragma unroll
        for (int h = 0; h < 2; ++h)
#pragma unroll
            for (int i = 0; i < 2; ++i) v[h][i] = (unsigned)(((u.pm * BM + h * HALF + R[i]) * K + C[i]) * 2);
    }
};

struct EpiBf16 {
    static constexpr bool PERM = true;
    bf16_t* O; int ldc;
    __device__ __forceinline__ void operator()(const f32x4 (&acc)[2][2][4][2], const Unit& u, int wr, int wc, int fr, int fq) const {
        const int row0 = u.pm * BM + wr * 64 + fr, col0 = u.pn * BM + wc * 32 + 8 * fq;
#pragma unroll
        for (int ai = 0; ai < 2; ++ai)
#pragma unroll
            for (int m = 0; m < 4; ++m) { bf16_t* rowp = O + (size_t)(row0 + ai * HALF + m * 16) * ldc + col0;
#pragma unroll
                for (int bj = 0; bj < 2; ++bj) { const f32x4 v0 = acc[ai][bj][m][0], v1 = acc[ai][bj][m][1];
                    u32x4 w; w.x = cvt_pk_bf16(v0[0], v0[1]); w.y = cvt_pk_bf16(v0[2], v0[3]); w.z = cvt_pk_bf16(v1[0], v1[1]); w.w = cvt_pk_bf16(v1[2], v1[3]);
                    *(u32x4*)(rowp + bj * HALF) = w; } }
    }
};
struct EpiF32 {
    static constexpr bool PERM = false;
    float* C; int ldc;
    __device__ __forceinline__ void operator()(const f32x4 (&acc)[2][2][4][2], const Unit& u, int wr, int wc, int fr, int fq) const {
        const int row0 = u.pm * BM + wr * 64 + fr, col0 = u.pn * BM + wc * 32 + 4 * fq;
#pragma unroll
        for (int ai = 0; ai < 2; ++ai)
#pragma unroll
            for (int m = 0; m < 4; ++m) { float* rowp = C + (size_t)(row0 + ai * HALF + m * 16) * ldc + col0;
#pragma unroll
                for (int bj = 0; bj < 2; ++bj)
#pragma unroll
                    for (int n = 0; n < 2; ++n) *(f32x4*)(rowp + bj * HALF + n * 16) = acc[ai][bj][m][n]; }
    }
};

struct GroupSched {
    const char* A; const char* Bt; int K; int nN; size_t bstride; LAS int* tstart; LAS int* cnt; int total; int G, c; const int* tokl;
    __device__ __forceinline__ bool next(int i, Unit& u) const {
        const int L = i * G + c; if (L >= total * nN) return false;
        const int tile = L / nN; u.pn = L % nN; int e = 0; while (e < NE - 1 && tstart[e + 1] <= tile) ++e;
        u.e = e; u.pm = tile; u.r0 = (tile - tstart[e]) * BM; return true;
    }
    __device__ __forceinline__ const char* a_base() const { return A; }
    __device__ __forceinline__ const char* b_ptr(const Unit& u) const { return Bt + (size_t)u.e * bstride + (size_t)u.pn * BM * K * 2; }
    __device__ __forceinline__ void a_off(const Unit& u, const int (&R)[2], const int (&C)[2], unsigned (&v)[2][2]) const {
        const int ce = cnt[u.e];
#pragma unroll
        for (int h = 0; h < 2; ++h)
#pragma unroll
            for (int i = 0; i < 2; ++i) {
                const int r = u.r0 + h * HALF + R[i];
                int grow = u.pm * BM + h * HALF + R[i];
                if (tokl) grow = (r < ce) ? tokl[(size_t)u.e * T_ + r] : 0;
                v[h][i] = (unsigned)((grow * K + C[i]) * 2);
            }
    }
};
struct EpiGU {
    static constexpr bool PERM = false;
    bf16_t* HID;
    __device__ __forceinline__ void operator()(const f32x4 (&acc)[2][2][4][2], const Unit& u, int wr, int wc, int fr, int fq) const {
        const int row0 = u.pm * BM + wr * 64 + fr;
#pragma unroll
        for (int ai = 0; ai < 2; ++ai)
#pragma unroll
            for (int m = 0; m < 4; ++m) { bf16_t* rowp = HID + (size_t)(row0 + ai * HALF + m * 16) * DE;
#pragma unroll
                for (int bj = 0; bj < 2; ++bj) { const f32x4 g = acc[ai][bj][m][0], up = acc[ai][bj][m][1];
                    float h[4];
#pragma unroll
                    for (int i = 0; i < 4; ++i) h[i] = g[i] / (1.f + __expf(-g[i])) * up[i];
                    u32x2 w; w.x = cvt_pk_bf16(h[0], h[1]); w.y = cvt_pk_bf16(h[2], h[3]);
                    *(u32x2*)(rowp + 16 * (u.pn * 8 + 4 * bj + wc) + 4 * fq) = w; } }
    }
};
struct EpiDown {
    static constexpr bool PERM = true;
    bf16_t* Y; const float* wl; LAS int* cnt;
    __device__ __forceinline__ void operator()(const f32x4 (&acc)[2][2][4][2], const Unit& u, int wr, int wc, int fr, int fq) const {
        const int rloc = wr * 64 + fr, col0 = u.pn * BM + wc * 32 + 8 * fq, ce = cnt[u.e];
#pragma unroll
        for (int ai = 0; ai < 2; ++ai)
#pragma unroll
            for (int m = 0; m < 4; ++m) { const int r = u.r0 + rloc + ai * HALF + m * 16;
                if (r < ce) {
                    const float w = wl[(size_t)u.e * T_ + r];
                    bf16_t* rowp = Y + (size_t)(u.pm * BM + rloc + ai * HALF + m * 16) * D_ + col0;
#pragma unroll
                    for (int bj = 0; bj < 2; ++bj) { const f32x4 v0 = acc[ai][bj][m][0] * w, v1 = acc[ai][bj][m][1] * w;
                        u32x4 o; o.x = cvt_pk_bf16(v0[0], v0[1]); o.y = cvt_pk_bf16(v0[2], v0[3]); o.z = cvt_pk_bf16(v1[0], v1[1]); o.w = cvt_pk_bf16(v1[2], v1[3]);
                        *(u32x4*)(rowp + bj * HALF) = o; } } }
    }
};

template <class Epi, class Sched>
__device__ __forceinline__ void gemm_phase(PG8_LAS unsigned char* lds, const Sched& S, const Epi& E) {
    int tid_ = threadIdx.x; asm volatile("" : "+v"(tid_));
    const int tid = tid_, wid = __builtin_amdgcn_readfirstlane(tid >> 6), lane = tid & 63, wr = wid >> 2, wc = wid & 3, fr = lane & 15, fq = lane >> 4;
    const int K = S.K, nt = K / BK;
    int sR[2], sC[2]; unsigned voffB[2];
#pragma unroll
    for (int i = 0; i < 2; ++i) { int R, C; stage_rc(tid * 16 + i * 8192, R, C); sR[i] = R; sC[i] = C; const int Rb = Epi::PERM ? ((R & ~31) + perm32(R & 31)) : R; voffB[i] = (unsigned)(Rb * K + C) * 2u; }
    const size_t kstep = (size_t)(BK * 2);
    const size_t hstep = (size_t)HALF * K * 2;
    const unsigned ldsw = (unsigned)wid * 1024u;
    const int aoff = lds_byte(wr * 64 + fr, fq * 8), boff = lds_byte(wc * 32 + fr, fq * 8);
#define PG8_SA(b, h) (((b) * 2 + (h)) * HTB)
#define PG8_SB(b, h) ((4 + (b) * 2 + (h)) * HTB)
#define PG8_STAGE(bufoff, gbase, voff) do { _Pragma("unroll") for (int _i = 0; _i < 2; ++_i) \
        __builtin_amdgcn_global_load_lds((const unsigned*)((const char*)(gbase) + (voff)[_i]), (PG8_LAS unsigned*)(lds + (bufoff) + ldsw + _i * 8192), 16, 0, 0); } while (0)
#define PG8_LDA(dst, b, h) do { _Pragma("unroll") for (int m = 0; m < 4; ++m) _Pragma("unroll") for (int k = 0; k < 2; ++k) dst[m][k] = *(const PG8_LAS bf16x8*)(lds + PG8_SA(b, h) + aoff + m * 2048 + k * 1024); } while (0)
#define PG8_LDB(dst, b, h) do { _Pragma("unroll") for (int n = 0; n < 2; ++n) _Pragma("unroll") for (int k = 0; k < 2; ++k) dst[n][k] = *(const PG8_LAS bf16x8*)(lds + PG8_SB(b, h) + boff + n * 2048 + k * 1024); } while (0)
#define PG8_MMA(ai, bj, At, Bt) do { __builtin_amdgcn_s_setprio(1); _Pragma("unroll") for (int m = 0; m < 4; ++m) _Pragma("unroll") for (int n = 0; n < 2; ++n) _Pragma("unroll") for (int k = 0; k < 2; ++k) \
        acc[ai][bj][m][n] = __builtin_amdgcn_mfma_f32_16x16x32_bf16(Bt[n][k], At[m][k], acc[ai][bj][m][n], 0, 0, 0); __builtin_amdgcn_s_setprio(0); } while (0)
#define PG8_WAIT_V(n) asm volatile("s_waitcnt vmcnt(" #n ")" ::: "memory")
#define PG8_WAIT_L(n) asm volatile("s_waitcnt lgkmcnt(" #n ")" ::: "memory")
#define PG8_BAR __builtin_amdgcn_s_barrier()
#define PG8_SCHED __builtin_amdgcn_sched_barrier(0)
    Unit cur, nxt; int ui = 0;
    if (!S.next(0, cur)) return;
    f32x4 acc[2][2][4][2];
#pragma unroll
    for (int a = 0; a < 2; ++a)
#pragma unroll
        for (int b = 0; b < 2; ++b)
#pragma unroll
            for (int m = 0; m < 4; ++m)
#pragma unroll
                for (int n = 0; n < 2; ++n) acc[a][b][m][n] = (f32x4){0.f, 0.f, 0.f, 0.f};
    bf16x8 At[4][2], B0[2][2], B1[2][2];
    const char* const gA = S.a_base();
    unsigned vC[2][2];
    S.a_off(cur, sR, sC, vC);
    const char* cB = S.b_ptr(cur);
    PG8_STAGE(PG8_SB(0, 0), cB, voffB); PG8_STAGE(PG8_SB(0, 1), cB + hstep, voffB); PG8_STAGE(PG8_SA(0, 0), gA, vC[0]); PG8_STAGE(PG8_SA(0, 1), gA, vC[1]);
    if (wr == 1) PG8_BAR;
    PG8_WAIT_V(2); PG8_BAR;
    PG8_STAGE(PG8_SB(1, 0), cB + kstep, voffB); PG8_STAGE(PG8_SA(1, 0), gA + kstep, vC[0]); PG8_STAGE(PG8_SB(1, 1), cB + hstep + kstep, voffB);
    PG8_WAIT_V(6); PG8_BAR;
    for (;;) {
        const bool has_next = S.next(ui + 1, nxt);
        const char* nB = has_next ? S.b_ptr(nxt) : cB;
        for (int t = 0; t < nt; t += 2) {
            const bool last = (t == nt - 2);
            const char* a1 = gA + (size_t)(t + 1) * kstep;
            const char* a2 = last ? gA : gA + (size_t)(t + 2) * kstep; const char* b2 = last ? nB : cB + (size_t)(t + 2) * kstep;
            const char* a3 = a2 + kstep; const char* b3 = b2 + kstep;
            PG8_LDB(B0, 0, 0); PG8_LDB(B1, 0, 1); PG8_SCHED; PG8_LDA(At, 0, 0); PG8_STAGE(PG8_SA(1, 1), a1, vC[1]);
            PG8_WAIT_V(8); PG8_WAIT_L(0); PG8_BAR; PG8_MMA(0, 0, At, B0); PG8_MMA(0, 1, At, B1); PG8_BAR; PG8_SCHED;
            if (last && has_next) S.a_off(nxt, sR, sC, vC);
            PG8_LDA(At, 0, 1); PG8_STAGE(PG8_SB(0, 0), b2, voffB); PG8_STAGE(PG8_SB(0, 1), b2 + hstep, voffB); PG8_STAGE(PG8_SA(0, 0), a2, vC[0]);
            PG8_WAIT_V(8); PG8_WAIT_L(0); PG8_BAR; PG8_MMA(1, 0, At, B0); PG8_MMA(1, 1, At, B1); PG8_BAR; PG8_SCHED;
            PG8_LDB(B0, 1, 0); PG8_LDB(B1, 1, 1); PG8_SCHED; PG8_LDA(At, 1, 0); PG8_STAGE(PG8_SA(0, 1), a2, vC[1]);
            PG8_WAIT_V(8); PG8_WAIT_L(0); PG8_BAR; PG8_MMA(0, 0, At, B0); PG8_MMA(0, 1, At, B1); PG8_BAR; PG8_SCHED;
            PG8_LDA(At, 1, 1); PG8_STAGE(PG8_SB(1, 0), b3, voffB); PG8_STAGE(PG8_SB(1, 1), b3 + hstep, voffB); PG8_STAGE(PG8_SA(1, 0), a3, vC[0]);
            PG8_WAIT_V(8); PG8_WAIT_L(0); PG8_BAR; PG8_MMA(1, 0, At, B0); PG8_MMA(1, 1, At, B1); PG8_BAR; PG8_SCHED;
        }
        if (wr == 0) PG8_BAR;
        E(acc, cur, wr, wc, fr, fq);
        if (!has_next) break;
#pragma unroll
        for (int a = 0; a < 2; ++a)
#pragma unroll
            for (int b = 0; b < 2; ++b)
#pragma unroll
                for (int m = 0; m < 4; ++m)
#pragma unroll
                    for (int n = 0; n < 2; ++n) acc[a][b][m][n] = (f32x4){0.f, 0.f, 0.f, 0.f};
        cur = nxt; cB = nB; ++ui;
        if (wr == 1) PG8_BAR;
    }
    PG8_WAIT_V(0);
    PG8_BAR;
#undef PG8_SA
#undef PG8_SB
#undef PG8_STAGE
#undef PG8_LDA
#undef PG8_LDB
#undef PG8_MMA
#undef PG8_WAIT_V
#undef PG8_WAIT_L
#undef PG8_BAR
#undef PG8_SCHED
}
}

template <class CM>
__device__ __forceinline__ void transpose_item(const float* W, int ldw, int K, bf16* WT, LAS float* scr, int k0, int n0, int lane, const CM& cmap) {
    const int kb = lane >> 3, ng = lane & 7;
    const float* src = W + cmap(n0 + 4 * ng) + (size_t)(k0 + 8 * kb) * ldw;
    f32x4 v[8];
#pragma unroll
    for (int i = 0; i < 8; ++i) v[i] = *(const f32x4*)(src + (size_t)i * ldw);
#pragma unroll
    for (int q = 0; q < 4; ++q) {
        uint4 o; o.x = f2bf(v[0][q]) | (f2bf(v[1][q]) << 16); o.y = f2bf(v[2][q]) | (f2bf(v[3][q]) << 16); o.z = f2bf(v[4][q]) | (f2bf(v[5][q]) << 16); o.w = f2bf(v[6][q]) | (f2bf(v[7][q]) << 16);
        *(uint4*)(WT + (size_t)(n0 + 4 * ng + q) * K + k0 + 8 * kb) = o;
    }
}
__device__ void ph_wprep(const Params& p, LAS float* lds, int bid, int nb) {
    const int tid = opaque_tid(), lane = tid & 63, wave = tid >> 6;
    LAS float* scr = lds + wave * 4096;
    bf16* WINT = (bf16*)(p.ws + WS_WINT); bf16* WOUTT = (bf16*)(p.ws + WS_WOUTT);
    constexpr int I_IN = (D_ / 64) * (PJ / 32), I_OUT = (D_ / 64) * (D_ / 32);
    for (int it = bid * 8 + wave; it < I_IN + I_OUT; it += nb * 8) {
        if (it < I_IN) { const int kb = it / (PJ / 32), nbk = it % (PJ / 32); transpose_item(p.in[6], INC, D_, WINT, scr, 64 * kb, 32 * nbk, lane, [](int n) { return n < 2048 ? n : n + 8; }); }
        else { const int r = it - I_IN, kb = r / (D_ / 32), nbk = r % (D_ / 32); transpose_item(p.in[16], D_, D_, WOUTT, scr, 64 * kb, 32 * nbk, lane, [](int n) { return n; }); }
    }
    float* W8T = (float*)(p.ws + WS_W8T); bf16* WRTH = (bf16*)(p.ws + WS_WRTH); bf16* WRTL = (bf16*)(p.ws + WS_WRTL);
    for (int i = bid * NTHR + tid; i < 8 * 1024 + 80 * 1024; i += nb * NTHR) {
        if (i < 8192) { const int j = i >> 10, c = i & 1023; W8T[i] = p.in[6][(size_t)c * INC + 2048 + j]; }
        else { const int q = i - 8192, n = q >> 10, c = q & 1023;
            const float w = n < 8 ? p.in[19][(size_t)c * 8 + n] : (n < 16 ? 0.f : p.in[21][(size_t)c * NE + (n - 16)]);
            const unsigned hi = f2bf(w); WRTH[q] = (bf16)hi; WRTL[q] = (bf16)f2bf(w - bf2f(hi)); }
    }
}
template <class CM>
__device__ __forceinline__ void transpose_item4(const float* W, int ldw, int K, bf16* WT, int k0, int n0, int lane, const CM& cmap) {
    const int kb = lane >> 3, ng = lane & 7;
    f32x4 v[4][8];
#pragma unroll
    for (int t = 0; t < 4; ++t) { const float* src = W + cmap(n0 + 32 * t + 4 * ng) + (size_t)(k0 + 8 * kb) * ldw;
#pragma unroll
        for (int i = 0; i < 8; ++i) v[t][i] = *(const f32x4*)(src + (size_t)i * ldw); }
#pragma unroll
    for (int t = 0; t < 4; ++t)
#pragma unroll
        for (int q = 0; q < 4; ++q) {
            uint4 o; o.x = f2bf(v[t][0][q]) | (f2bf(v[t][1][q]) << 16); o.y = f2bf(v[t][2][q]) | (f2bf(v[t][3][q]) << 16); o.z = f2bf(v[t][4][q]) | (f2bf(v[t][5][q]) << 16); o.w = f2bf(v[t][6][q]) | (f2bf(v[t][7][q]) << 16);
            *(uint4*)(WT + (size_t)(n0 + 32 * t + 4 * ng + q) * K + k0 + 8 * kb) = o;
        }
}
__device__ void ph_wprep_experts(const Params& p, int bid, int nb, int lo, int hi) {
    const int tid = opaque_tid(), lane = tid & 63, wave = tid >> 6;
    bf16* WGUT = (bf16*)(p.ws + WS_WGUT); bf16* WDNT = (bf16*)(p.ws + WS_WDNT);
    constexpr int I_GU = (D_ / 64) * (2 * DE / 128), I_DN = (DE / 64) * (D_ / 128);
    for (int it = lo + bid * 8 + wave; it < hi; it += nb * 8) {
        int r = it; const int e = r / (I_GU + I_DN); r -= e * (I_GU + I_DN);
        if (r < I_GU) { const int kb = r / (2 * DE / 128), nbk = r % (2 * DE / 128);
            const float* wg = p.in[23] + (size_t)e * D_ * DE; const long up_off = (long)(p.in[24] - p.in[23]);
            transpose_item4(wg, DE, D_, WGUT + (size_t)e * 2 * DE * D_, 64 * kb, 128 * nbk, lane, [up_off](int n) -> long { const int g = n >> 5, w = n & 31; return w < 16 ? (long)(16 * g + w) : up_off + (long)(16 * g + w - 16); }); }
        else { r -= I_GU; const int kb = r / (D_ / 128), nbk = r % (D_ / 128);
            transpose_item4(p.in[25] + (size_t)e * DE * D_, D_, DE, WDNT + (size_t)e * D_ * DE, 64 * kb, 128 * nbk, lane, [](int n) { return n; }); }
    }
}

__device__ void ph_mod(const Params& p, LAS float* lds, int bid, int nb) {
    const int tid = opaque_tid();
    const float* c = p.in[1]; const float* w_ada = p.in[2]; const float* b_ada = p.in[3];
    float* mod = (float*)(p.ws + WS_MOD);
    LAS float* cact = lds;
    LAS float* part = lds + 8192;
    for (int i = tid; i < 8192; i += NTHR) cact[i] = siluf_(c[i]);
    __syncthreads();
    for (int cg = bid; cg < 256; cg += nb) {
        const int n0 = cg * 24;
        const int kq = tid / 6, cq = tid % 6;
        float acc[8][4];
#pragma unroll
        for (int b = 0; b < 8; ++b) { acc[b][0] = acc[b][1] = acc[b][2] = acc[b][3] = 0.f; }
        if (kq < 85) {
            for (int k = kq; k < 1024; k += 85) {
                const float4 w = *(const float4*)(w_ada + (size_t)k * 6144 + n0 + 4 * cq);
#pragma unroll
                for (int b = 0; b < 8; ++b) { const float a = cact[b * 1024 + k]; acc[b][0] += a * w.x; acc[b][1] += a * w.y; acc[b][2] += a * w.z; acc[b][3] += a * w.w; }
            }
#pragma unroll
            for (int b = 0; b < 8; ++b)
#pragma unroll
                for (int j = 0; j < 4; ++j) part[(kq * 8 + b) * 24 + 4 * cq + j] = acc[b][j];
        }
        __syncthreads();
        if (tid < 192) {
            const int b = tid / 24, j = tid % 24; float s = 0.f;
            for (int q = 0; q < 85; ++q) s += part[(q * 8 + b) * 24 + j];
            mod[b * 6144 + n0 + j] = s + b_ada[n0 + j];
        }
        __syncthreads();
    }
}

__device__ void ph_h(const Params& p, LAS float* lds, int bid, int nb) {
    const int tid = opaque_tid(), lane = tid & 63, wave = tid >> 6;
    const float* x = p.in[0]; const float* npm = p.in[4];
    const float* mod = (const float*)(p.ws + WS_MOD); const float* W8T = (const float*)(p.ws + WS_W8T);
    bf16* H = (bf16*)(p.ws + WS_H); float* SM = (float*)(p.ws + WS_SMALL);
    for (int i = tid; i < 2048; i += NTHR) *(LAS f32x4*)(lds + 4 * i) = *(const f32x4*)(W8T + 4 * i);
    __syncthreads();
    for (int t = bid * 8 + wave; t < T_; t += nb * 8) {
        const int b = t / NS_;
        const float* xr = x + (size_t)t * D_;
        f32x4 v[4]; float ss = 0.f;
#pragma unroll
        for (int j = 0; j < 4; ++j) { v[j] = *(const f32x4*)(xr + 4 * lane + 256 * j); ss += v[j][0] * v[j][0] + v[j][1] * v[j][1] + v[j][2] * v[j][2] + v[j][3] * v[j][3]; }
        ss = wave_sum(ss);
        const float rstd = rsqrtf(ss * (1.f / D_) + EPS);
        float sm[8];
#pragma unroll
        for (int j = 0; j < 8; ++j) sm[j] = 0.f;
#pragma unroll
        for (int j = 0; j < 4; ++j) {
            const int c0 = 4 * lane + 256 * j;
            const f32x4 nw = *(const f32x4*)(npm + c0);
            const f32x4 sh = *(const f32x4*)(mod + b * 6144 + c0);
            const f32x4 sc = *(const f32x4*)(mod + b * 6144 + 1024 + c0);
            const f32x4 h = v[j] * rstd * nw * (sc + 1.f) + sh;
            uint2 o; o.x = f2bf(h[0]) | (f2bf(h[1]) << 16); o.y = f2bf(h[2]) | (f2bf(h[3]) << 16);
            *(uint2*)(H + (size_t)t * D_ + c0) = o;
#pragma unroll
            for (int q = 0; q < 8; ++q) { const f32x4 w = *(const LAS f32x4*)(lds + q * 1024 + c0); sm[q] += h[0] * w[0] + h[1] * w[1] + h[2] * w[2] + h[3] * w[3]; }
        }
#pragma unroll
        for (int j = 0; j < 8; ++j) sm[j] = wave_sum(sm[j]);
        if (lane == 0) { *(float4*)(SM + (size_t)t * 8) = make_float4(sm[0], sm[1], sm[2], sm[3]); *(float4*)(SM + (size_t)t * 8 + 4) = make_float4(sm[4], sm[5], sm[6], sm[7]); }
    }
}

template <class AF, class BF, class EF>
__device__ __forceinline__ void sgemm_tile(LAS float* lds, int K, const AF& af, const BF& bf, const EF& ef) {
    LAS float* As = lds; LAS float* Bs = lds + 16 * 132;
    const int tid = opaque_tid(), ty = tid >> 4, tx = tid & 15;
    float acc[4][4];
#pragma unroll
    for (int i = 0; i < 4; ++i)
#pragma unroll
        for (int j = 0; j < 4; ++j) acc[i][j] = 0.f;
    const int arow = tid >> 2, akq = tid & 3;
    const bf16* ap = af(arow);
    for (int k0 = 0; k0 < K; k0 += 16) {
        float a4[4] = {0.f, 0.f, 0.f, 0.f};
        if (ap) { const uint2 v = *(const uint2*)(ap + k0 + 4 * akq); a4[0] = bf2f(v.x & 0xffffu); a4[1] = bf2f(v.x >> 16); a4[2] = bf2f(v.y & 0xffffu); a4[3] = bf2f(v.y >> 16); }
        float4 b4 = make_float4(0.f, 0.f, 0.f, 0.f);
        if (tid < 256) b4 = *(const float4*)bf(k0 + (tid >> 4), 4 * (tid & 15));
        __syncthreads();
#pragma unroll
        for (int i = 0; i < 4; ++i) As[(4 * akq + i) * 132 + arow] = a4[i];
        if (tid < 256) { LAS float* bp = Bs + (tid >> 4) * 64 + 4 * (tid & 15); bp[0] = b4.x; bp[1] = b4.y; bp[2] = b4.z; bp[3] = b4.w; }
        __syncthreads();
#pragma unroll
        for (int kk = 0; kk < 16; ++kk) {
            float a[4], b[4];
#pragma unroll
            for (int i = 0; i < 4; ++i) { a[i] = As[kk * 132 + ty * 4 + i]; b[i] = Bs[kk * 64 + tx * 4 + i]; }
#pragma unroll
            for (int i = 0; i < 4; ++i)
#pragma unroll
                for (int j = 0; j < 4; ++j) acc[i][j] += a[i] * b[j];
        }
    }
    __syncthreads();
#pragma unroll
    for (int i = 0; i < 4; ++i) { f32x4 v = {acc[i][0], acc[i][1], acc[i][2], acc[i][3]}; ef(ty * 4 + i, tx * 4, v); }
}

__device__ __forceinline__ void ph_proj(const Params& p, LAS unsigned char* lds, int bid, int nb) {
    pg8::DenseSched S; S.init(p.ws + WS_H, p.ws + WS_WINT, T_, PJ, D_, nb, bid);
    pg8::EpiBf16 E{(bf16*)(p.ws + WS_PROJ), PJ};
    pg8::gemm_phase(lds, S, E);
}

typedef short bf16x8_t __attribute__((ext_vector_type(8)));
typedef unsigned u32x4_t __attribute__((ext_vector_type(4)));
typedef unsigned u32x2_t __attribute__((ext_vector_type(2)));
__device__ __forceinline__ int lds_off16(int row, int ch) { return row * 256 + ((ch ^ (row & 15)) << 4); }
__device__ __forceinline__ int lds_off8(int row, int ch) { return row * 128 + ((ch ^ ((row >> 1) & 7)) << 4); }
__device__ __forceinline__ unsigned pk2bf(float lo, float hi) { return f2bf(lo) | (f2bf(hi) << 16); }
__device__ __forceinline__ bf16x8_t ldfrag(const LAS unsigned char* p) { return *(const LAS bf16x8_t*)p; }

__device__ void ph_dnprep(const Params& p, LAS unsigned char* lds, int bid, int nb) {
    int tid_ = threadIdx.x; asm volatile("" : "+v"(tid_));
    const int tid = tid_, lane = tid & 63, wave = tid >> 6, fr = lane & 15, fq = lane >> 4;
    const bf16* PROJ = (const bf16*)(p.ws + WS_PROJ); const float* cw = p.in[7]; const float* a_log = p.in[8]; const float* dt_bias = p.in[9];
    const float* SM = (const float*)(p.ws + WS_SMALL);
    bf16* DW = (bf16*)(p.ws + WS_DW); bf16* DQG = (bf16*)(p.ws + WS_DQG); bf16* DKDT = (bf16*)(p.ws + WS_DKDT); bf16* DATT = (bf16*)(p.ws + WS_DATT);
    float* DU = (float*)(p.ws + WS_DU); float* DEGL = (float*)(p.ws + WS_DEGL);
    constexpr int O_KN = 0, O_QS = 16384, O_KD = 32768, O_AM = 50176, O_RHS = 66560, O_GC = 132096;
    LAS float* AM = (LAS float*)(lds + O_AM); LAS float* RHS = (LAS float*)(lds + O_RHS); LAS float* GC = (LAS float*)(lds + O_GC);
    LAS unsigned short* KD = (LAS unsigned short*)(lds + O_KD);
    const float qscale = 0.08838834764831845f;
    for (int item = bid; item < 1024; item += nb) {
        const int b = item >> 7, h = (item >> 5) & 3, n = item & 31, t0 = b * NS_ + n * 64, tl0 = n * 64;
        if (wave == 0) {
            const int t = t0 + lane;
            const float bl = SM[(size_t)t * 8 + h], al = SM[(size_t)t * 8 + 4 + h];
            const float beta = sigmoidf_(bl);
            const float xx = al + dt_bias[h];
            const float sp = xx > 20.f ? xx : log1pf(expf(xx));
            float gc = -expf(a_log[h]) * sp;
#pragma unroll
            for (int o = 1; o < 64; o <<= 1) { const float y = __shfl_up(gc, o); if (lane >= o) gc += y; }
            const float glast = __shfl(gc, 63);
            GC[lane] = gc; GC[64 + lane] = beta; GC[128 + lane] = expf(gc); GC[192 + lane] = expf(glast - gc);
            if (lane == 63) DEGL[item] = expf(gc);
        }
        __syncthreads();
        {
            const int r = tid >> 3, seg = tid & 7;
            const float beta = GC[64 + r], egc = GC[128 + r], edec = GC[192 + r];
            float v3[3][16];
#pragma unroll
            for (int part = 0; part < 3; ++part) {
                const int ch = part * 512 + h * 128 + seg * 16;
#pragma unroll
                for (int i = 0; i < 16; ++i) v3[part][i] = 0.f;
#pragma unroll
                for (int j = 0; j < 4; ++j) {
                    const bool ok = tl0 + r - 3 + j >= 0;
                    const size_t srow = (size_t)(ok ? t0 + r - 3 + j : t0);
                    const u32x4_t x0 = *(const u32x4_t*)(PROJ + srow * PJ + ch), x1 = *(const u32x4_t*)(PROJ + srow * PJ + ch + 8);
                    const unsigned xs[8] = {x0.x, x0.y, x0.z, x0.w, x1.x, x1.y, x1.z, x1.w};
#pragma unroll
                    for (int i = 0; i < 8; ++i) { float2 w = *(const float2*)(cw + j * 1536 + ch + 2 * i); if (!ok) { w.x = 0.f; w.y = 0.f; } v3[part][2 * i] += w.x * bf2f(xs[i] & 0xffffu); v3[part][2 * i + 1] += w.y * bf2f(xs[i] >> 16); }
                }
                asm volatile("" ::: "memory");
                float ss = 0.f;
#pragma unroll
                for (int i = 0; i < 16; ++i) { v3[part][i] = siluf_(v3[part][i]); ss += v3[part][i] * v3[part][i]; }
                if (part < 2) {
                    ss += __shfl_xor(ss, 1); ss += __shfl_xor(ss, 2); ss += __shfl_xor(ss, 4);
                    const float rn = rsqrtf(ss + EPS);
#pragma unroll
                    for (int i = 0; i < 16; ++i) v3[part][i] *= rn;
                }
            }
            {
                u32x4_t a0, a1, g0, g1; const float* q = v3[0]; const float s = qscale, sg = qscale * egc;
                a0.x = pk2bf(q[0] * s, q[1] * s); a0.y = pk2bf(q[2] * s, q[3] * s); a0.z = pk2bf(q[4] * s, q[5] * s); a0.w = pk2bf(q[6] * s, q[7] * s);
                a1.x = pk2bf(q[8] * s, q[9] * s); a1.y = pk2bf(q[10] * s, q[11] * s); a1.z = pk2bf(q[12] * s, q[13] * s); a1.w = pk2bf(q[14] * s, q[15] * s);
                g0.x = pk2bf(q[0] * sg, q[1] * sg); g0.y = pk2bf(q[2] * sg, q[3] * sg); g0.z = pk2bf(q[4] * sg, q[5] * sg); g0.w = pk2bf(q[6] * sg, q[7] * sg);
                g1.x = pk2bf(q[8] * sg, q[9] * sg); g1.y = pk2bf(q[10] * sg, q[11] * sg); g1.z = pk2bf(q[12] * sg, q[13] * sg); g1.w = pk2bf(q[14] * sg, q[15] * sg);
                *(LAS u32x4_t*)(lds + O_QS + lds_off16(r, 2 * seg)) = a0; *(LAS u32x4_t*)(lds + O_QS + lds_off16(r, 2 * seg + 1)) = a1;
                bf16* dst = DQG + (size_t)item * 8192 + r * 128 + seg * 16; *(u32x4_t*)dst = g0; *(u32x4_t*)(dst + 8) = g1;
            }
            {
                u32x4_t a0, a1; const float* k = v3[1];
                a0.x = pk2bf(k[0], k[1]); a0.y = pk2bf(k[2], k[3]); a0.z = pk2bf(k[4], k[5]); a0.w = pk2bf(k[6], k[7]);
                a1.x = pk2bf(k[8], k[9]); a1.y = pk2bf(k[10], k[11]); a1.z = pk2bf(k[12], k[13]); a1.w = pk2bf(k[14], k[15]);
                *(LAS u32x4_t*)(lds + O_KN + lds_off16(r, 2 * seg)) = a0; *(LAS u32x4_t*)(lds + O_KN + lds_off16(r, 2 * seg + 1)) = a1;
                u32x4_t d0, d1;
                d0.x = pk2bf(k[0] * edec, k[1] * edec); d0.y = pk2bf(k[2] * edec, k[3] * edec); d0.z = pk2bf(k[4] * edec, k[5] * edec); d0.w = pk2bf(k[6] * edec, k[7] * edec);
                d1.x = pk2bf(k[8] * edec, k[9] * edec); d1.y = pk2bf(k[10] * edec, k[11] * edec); d1.z = pk2bf(k[12] * edec, k[13] * edec); d1.w = pk2bf(k[14] * edec, k[15] * edec);
                *(LAS u32x4_t*)(KD + r * 136 + seg * 16) = d0; *(LAS u32x4_t*)(KD + r * 136 + seg * 16 + 8) = d1;
                const float bw = beta * egc;
#pragma unroll
                for (int i = 0; i < 4; ++i) *(LAS f32x4*)(RHS + r * 256 + 128 + seg * 16 + 4 * i) = (f32x4){k[4 * i] * bw, k[4 * i + 1] * bw, k[4 * i + 2] * bw, k[4 * i + 3] * bw};
            }
            {
                const float* v = v3[2];
#pragma unroll
                for (int i = 0; i < 4; ++i) *(LAS f32x4*)(RHS + r * 256 + seg * 16 + 4 * i) = (f32x4){v[4 * i] * beta, v[4 * i + 1] * beta, v[4 * i + 2] * beta, v[4 * i + 3] * beta};
            }
        }
        __syncthreads();
        {
            const int rb = wave & 3;
            bf16x8_t xf[4];
#pragma unroll
            for (int s4 = 0; s4 < 4; ++s4) xf[s4] = ldfrag(lds + O_KN + lds_off16(16 * rb + fr, 4 * s4 + fq));
#pragma unroll
            for (int cb = 0; cb < 4; ++cb) {
                f32x4 acc = {0.f, 0.f, 0.f, 0.f};
                const int yoff = (wave < 4) ? O_KN : O_QS;
#pragma unroll
                for (int s4 = 0; s4 < 4; ++s4) { const bf16x8_t yf = ldfrag(lds + yoff + lds_off16(16 * cb + fr, 4 * s4 + fq)); acc = __builtin_amdgcn_mfma_f32_16x16x32_bf16(xf[s4], yf, acc, 0, 0, 0); }
                const int xr0 = 16 * rb + 4 * fq, yr = 16 * cb + fr;
                const f32x4 gx = *(const LAS f32x4*)(GC + xr0); const float gy = GC[yr];
                if (wave < 4) {
                    const f32x4 bx = *(const LAS f32x4*)(GC + 64 + xr0);
                    f32x4 o;
#pragma unroll
                    for (int r = 0; r < 4; ++r) { const bool m = xr0 + r > yr; const float dec = __expf(m ? gx[r] - gy : 0.f); o[r] = m ? bx[r] * acc[r] * dec : 0.f; }
                    *(LAS f32x4*)(AM + ((xr0 >> 2) * 64 + yr) * 4) = o;
                } else {
                    float o[4];
#pragma unroll
                    for (int r = 0; r < 4; ++r) { const bool m = yr >= xr0 + r; const float dec = __expf(m ? gy - gx[r] : 0.f); o[r] = m ? acc[r] * dec : 0.f; }
                    u32x2_t w; w.x = pk2bf(o[0], o[1]); w.y = pk2bf(o[2], o[3]);
                    *(u32x2_t*)(DATT + (size_t)item * 4096 + yr * 64 + xr0) = w;
                }
            }
        }
        __syncthreads();
        if (tid < 256) {
            const int c = tid;
            float x[64];
#pragma unroll
            for (int blk = 0; blk < 16; ++blk) {
                float s0 = RHS[(4 * blk + 0) * 256 + c], s1 = RHS[(4 * blk + 1) * 256 + c], s2 = RHS[(4 * blk + 2) * 256 + c], s3 = RHS[(4 * blk + 3) * 256 + c];
#pragma unroll
                for (int j0 = 0; j0 < 4 * blk; j0 += 16) {
                    f32x4 a[16];
#pragma unroll
                    for (int q = 0; q < 16; ++q) if (j0 + q < 4 * blk) a[q] = *(const LAS f32x4*)(AM + (blk * 64 + j0 + q) * 4);
#pragma unroll
                    for (int q = 0; q < 16; ++q) if (j0 + q < 4 * blk) { const float xv = x[j0 + q]; s0 -= a[q][0] * xv; s1 -= a[q][1] * xv; s2 -= a[q][2] * xv; s3 -= a[q][3] * xv; }
                }
                const f32x4 t0 = *(const LAS f32x4*)(AM + (blk * 64 + 4 * blk) * 4), t1 = *(const LAS f32x4*)(AM + (blk * 64 + 4 * blk + 1) * 4), t2 = *(const LAS f32x4*)(AM + (blk * 64 + 4 * blk + 2) * 4);
                x[4 * blk] = s0;
                s1 -= t0[1] * s0; s2 -= t0[2] * s0; s3 -= t0[3] * s0;
                x[4 * blk + 1] = s1;
                s2 -= t1[2] * s1; s3 -= t1[3] * s1;
                x[4 * blk + 2] = s2;
                s3 -= t2[3] * s2;
                x[4 * blk + 3] = s3;
            }
            if (c < 128) {
#pragma unroll
                for (int i = 0; i < 64; ++i) DU[(size_t)item * 8192 + i * 128 + c] = x[i];
            } else {
#pragma unroll
                for (int i = 0; i < 64; ++i) DW[(size_t)item * 8192 + i * 128 + (c - 128)] = (bf16)f2bf(x[i]);
            }
        } else {
            const int tt = tid - 256, d = tt >> 1, c0 = (tt & 1) * 32;
            unsigned w[16];
#pragma unroll
            for (int i = 0; i < 16; ++i) w[i] = (unsigned)KD[(c0 + 2 * i) * 136 + d] | ((unsigned)KD[(c0 + 2 * i + 1) * 136 + d] << 16);
            bf16* dst = DKDT + (size_t)item * 8192 + d * 64 + c0;
#pragma unroll
            for (int i = 0; i < 4; ++i) *(u32x4_t*)(dst + 8 * i) = (u32x4_t){w[4 * i], w[4 * i + 1], w[4 * i + 2], w[4 * i + 3]};
        }
        __syncthreads();
    }
}

__device__ void ph_dnscan(const Params& p, LAS unsigned char* lds, int sbid, int nsb) {
    int tid_ = threadIdx.x; asm volatile("" : "+v"(tid_));
    const int tid = tid_, lane = tid & 63, wave = __builtin_amdgcn_readfirstlane(tid >> 6), fr = lane & 15, fq = lane >> 4;
    const bf16* DW = (const bf16*)(p.ws + WS_DW); const bf16* DQG = (const bf16*)(p.ws + WS_DQG); const bf16* DKDT = (const bf16*)(p.ws + WS_DKDT); const bf16* DATT = (const bf16*)(p.ws + WS_DATT);
    const float* DU = (const float*)(p.ws + WS_DU); const float* DEGL = (const float*)(p.ws + WS_DEGL);
    float* ORAW = (float*)(p.ws + WS_ORAW);
    constexpr int BUF = 57344, O_W = 0, O_QG = 16384, O_KDT = 32768, O_ATT = 49152, O_SB = 114688, O_VNT = 131072;
    const int cb = wave >> 1, eb = wave & 1;
    for (int it = sbid; it < 128; it += nsb) {
        const int bh = (it & 7) * 4 + (it >> 5), es = (it >> 3) & 3, b = bh >> 2, h = bh & 3, e0 = es * 32, item0 = bh * 32;
        f32x4 st[2] = {{0.f, 0.f, 0.f, 0.f}, {0.f, 0.f, 0.f, 0.f}};
        *(LAS u32x4_t*)(lds + O_SB + tid * 16) = (u32x4_t){0u, 0u, 0u, 0u};
        u32x4_t rg[7]; float un[4]; float egl_n;
#define DN_LOAD(itm) do { const size_t _o = (size_t)(itm) * 8192; \
            rg[0] = *(const u32x4_t*)(DW + _o + (size_t)tid * 8); rg[1] = *(const u32x4_t*)(DW + _o + (size_t)(tid + 512) * 8); \
            rg[2] = *(const u32x4_t*)(DQG + _o + (size_t)tid * 8); rg[3] = *(const u32x4_t*)(DQG + _o + (size_t)(tid + 512) * 8); \
            rg[4] = *(const u32x4_t*)(DKDT + _o + (size_t)tid * 8); rg[5] = *(const u32x4_t*)(DKDT + _o + (size_t)(tid + 512) * 8); \
            rg[6] = *(const u32x4_t*)(DATT + (size_t)(itm) * 4096 + (size_t)tid * 8); \
            _Pragma("unroll") for (int _r = 0; _r < 4; ++_r) un[_r] = DU[_o + (size_t)(16 * cb + 4 * fq + _r) * 128 + e0 + 16 * eb + fr]; \
            egl_n = DEGL[(itm)]; } while (0)
#define DN_STORE(bufo) do { LAS unsigned char* _b = lds + (bufo); \
            *(LAS u32x4_t*)(_b + O_W + lds_off16(tid >> 4, tid & 15)) = rg[0]; *(LAS u32x4_t*)(_b + O_W + lds_off16((tid + 512) >> 4, tid & 15)) = rg[1]; \
            *(LAS u32x4_t*)(_b + O_QG + lds_off16(tid >> 4, tid & 15)) = rg[2]; *(LAS u32x4_t*)(_b + O_QG + lds_off16((tid + 512) >> 4, tid & 15)) = rg[3]; \
            *(LAS u32x4_t*)(_b + O_KDT + lds_off8(tid >> 3, tid & 7)) = rg[4]; *(LAS u32x4_t*)(_b + O_KDT + lds_off8((tid + 512) >> 3, tid & 7)) = rg[5]; \
            *(LAS u32x4_t*)(_b + O_ATT + lds_off8(tid >> 3, tid & 7)) = rg[6]; } while (0)
        DN_LOAD(item0);
        DN_STORE(0);
        float u[4] = {un[0], un[1], un[2], un[3]}; float egl = egl_n;
        __syncthreads();
        for (int n = 0; n < 32; ++n) {
            const int bufo = (n & 1) * BUF, sbo = O_SB + (n & 1) * 8192, sbn = O_SB + ((n + 1) & 1) * 8192;
            if (n < 31) DN_LOAD(item0 + n + 1);
            f32x4 acc = {0.f, 0.f, 0.f, 0.f};
            bf16x8_t sf[4];
#pragma unroll
            for (int s4 = 0; s4 < 4; ++s4) sf[s4] = ldfrag(lds + sbo + lds_off16(16 * eb + fr, 4 * s4 + fq));
#pragma unroll
            for (int s4 = 0; s4 < 4; ++s4) acc = __builtin_amdgcn_mfma_f32_16x16x32_bf16(ldfrag(lds + bufo + O_W + lds_off16(16 * cb + fr, 4 * s4 + fq)), sf[s4], acc, 0, 0, 0);
            {
                const float v0 = u[0] - acc[0], v1 = u[1] - acc[1], v2 = u[2] - acc[2], v3 = u[3] - acc[3];
                u32x2_t w; w.x = pk2bf(v0, v1); w.y = pk2bf(v2, v3);
                *(LAS u32x2_t*)(lds + O_VNT + lds_off8(16 * eb + fr, 2 * cb + (fq >> 1)) + 8 * (fq & 1)) = w;
            }
            __syncthreads();
            f32x4 oacc = {0.f, 0.f, 0.f, 0.f};
#pragma unroll
            for (int s4 = 0; s4 < 4; ++s4) oacc = __builtin_amdgcn_mfma_f32_16x16x32_bf16(ldfrag(lds + bufo + O_QG + lds_off16(16 * cb + fr, 4 * s4 + fq)), sf[s4], oacc, 0, 0, 0);
            bf16x8_t vf[2][2];
#pragma unroll
            for (int e2 = 0; e2 < 2; ++e2)
#pragma unroll
                for (int s2 = 0; s2 < 2; ++s2) vf[e2][s2] = ldfrag(lds + O_VNT + lds_off8(16 * e2 + fr, 4 * s2 + fq));
#pragma unroll
            for (int s2 = 0; s2 < 2; ++s2) oacc = __builtin_amdgcn_mfma_f32_16x16x32_bf16(ldfrag(lds + bufo + O_ATT + lds_off8(16 * cb + fr, 4 * s2 + fq)), ldfrag(lds + O_VNT + lds_off8(16 * eb + fr, 4 * s2 + fq)), oacc, 0, 0, 0);
            {
                const size_t t0 = (size_t)b * NS_ + n * 64;
#pragma unroll
                for (int r = 0; r < 4; ++r) ORAW[(t0 + 16 * cb + 4 * fq + r) * 512 + h * 128 + e0 + 16 * eb + fr] = oacc[r];
            }
#pragma unroll
            for (int e2 = 0; e2 < 2; ++e2) {
                st[e2] = st[e2] * egl;
#pragma unroll
                for (int s2 = 0; s2 < 2; ++s2) st[e2] = __builtin_amdgcn_mfma_f32_16x16x32_bf16(ldfrag(lds + bufo + O_KDT + lds_off8(16 * wave + fr, 4 * s2 + fq)), vf[e2][s2], st[e2], 0, 0, 0);
                u32x2_t w; w.x = pk2bf(st[e2][0], st[e2][1]); w.y = pk2bf(st[e2][2], st[e2][3]);
                *(LAS u32x2_t*)(lds + sbn + lds_off16(16 * e2 + fr, 2 * wave + (fq >> 1)) + 8 * (fq & 1)) = w;
            }
            if (n < 31) { DN_STORE(((n + 1) & 1) * BUF); u[0] = un[0]; u[1] = un[1]; u[2] = un[2]; u[3] = un[3]; egl = egl_n; }
            __syncthreads();
        }
#undef DN_LOAD
#undef DN_STORE
    }
}

__device__ void ph_mixed(const Params& p, int bid, int nb) {
    const int tid = opaque_tid(), lane = tid & 63, wave = tid >> 6;
    const float* ORAW = (const float*)(p.ws + WS_ORAW); const bf16* PROJ = (const bf16*)(p.ws + WS_PROJ); const float* nw = p.in[10];
    bf16* MIXED = (bf16*)(p.ws + WS_MIXED);
    for (int t = bid * 8 + wave; t < T_; t += nb * 8) {
#pragma unroll
        for (int hh = 0; hh < 4; ++hh) {
            const float2 o = *(const float2*)(ORAW + (size_t)t * 512 + hh * 128 + 2 * lane);
            const float ss = wave_sum(o.x * o.x + o.y * o.y);
            const float r = rsqrtf(ss * (1.f / 128.f) + EPS);
            const unsigned zz = *(const unsigned*)(PROJ + (size_t)t * PJ + 1536 + hh * 128 + 2 * lane);
            const float m0 = o.x * r * nw[2 * lane] * siluf_(bf2f(zz & 0xffffu)), m1 = o.y * r * nw[2 * lane + 1] * siluf_(bf2f(zz >> 16));
            *(unsigned*)(MIXED + (size_t)t * D_ + hh * 128 + 2 * lane) = f2bf(m0) | (f2bf(m1) << 16);
        }
    }
}

__device__ void ph_cf(const Params& p, LAS float* lds, int bid, int nb) {
    const int tid = opaque_tid(), lane = tid & 63, wave = tid >> 6;
    const bf16* PROJ = (const bf16*)(p.ws + WS_PROJ);
    const float* pwb = p.in[11]; const float* dww = p.in[12]; const float* dwb = p.in[13]; const float* lnw = p.in[14]; const float* lnb = p.in[15];
    bf16* MIXED = (bf16*)(p.ws + WS_MIXED);
    constexpr int TT = 32;
    const int c = tid;
    float w[CFK];
#pragma unroll
    for (int j = 0; j < CFK; ++j) w[j] = dww[j * CFW + c];
    const float ba = pwb[c], bg = pwb[512 + c], cb = dwb[c];
    for (int it = bid; it < T_ / TT; it += nb) {
        const int t0 = it * TT, tl0 = t0 % NS_;
        float xg[TT + CFK - 1];
#pragma unroll
        for (int i = 0; i < TT + CFK - 1; ++i) {
            const int tl = tl0 - (CFK - 1) + i;
            const size_t row = (size_t)(t0 - (CFK - 1) + i + (tl < 0 ? -tl : 0));
            const float a = bf2f(PROJ[row * PJ + 2048 + c]) + ba, gt = bf2f(PROJ[row * PJ + 2560 + c]) + bg;
            const float g = a * sigmoidf_(gt);
            xg[i] = tl >= 0 ? g : 0.f;
            if ((i & 15) == 15) asm volatile("" ::: "memory");
        }
        __syncthreads();
#pragma unroll
        for (int r = 0; r < TT; ++r) {
            float s = cb;
#pragma unroll
            for (int j = 0; j < CFK; ++j) s += w[j] * xg[r + j];
            lds[r * 512 + c] = s;
        }
        __syncthreads();
#pragma unroll
        for (int rr = 0; rr < 4; ++rr) {
            const int r = wave * 4 + rr;
            float v[8]; float s = 0.f;
#pragma unroll
            for (int j = 0; j < 8; ++j) { v[j] = lds[r * 512 + lane + 64 * j]; s += v[j]; }
            const float mu = wave_sum(s) * (1.f / 512.f);
            float q = 0.f;
#pragma unroll
            for (int j = 0; j < 8; ++j) { v[j] -= mu; q += v[j] * v[j]; }
            const float rstd = rsqrtf(wave_sum(q) * (1.f / 512.f) + EPS);
#pragma unroll
            for (int j = 0; j < 8; ++j) { const int cc = lane + 64 * j; const float y = v[j] * rstd * lnw[cc] + lnb[cc]; MIXED[(size_t)(t0 + r) * D_ + 512 + cc] = (bf16)f2bf(siluf_(y)); }
        }
    }
}

__device__ __forceinline__ void ph_outproj(const Params& p, LAS unsigned char* lds, int bid, int nb) {
    pg8::DenseSched S; S.init(p.ws + WS_MIXED, p.ws + WS_WOUTT, T_, D_, D_, nb, bid);
    pg8::EpiF32 E{(float*)(p.ws + WS_HMIX), D_};
    pg8::gemm_phase(lds, S, E);
}

__device__ __forceinline__ void row2_front(const Params& p, LAS unsigned char* lds, int t, int lr, int lane, const f32x4 (&hm)[4], const f32x4 (&xv)[4]) {
    const float* npost = p.in[5]; const float* npre = p.in[17];
    const float* mod = (const float*)(p.ws + WS_MOD) + (t / NS_) * 6144; bf16* H2 = (bf16*)(p.ws + WS_H);
    float ss = 0.f;
#pragma unroll
    for (int j = 0; j < 4; ++j) ss += hm[j][0] * hm[j][0] + hm[j][1] * hm[j][1] + hm[j][2] * hm[j][2] + hm[j][3] * hm[j][3];
    ss = wave_sum(ss);
    const float r1 = rsqrtf(ss * (1.f / D_) + EPS);
    f32x4 x1[4]; float s2 = 0.f;
#pragma unroll
    for (int j = 0; j < 4; ++j) {
        const int c0 = 4 * lane + 256 * j;
        x1[j] = xv[j] + *(const f32x4*)(mod + 2048 + c0) * (hm[j] * r1 * *(const f32x4*)(npost + c0));
        s2 += x1[j][0] * x1[j][0] + x1[j][1] * x1[j][1] + x1[j][2] * x1[j][2] + x1[j][3] * x1[j][3];
        *(f32x4*)(p.out + (size_t)t * D_ + c0) = x1[j];
    }
    s2 = wave_sum(s2);
    const float r2 = rsqrtf(s2 * (1.f / D_) + EPS);
#pragma unroll
    for (int j = 0; j < 4; ++j) {
        const int c0 = 4 * lane + 256 * j;
        const f32x4 h = x1[j] * r2 * *(const f32x4*)(npre + c0) * (*(const f32x4*)(mod + 4096 + c0) + 1.f) + *(const f32x4*)(mod + 3072 + c0);
        unsigned hi[4]; float lo[4];
#pragma unroll
        for (int i = 0; i < 4; ++i) { hi[i] = f2bf(h[i]); lo[i] = h[i] - bf2f(hi[i]); }
        u32x2_t wh; wh.x = hi[0] | (hi[1] << 16); wh.y = hi[2] | (hi[3] << 16);
        u32x2_t wl; wl.x = pk2bf(lo[0], lo[1]); wl.y = pk2bf(lo[2], lo[3]);
        *(u32x2_t*)(H2 + (size_t)t * D_ + c0) = wh;
        const int ch = c0 >> 3, off = lr * 2048 + ((ch ^ (lr & 15)) << 4) + (c0 & 7) * 2;
        *(LAS u32x2_t*)(lds + off) = wh; *(LAS u32x2_t*)(lds + 65536 + off) = wl;
    }
}
__device__ void ph_row2(const Params& p, LAS unsigned char* lds, int bid, int nb) {
    const int tid = opaque_tid(), lane = tid & 63, wave = __builtin_amdgcn_readfirstlane(tid >> 6), fr = lane & 15, fq = lane >> 4;
    const float* x = p.in[0]; const float* brg = p.in[20]; const float* bre = p.in[22];
    const float* HMIX = (const float*)(p.ws + WS_HMIX);
    const bf16* WRTH = (const bf16*)(p.ws + WS_WRTH); const bf16* WRTL = (const bf16*)(p.ws + WS_WRTL);
    int* ROUTE = (int*)(p.ws + WS_ROUTE); int* POS = (int*)(p.ws + WS_POS); int* TOKL = (int*)(p.ws + WS_TOKL); float* WL = (float*)(p.ws + WS_WL);
    unsigned* cnt = (unsigned*)(p.ws + WS_CTL) + CW_CNT;
    LAS float* PART = (LAS float*)lds;
    LAS float* LOG = (LAS float*)(lds + 131072);
    LAS int* rte = (LAS int*)(lds + 131072 + 10240); LAS int* rtr = rte + 128; LAS float* rtw = (LAS float*)(rtr + 128); LAS int* lcnt = (LAS int*)(rtw + 128); LAS int* lbase = lcnt + 64;
    if (tid < 64) lcnt[tid] = 0;
    __syncthreads();
    for (int chunk = bid; chunk < T_ / 64; chunk += nb) {
#pragma unroll 1
        for (int pass = 0; pass < 2; ++pass) {
            const int tb = chunk * 64 + pass * 32 + wave * 4;
            f32x4 hmA[4], xvA[4], hmB[4], xvB[4];
#define R2_LOAD(hm, xv, t) do { _Pragma("unroll") for (int j = 0; j < 4; ++j) { hm[j] = *(const f32x4*)(HMIX + (size_t)(t) * D_ + 4 * lane + 256 * j); xv[j] = *(const f32x4*)(x + (size_t)(t) * D_ + 4 * lane + 256 * j); } } while (0)
            R2_LOAD(hmA, xvA, tb); R2_LOAD(hmB, xvB, tb + 1);
            row2_front(p, lds, tb, wave * 4, lane, hmA, xvA);
            R2_LOAD(hmA, xvA, tb + 2);
            row2_front(p, lds, tb + 1, wave * 4 + 1, lane, hmB, xvB);
            R2_LOAD(hmB, xvB, tb + 3);
            row2_front(p, lds, tb + 2, wave * 4 + 2, lane, hmA, xvA);
            row2_front(p, lds, tb + 3, wave * 4 + 3, lane, hmB, xvB);
#undef R2_LOAD
            __syncthreads();
            f32x4 acc[2][5];
#pragma unroll
            for (int mb = 0; mb < 2; ++mb)
#pragma unroll
                for (int n5 = 0; n5 < 5; ++n5) acc[mb][n5] = (f32x4){0.f, 0.f, 0.f, 0.f};
#pragma unroll
            for (int s4 = 0; s4 < 4; ++s4) {
                const int ks = wave * 4 + s4;
                bf16x8_t ah[2], al[2];
#pragma unroll
                for (int mb = 0; mb < 2; ++mb) { const int r = 16 * mb + fr, off = r * 2048 + (((4 * ks + fq) ^ (r & 15)) << 4); ah[mb] = ldfrag(lds + off); al[mb] = ldfrag(lds + 65536 + off); }
#pragma unroll
                for (int n5 = 0; n5 < 5; ++n5) {
                    const bf16x8_t bh = *(const bf16x8_t*)(WRTH + (size_t)(16 * n5 + fr) * 1024 + ks * 32 + fq * 8), bl = *(const bf16x8_t*)(WRTL + (size_t)(16 * n5 + fr) * 1024 + ks * 32 + fq * 8);
#pragma unroll
                    for (int mb = 0; mb < 2; ++mb) {
                        acc[mb][n5] = __builtin_amdgcn_mfma_f32_16x16x32_bf16(ah[mb], bh, acc[mb][n5], 0, 0, 0);
                        acc[mb][n5] = __builtin_amdgcn_mfma_f32_16x16x32_bf16(al[mb], bh, acc[mb][n5], 0, 0, 0);
                        acc[mb][n5] = __builtin_amdgcn_mfma_f32_16x16x32_bf16(ah[mb], bl, acc[mb][n5], 0, 0, 0);
                    }
                }
            }
            __syncthreads();
#pragma unroll
            for (int mb = 0; mb < 2; ++mb)
#pragma unroll
                for (int n5 = 0; n5 < 5; ++n5)
#pragma unroll
                    for (int r = 0; r < 4; ++r) PART[(wave * 32 + 16 * mb + 4 * fq + r) * 80 + 16 * n5 + fr] = acc[mb][n5][r];
            __syncthreads();
            for (int i = tid; i < 2560; i += NTHR) { float a = 0.f;
#pragma unroll
                for (int w = 0; w < 8; ++w) a += PART[w * 2560 + i];
                LOG[i] = a; }
            __syncthreads();
            if (tid < 32) {
                const LAS float* lg = LOG + tid * 80;
                float gmax = -3.0e38f; int gi = 0; float gl[8];
#pragma unroll
                for (int o = 0; o < 8; ++o) { gl[o] = lg[o] + brg[o]; if (gl[o] > gmax) { gmax = gl[o]; gi = o; } }
                float gden = 0.f;
#pragma unroll
                for (int o = 0; o < 8; ++o) gden += __expf(gl[o] - gmax);
                const float gp = 1.f / gden;
                float m1 = -3.0e38f, m2 = -3.0e38f; int i1 = 0, i2 = 0; float el[8];
#pragma unroll
                for (int o = 0; o < 8; ++o) el[o] = lg[16 + gi * 8 + o] + bre[gi * 8 + o];
#pragma unroll
                for (int o = 0; o < 8; ++o) { if (el[o] > m1) { m1 = el[o]; i1 = o; } }
#pragma unroll
                for (int o = 0; o < 8; ++o) { if (o != i1 && el[o] > m2) { m2 = el[o]; i2 = o; } }
                const float e2 = __expf(m2 - m1);
                const int lr = pass * 32 + tid, ea = gi * 8 + i1, eb = gi * 8 + i2;
                rte[2 * lr] = ea; rte[2 * lr + 1] = eb;
                rtw[2 * lr] = gp * (1.f / (1.f + e2)); rtw[2 * lr + 1] = gp * (e2 / (1.f + e2));
                rtr[2 * lr] = __hip_atomic_fetch_add(lcnt + ea, 1, __ATOMIC_RELAXED, __HIP_MEMORY_SCOPE_WORKGROUP); rtr[2 * lr + 1] = __hip_atomic_fetch_add(lcnt + eb, 1, __ATOMIC_RELAXED, __HIP_MEMORY_SCOPE_WORKGROUP);
            }
            __syncthreads();
        }
        if (tid < 64) { const int c = lcnt[tid]; lbase[tid] = c > 0 ? (int)atomicAdd(cnt + tid, (unsigned)c) : 0; }
        __syncthreads();
        if (tid < 128) {
            const int e = rte[tid], pos = lbase[e] + rtr[tid], t = chunk * 64 + (tid >> 1);
            ROUTE[(size_t)t * 4 + (tid & 1)] = e; POS[(size_t)t * 2 + (tid & 1)] = pos;
            TOKL[(size_t)e * T_ + pos] = t; WL[(size_t)e * T_ + pos] = rtw[tid];
        }
        __syncthreads();
        if (tid < 64) lcnt[tid] = 0;
        __syncthreads();
    }
}

struct MoeMap { LAS int* tstart; LAS int* cnt; int total_tiles; };
__device__ __forceinline__ MoeMap moe_map(const Params& p, LAS int* l) {
    const unsigned* cnt = (const unsigned*)(p.ws + WS_CTL) + CW_CNT;
    __syncthreads();
    if (threadIdx.x < 64) {
        const int e = threadIdx.x;
        const int c = (int)__hip_atomic_load(cnt + e, __ATOMIC_RELAXED, __HIP_MEMORY_SCOPE_AGENT);
        const int nt = (c + TM - 1) / TM; int incl = nt;
#pragma unroll
        for (int o = 1; o < 64; o <<= 1) { const int y = __shfl_up(incl, o); if (e >= o) incl += y; }
        l[e] = incl - nt; l[128 + e] = c; if (e == 63) l[NE] = incl;
    }
    __syncthreads();
    MoeMap m; m.tstart = l; m.cnt = l + 128; m.total_tiles = l[NE];
    return m;
}
__device__ __forceinline__ int moe_find(const MoeMap& m, int tile) { int e = 0; while (e < NE - 1 && m.tstart[e + 1] <= tile) ++e; return e; }

__device__ __forceinline__ void ph_moe_gu(const Params& p, LAS unsigned char* lds, int bid, int nb) {
    MoeMap mm = moe_map(p, (LAS int*)(lds + pg8::STAGE_BYTES));
    pg8::GroupSched S{(const char*)(p.ws + WS_H), (const char*)(p.ws + WS_WGUT), D_, 4, (size_t)2 * DE * D_ * 2, mm.tstart, mm.cnt, mm.total_tiles, nb, bid, (const int*)(p.ws + WS_TOKL)};
    pg8::EpiGU E{(bf16*)(p.ws + WS_HID)};
    pg8::gemm_phase(lds, S, E);
}
__device__ __forceinline__ void ph_moe_down(const Params& p, LAS unsigned char* lds, int bid, int nb) {
    MoeMap mm = moe_map(p, (LAS int*)(lds + pg8::STAGE_BYTES));
    pg8::GroupSched S{(const char*)(p.ws + WS_HID), (const char*)(p.ws + WS_WDNT), DE, 4, (size_t)D_ * DE * 2, mm.tstart, mm.cnt, mm.total_tiles, nb, bid, nullptr};
    pg8::EpiDown E{(bf16*)(p.ws + WS_Y), (const float*)(p.ws + WS_WL), mm.cnt};
    pg8::gemm_phase(lds, S, E);
}

__device__ void ph_final(const Params& p, LAS float* lds, int bid, int nb) {
    const int tid = opaque_tid(), lane = tid & 63, wave = tid >> 6;
    const float* npf = p.in[18]; const float* mod = (const float*)(p.ws + WS_MOD);
    const bf16* Y = (const bf16*)(p.ws + WS_Y); const int* ROUTE = (const int*)(p.ws + WS_ROUTE); const int* POS = (const int*)(p.ws + WS_POS);
    MoeMap mm = moe_map(p, (LAS int*)lds);
    for (int t = bid * 8 + wave; t < T_; t += nb * 8) {
        const int b = t / NS_;
        const int ea = ROUTE[(size_t)t * 4], eb = ROUTE[(size_t)t * 4 + 1];
        const size_t ga = (size_t)mm.tstart[ea] * TM + POS[(size_t)t * 2], gb = (size_t)mm.tstart[eb] * TM + POS[(size_t)t * 2 + 1];
        float m[16]; float ss = 0.f;
#pragma unroll
        for (int j = 0; j < 4; ++j) {
            const uint2 a = *(const uint2*)(Y + ga * D_ + 4 * lane + 256 * j), bb = *(const uint2*)(Y + gb * D_ + 4 * lane + 256 * j);
            m[4 * j] = bf2f(a.x & 0xffffu) + bf2f(bb.x & 0xffffu); m[4 * j + 1] = bf2f(a.x >> 16) + bf2f(bb.x >> 16);
            m[4 * j + 2] = bf2f(a.y & 0xffffu) + bf2f(bb.y & 0xffffu); m[4 * j + 3] = bf2f(a.y >> 16) + bf2f(bb.y >> 16);
#pragma unroll
            for (int i = 0; i < 4; ++i) ss += m[4 * j + i] * m[4 * j + i];
        }
        ss = wave_sum(ss);
        const float r = rsqrtf(ss * (1.f / D_) + EPS);
#pragma unroll
        for (int j = 0; j < 4; ++j) {
            const int c0 = 4 * lane + 256 * j;
            float4 o = *(float4*)(p.out + (size_t)t * D_ + c0);
            o.x += mod[b * 6144 + 5120 + c0] * (m[4 * j] * r * npf[c0]);
            o.y += mod[b * 6144 + 5120 + c0 + 1] * (m[4 * j + 1] * r * npf[c0 + 1]);
            o.z += mod[b * 6144 + 5120 + c0 + 2] * (m[4 * j + 2] * r * npf[c0 + 2]);
            o.w += mod[b * 6144 + 5120 + c0 + 3] * (m[4 * j + 3] * r * npf[c0 + 3]);
            *(float4*)(p.out + (size_t)t * D_ + c0) = o;
        }
    }
}

constexpr int LDS_BYTES = 147456;
#define XB_TMO      128
#define XB_XCNT(j)  (256  + 64 * (j))
#define XB_XSUB(j)  (1280 + 64 * (j))
#define XB_XGEN(j)  (2304 + 64 * (j))
#define XB_TOP      3328
#define XB_TOPGEN   3392
#define XCD_BAR_WORDS 3456
#define XB_SPIN_CAP (1u << 22)
__device__ __forceinline__ unsigned xb_ld(unsigned* p)              { return __hip_atomic_load(p, __ATOMIC_RELAXED, __HIP_MEMORY_SCOPE_AGENT); }
__device__ __forceinline__ unsigned xb_add(unsigned* p, unsigned v) { return __hip_atomic_fetch_add(p, v, __ATOMIC_RELAXED, __HIP_MEMORY_SCOPE_AGENT); }
__device__ __forceinline__ unsigned xb_xcc_id() { return (unsigned)__builtin_amdgcn_s_getreg((3 << 11) | 20) & 0xFu; }
#define XB_SPIN(cond, bar) do { unsigned _sp = 0; while (cond) { __builtin_amdgcn_s_sleep(1); \
    if ((++_sp & 255u) == 0u) { if (xb_ld(&(bar)[XB_TMO])) break; if (_sp > XB_SPIN_CAP) { atomicAdd(&(bar)[XB_TMO], 1u); break; } } } } while (0)
struct XcdBarrier { unsigned* bar; unsigned x; volatile LAS unsigned* st; };
__device__ __forceinline__ XcdBarrier xcd_barrier_post(unsigned* bar, volatile LAS unsigned* st) {
    XcdBarrier b; b.bar = bar; b.x = xb_xcc_id(); b.st = st;
    if (threadIdx.x == 0) (void)xb_add(&bar[XB_XCNT(b.x)], 1u);
    return b;
}
__device__ __forceinline__ void xcd_barrier_complete(unsigned* bar, unsigned x, unsigned& nloc, unsigned& nx) {
    const unsigned G = gridDim.x * gridDim.y * gridDim.z;
    unsigned sum, cnt, mine, sp = 0u;
    for (;;) {
        sum = 0u; cnt = 0u; mine = 0u;
#pragma unroll
        for (unsigned j = 0; j < 16; ++j) { const unsigned c = xb_ld(&bar[XB_XCNT(j)]); sum += c; cnt += (c > 0u) ? 1u : 0u; mine = (j == x) ? c : mine; }
        if (sum == G) break;
        __builtin_amdgcn_s_sleep(1);
        if ((++sp & 255u) == 0u) { if (xb_ld(&bar[XB_TMO])) break; if (sp > XB_SPIN_CAP) { atomicAdd(&bar[XB_TMO], 1u); break; } }
    }
    nloc = mine > 0u ? mine : 1u; nx = cnt > 0u ? cnt : 1u;
}
__device__ __forceinline__ void xcd_barrier(unsigned char* ws, volatile LAS unsigned* st) {
    XcdBarrier b; b.bar = (unsigned*)(ws + WS_CTL) + 4096; b.x = xb_xcc_id(); b.st = st;
    asm volatile("s_waitcnt vmcnt(0)" ::: "memory");
    __syncthreads();
    if (threadIdx.x == 0) {
        unsigned* bar = b.bar;
        __builtin_amdgcn_s_waitcnt(0);
        unsigned nloc = b.st[0], nx = b.st[1];
        if (nloc == 0u) { xcd_barrier_complete(bar, b.x, nloc, nx); b.st[0] = nloc; b.st[1] = nx; }
        const unsigned old = xb_add(&bar[XB_XSUB(b.x)], 1u);
        const unsigned gen = old / nloc;
        if (old + 1u == (gen + 1u) * nloc) {
            __builtin_amdgcn_fence(__ATOMIC_RELEASE, "agent");
            asm volatile("s_waitcnt vmcnt(0)" ::: "memory");
            const unsigned og = xb_add(&bar[XB_TOP], 1u);
            const unsigned tg = og / nx;
            if (og + 1u == (tg + 1u) * nx) xb_add(&bar[XB_TOPGEN], 1u);
            else XB_SPIN(xb_ld(&bar[XB_TOPGEN]) == tg, bar);
            __builtin_amdgcn_fence(__ATOMIC_ACQUIRE, "agent");
            xb_add(&bar[XB_XGEN(b.x)], 1u);
            asm volatile("s_waitcnt vmcnt(0)" ::: "memory");
        } else {
            XB_SPIN(xb_ld(&bar[XB_XGEN(b.x)]) == gen, bar);
            __builtin_amdgcn_fence(__ATOMIC_ACQUIRE, "agent");
            asm volatile("s_waitcnt vmcnt(0)" ::: "memory");
        }
    }
    __syncthreads();
}
constexpr int CW_BAR = 4096;
constexpr int LDS_ST_OFF = LDS_BYTES - 64;

__global__ void __launch_bounds__(NTHR, 2) mk_all(Params p) {
    extern __shared__ __attribute__((aligned(16))) unsigned char lds_raw[];
    LAS float* lds = (LAS float*)lds_raw;
    const int bid = blockIdx.x, nb = gridDim.x;
    volatile LAS unsigned* st = (volatile LAS unsigned*)((LAS unsigned char*)lds_raw + LDS_ST_OFF);
    if (threadIdx.x < 16) st[threadIdx.x] = 0u;
    __syncthreads();
    (void)xcd_barrier_post((unsigned*)(p.ws + WS_CTL) + CW_BAR, st);
#ifndef STAMP_SEL
#define STAMP_SEL -1
#endif
    unsigned long long t_prev = 0, dt_sel = 0;
    if (STAMP_SEL >= 0) t_prev = __builtin_amdgcn_s_memrealtime();
#define STAMP(k) do { if (STAMP_SEL >= 0) { const unsigned long long now_ = __builtin_amdgcn_s_memrealtime(); if ((k) == STAMP_SEL && bid == 0) dt_sel = now_ - t_prev; t_prev = now_; } } while (0)
    ph_wprep(p, lds, bid, nb); __syncthreads();
    ph_mod(p, lds, bid, nb);            xcd_barrier(p.ws, st); STAMP(0);
    ph_h(p, lds, bid, nb);              xcd_barrier(p.ws, st); STAMP(1);
    ph_proj(p, (LAS unsigned char*)lds_raw, bid, nb);           xcd_barrier(p.ws, st); STAMP(2);
    ph_dnprep(p, (LAS unsigned char*)lds_raw, bid, nb);    xcd_barrier(p.ws, st); STAMP(3);
    {
        constexpr int CONV_ITEMS = NE * ((D_ / 64) * (2 * DE / 128) + (DE / 64) * (D_ / 128)), CONV_SPLIT = (CONV_ITEMS * 6 / 10) & ~7;
        if (bid < nb / 2) { ph_dnscan(p, (LAS unsigned char*)lds_raw, bid, nb / 2); ph_wprep_experts(p, bid, nb / 2, 0, CONV_SPLIT); }
        else { ph_cf(p, lds, bid - nb / 2, nb - nb / 2); ph_wprep_experts(p, bid - nb / 2, nb - nb / 2, CONV_SPLIT, CONV_ITEMS); }
    }
    if (STAMP_SEL == 40 && bid == 0) { const unsigned long long now_ = __builtin_amdgcn_s_memrealtime(); dt_sel = now_ - t_prev; }
    xcd_barrier(p.ws, st); STAMP(4);
    ph_mixed(p, bid, nb);               xcd_barrier(p.ws, st); STAMP(5);
    ph_outproj(p, (LAS unsigned char*)lds_raw, bid, nb);        xcd_barrier(p.ws, st); STAMP(6);
    ph_row2(p, (LAS unsigned char*)lds_raw, bid, nb);           xcd_barrier(p.ws, st); STAMP(7);
    ph_moe_gu(p, (LAS unsigned char*)lds_raw, bid, nb);      xcd_barrier(p.ws, st); STAMP(8);
    ph_moe_down(p, (LAS unsigned char*)lds_raw, bid, nb);    xcd_barrier(p.ws, st); STAMP(9);
    ph_final(p, lds, bid, nb);
    if (STAMP_SEL >= 0) {
        __syncthreads(); STAMP(10);
        { const unsigned long long t0 = __builtin_amdgcn_s_memrealtime(); while (__builtin_amdgcn_s_memrealtime() - t0 < 8ull * dt_sel) __builtin_amdgcn_s_sleep(8); }
    }
}

extern "C" void kernel_launch(void* const* d_in, const int* in_sizes, int n_in, void* d_out, int out_size, void* d_ws, size_t ws_size, hipStream_t stream) {
    static int inited = 0;
    if (!inited) {
        if (n_in != 26 || out_size != T_ * D_ || ws_size < WS_END) { fprintf(stderr, "kernel_launch: unexpected shapes n_in %d out %d ws %zu\n", n_in, out_size, ws_size); inited = -1; return; }
        if (hipFuncSetAttribute((const void*)mk_all, hipFuncAttributeMaxDynamicSharedMemorySize, LDS_BYTES) != hipSuccess) { fprintf(stderr, "hipFuncSetAttribute failed\n"); inited = -1; return; }
        inited = 1;
    }
    if (inited < 0) return;
    (void)hipMemsetAsync((char*)d_ws + WS_CTL, 0, 1 * MiB, stream);
    Params p{};
    for (int i = 0; i < 26; ++i) p.in[i] = (const float*)d_in[i];
    p.out = (float*)d_out; p.ws = (unsigned char*)d_ws;
    hipLaunchKernelGGL(mk_all, dim3(256), dim3(NTHR), LDS_BYTES, stream, p);
}
```

```cpp
#include <hip/hip_runtime.h>
#include <cstdio>
#include <cstdint>

#define LAS __attribute__((address_space(3)))
typedef unsigned short bf16;
typedef float f32x4 __attribute__((ext_vector_type(4)));

constexpr int NB_ = 8, NS_ = 2048, D_ = 1024, T_ = NB_ * NS_;
constexpr int DNW = 512, NH = 4, HD = 128;
constexpr int CFW = 512, CFK = 31;
constexpr int INC = 3080;
constexpr int PJ = 3072;
constexpr int NE = 64, DE = 512;
constexpr int NTHR = 512;
constexpr float EPS = 1e-6f;
constexpr int TM = 256;
constexpr int MAXROWS = 2 * T_ + NE * TM;

constexpr size_t MiB = 1u << 20;
constexpr size_t WS_CTL = 0;
constexpr size_t WS_MOD = 1 * MiB;
constexpr size_t WS_SMALL = 1 * MiB + 512 * 1024;
constexpr size_t WS_ROUTE = 2 * MiB;
constexpr size_t WS_POS = 2 * MiB + 512 * 1024;
constexpr size_t WS_TOKL = 3 * MiB;
constexpr size_t WS_WL = 7 * MiB;
constexpr size_t WS_W8T = 11 * MiB;
constexpr size_t WS_WRTH = 12 * MiB;
constexpr size_t WS_WRTL = 12 * MiB + 256 * 1024;
constexpr size_t WS_WINT = 16 * MiB;
constexpr size_t WS_WOUTT = 22 * MiB;
constexpr size_t WS_WGUT = 24 * MiB;
constexpr size_t WS_WDNT = 152 * MiB;
constexpr size_t WS_H = 216 * MiB;
constexpr size_t WS_PROJ = 248 * MiB;
constexpr size_t WS_HMIX = 248 * MiB;
constexpr size_t WS_HID = 248 * MiB;
constexpr size_t WS_DW = 344 * MiB;
constexpr size_t WS_DQG = 360 * MiB;
constexpr size_t WS_DKDT = 376 * MiB;
constexpr size_t WS_DATT = 392 * MiB;
constexpr size_t WS_DU = 400 * MiB;
constexpr size_t WS_DEGL = 432 * MiB;
constexpr size_t WS_Y = 344 * MiB;
constexpr size_t WS_ORAW = 440 * MiB;
constexpr size_t WS_MIXED = 472 * MiB;
constexpr size_t WS_END = 504 * MiB;
constexpr int CW_CNT = 1024;
constexpr int CW_DNF = 2048;

__device__ __forceinline__ unsigned f2bf(float f) { unsigned u = __builtin_bit_cast(unsigned, f); return (u + 0x7fffu + ((u >> 16) & 1u)) >> 16; }
__device__ __forceinline__ float bf2f(unsigned b) { return __builtin_bit_cast(float, b << 16); }
template <int CTRL, int ROWMASK> __device__ __forceinline__ float dpp_f(float v) {
    return __builtin_bit_cast(float, __builtin_amdgcn_update_dpp(0, __builtin_bit_cast(int, v), CTRL, ROWMASK, 0xF, true));
}
__device__ __forceinline__ float wave_sum(float v) {
    v += dpp_f<0xB1, 0xF>(v);
    v += dpp_f<0x4E, 0xF>(v);
    v += dpp_f<0x141, 0xF>(v);
    v += dpp_f<0x140, 0xF>(v);
    v += dpp_f<0x142, 0xA>(v);
    v += dpp_f<0x143, 0xC>(v);
    return __builtin_bit_cast(float, __builtin_amdgcn_readlane(__builtin_bit_cast(int, v), 63));
}
__device__ __forceinline__ float sigmoidf_(float x) { return 1.f / (1.f + __expf(-x)); }
__device__ __forceinline__ float siluf_(float x) { return x / (1.f + __expf(-x)); }

__device__ __forceinline__ int opaque_tid() { int t = threadIdx.x; asm volatile("" : "+v"(t)); return t; }

struct Params {
    const float* in[26];
    float* out;
    unsigned char* ws;
};


namespace pg8 {
#define PG8_LAS __attribute__((address_space(3)))
typedef unsigned short bf16_t;
typedef short bf16x8 __attribute__((ext_vector_type(8)));
typedef float f32x4 __attribute__((ext_vector_type(4)));
typedef unsigned u32x4 __attribute__((ext_vector_type(4)));
typedef unsigned u32x2 __attribute__((ext_vector_type(2)));
constexpr int BM = 256, BK = 64, HALF = 128, HTB = HALF * BK * 2, STAGE_BYTES = 8 * HTB, NXCD = 8, WGM = 8;
__host__ __device__ __forceinline__ int lds_byte(int r, int c) { const int st = (r >> 4) * 2 + (c >> 5), rr = r & 15, cc = c & 31, ob = rr * 64 + cc * 2; return st * 1024 + (ob ^ (((ob >> 9) & 1) << 5)); }
__host__ __device__ __forceinline__ void stage_rc(int b, int& R, int& C) { const int st = b / 1024, sb = b % 1024, swz = sb ^ (((sb >> 9) & 1) << 5); R = (st >> 1) * 16 + swz / 64; C = (st & 1) * 32 + (swz % 64) / 2; }
__host__ __device__ __forceinline__ int perm32(int rho) { const int n = rho >> 4, i = rho & 15; return 8 * (i >> 2) + 4 * n + (i & 3); }
struct Unit { int pm, pn, e, r0; };
__device__ __forceinline__ unsigned cvt_pk_bf16(float lo, float hi) { unsigned r; asm volatile("v_cvt_pk_bf16_f32 %0, %1, %2" : "=v"(r) : "v"(lo), "v"(hi)); return r; }

struct DenseSched {
    const char* A; const char* Bt; int K; int nM, nN, nwg, G, c;
    __device__ void init(const void* A_, const void* Bt_, int M, int N, int K_, int G_, int c_) { A = (const char*)A_; Bt = (const char*)Bt_; K = K_; nM = M / BM; nN = N / BM; nwg = nM * nN; G = G_; c = c_; }
    __device__ bool next(int i, Unit& u) const {
        const long L = (long)i * G + c; if (L >= nwg) return false;
        int wgid = (int)L; { const int q = nwg / NXCD, r = nwg % NXCD, xcd = wgid % NXCD, off = wgid / NXCD; wgid = (xcd < r ? xcd * (q + 1) : r * (q + 1) + (xcd - r) * q) + off; }
        const int nig = WGM * nN, gid = wgid / nig, fm = gid * WGM, gsz = (nM - fm) < WGM ? (nM - fm) : WGM;
        u.pm = fm + ((wgid % nig) % gsz); u.pn = (wgid % nig) / gsz; u.e = 0; u.r0 = 0; return true;
    }
    __device__ __forceinline__ const char* a_base() const { return A; }
    __device__ __forceinline__ const char* b_ptr(const Unit& u) const { return Bt + (size_t)u.pn * BM * K * 2; }
    __device__ __forceinline__ void a_off(const Unit& u, const int (&R)[2], const int (&C)[2], unsigned (&v)[2][2]) const {
#pragma unroll
        for (int h = 0; h < 2; ++h)
#pragma unroll
            for (int i = 0; i < 2; ++i) v[h][i] = (unsigned)(((u.pm * BM + h * HALF + R[i]) * K + C[i]) * 2);
    }
};

struct EpiBf16 {
    static constexpr bool PERM = true;
    bf16_t* O; int ldc;
    __device__ __forceinline__ void operator()(const f32x4 (&acc)[2][2][4][2], const Unit& u, int wr, int wc, int fr, int fq) const {
        const int row0 = u.pm * BM + wr * 64 + fr, col0 = u.pn * BM + wc * 32 + 8 * fq;
#pragma unroll
        for (int ai = 0; ai < 2; ++ai)
#pragma unroll
            for (int m = 0; m < 4; ++m) { bf16_t* rowp = O + (size_t)(row0 + ai * HALF + m * 16) * ldc + col0;
#pragma unroll
                for (int bj = 0; bj < 2; ++bj) { const f32x4 v0 = acc[ai][bj][m][0], v1 = acc[ai][bj][m][1];
                    u32x4 w; w.x = cvt_pk_bf16(v0[0], v0[1]); w.y = cvt_pk_bf16(v0[2], v0[3]); w.z = cvt_pk_bf16(v1[0], v1[1]); w.w = cvt_pk_bf16(v1[2], v1[3]);
                    *(u32x4*)(rowp + bj * HALF) = w; } }
    }
};
struct EpiF32 {
    static constexpr bool PERM = false;
    float* C; int ldc;
    __device__ __forceinline__ void operator()(const f32x4 (&acc)[2][2][4][2], const Unit& u, int wr, int wc, int fr, int fq) const {
        const int row0 = u.pm * BM + wr * 64 + fr, col0 = u.pn * BM + wc * 32 + 4 * fq;
#pragma unroll
        for (int ai = 0; ai < 2; ++ai)
#pragma unroll
            for (int m = 0; m < 4; ++m) { float* rowp = C + (size_t)(row0 + ai * HALF + m * 16) * ldc + col0;
#pragma unroll
                for (int bj = 0; bj < 2; ++bj)
#pragma unroll
                    for (int n = 0; n < 2; ++n) *(f32x4*)(rowp + bj * HALF + n * 16) = acc[ai][bj][m][n]; }
    }
};

struct GroupSched {
    const char* A; const char* Bt; int K; int nN; size_t bstride; LAS int* tstart; LAS int* cnt; int total; int G, c; const int* tokl;
    __device__ __forceinline__ bool next(int i, Unit& u) const {
        const int L = i * G + c; if (L >= total * nN) return false;
        const int tile = L / nN; u.pn = L % nN; int e = 0; while (e < NE - 1 && tstart[e + 1] <= tile) ++e;
        u.e = e; u.pm = tile; u.r0 = (tile - tstart[e]) * BM; return true;
    }
    __device__ __forceinline__ const char* a_base() const { return A; }
    __device__ __forceinline__ const char* b_ptr(const Unit& u) const { return Bt + (size_t)u.e * bstride + (size_t)u.pn * BM * K * 2; }
    __device__ __forceinline__ void a_off(const Unit& u, const int (&R)[2], const int (&C)[2], unsigned (&v)[2][2]) const {
        const int ce = cnt[u.e];
#pragma unroll
        for (int h = 0; h < 2; ++h)
#pragma unroll
            for (int i = 0; i < 2; ++i) {
                const int r = u.r0 + h * HALF + R[i];
                int grow = u.pm * BM + h * HALF + R[i];
                if (tokl) grow = (r < ce) ? tokl[(size_t)u.e * T_ + r] : 0;
                v[h][i] = (unsigned)((grow * K + C[i]) * 2);
            }
    }
};
struct EpiGU {
    static constexpr bool PERM = false;
    bf16_t* HID;
    __device__ __forceinline__ void operator()(const f32x4 (&acc)[2][2][4][2], const Unit& u, int wr, int wc, int fr, int fq) const {
        const int row0 = u.pm * BM + wr * 64 + fr;
#pragma unroll
        for (int ai = 0; ai < 2; ++ai)
#pragma unroll
            for (int m = 0; m < 4; ++m) { bf16_t* rowp = HID + (size_t)(row0 + ai * HALF + m * 16) * DE;
#pragma unroll
                for (int bj = 0; bj < 2; ++bj) { const f32x4 g = acc[ai][bj][m][0], up = acc[ai][bj][m][1];
                    float h[4];
#pragma unroll
                    for (int i = 0; i < 4; ++i) h[i] = g[i] / (1.f + __expf(-g[i])) * up[i];
                    u32x2 w; w.x = cvt_pk_bf16(h[0], h[1]); w.y = cvt_pk_bf16(h[2], h[3]);
                    *(u32x2*)(rowp + 16 * (u.pn * 8 + 4 * bj + wc) + 4 * fq) = w; } }
    }
};
struct EpiDown {
    static constexpr bool PERM = true;
    bf16_t* Y; const float* wl; LAS int* cnt;
    __device__ __forceinline__ void operator()(const f32x4 (&acc)[2][2][4][2], const Unit& u, int wr, int wc, int fr, int fq) const {
        const int rloc = wr * 64 + fr, col0 = u.pn * BM + wc * 32 + 8 * fq, ce = cnt[u.e];
#pragma unroll
        for (int ai = 0; ai < 2; ++ai) {
            float w4[4];
#pragma unroll
            for (int m = 0; m < 4; ++m) { const int r = u.r0 + rloc + ai * HALF + m * 16; w4[m] = wl[(size_t)u.e * T_ + (r < ce ? r : 0)]; }
            asm volatile("" : "+v"(w4[0]), "+v"(w4[1]), "+v"(w4[2]), "+v"(w4[3]));
#pragma unroll
            for (int m = 0; m < 4; ++m) { const int r = u.r0 + rloc + ai * HALF + m * 16;
                if (r < ce) {
                    const float w = w4[m];
                    bf16_t* rowp = Y + (size_t)(u.pm * BM + rloc + ai * HALF + m * 16) * D_ + col0;
#pragma unroll
                    for (int bj = 0; bj < 2; ++bj) { const f32x4 v0 = acc[ai][bj][m][0] * w, v1 = acc[ai][bj][m][1] * w;
                        u32x4 o; o.x = cvt_pk_bf16(v0[0], v0[1]); o.y = cvt_pk_bf16(v0[2], v0[3]); o.z = cvt_pk_bf16(v1[0], v1[1]); o.w = cvt_pk_bf16(v1[2], v1[3]);
                        *(u32x4*)(rowp + bj * HALF) = o; } } }
        }
    }
};

template <class Epi, class Sched>
__device__ __forceinline__ void gemm_phase(PG8_LAS unsigned char* lds, const Sched& S, const Epi& E) {
    int tid_ = threadIdx.x; asm volatile("" : "+v"(tid_));
    const int tid = tid_, wid = __builtin_amdgcn_readfirstlane(tid >> 6), lane = tid & 63, wr = wid >> 2, wc = wid & 3, fr = lane & 15, fq = lane >> 4;
    const int K = S.K, nt = K / BK;
    int sR[2], sC[2]; unsigned voffB[2];
#pragma unroll
    for (int i = 0; i < 2; ++i) { int R, C; stage_rc(tid * 16 + i * 8192, R, C); sR[i] = R; sC[i] = C; const int Rb = Epi::PERM ? ((R & ~31) + perm32(R & 31)) : R; voffB[i] = (unsigned)(Rb * K + C) * 2u; }
    const size_t kstep = (size_t)(BK * 2);
    const size_t hstep = (size_t)HALF * K * 2;
    const unsigned ldsw = (unsigned)wid * 1024u;
    const int aoff = lds_byte(wr * 64 + fr, fq * 8), boff = lds_byte(wc * 32 + fr, fq * 8);
#define PG8_SA(b, h) (((b) * 2 + (h)) * HTB)
#define PG8_SB(b, h) ((4 + (b) * 2 + (h)) * HTB)
#define PG8_STAGE(bufoff, gbase, voff) do { _Pragma("unroll") for (int _i = 0; _i < 2; ++_i) \
        __builtin_amdgcn_global_load_lds((const unsigned*)((const char*)(gbase) + (voff)[_i]), (PG8_LAS unsigned*)(lds + (bufoff) + ldsw + _i * 8192), 16, 0, 0); } while (0)
#define PG8_LDA(dst, b, h) do { _Pragma("unroll") for (int m = 0; m < 4; ++m) _Pragma("unroll") for (int k = 0; k < 2; ++k) dst[m][k] = *(const PG8_LAS bf16x8*)(lds + PG8_SA(b, h) + aoff + m * 2048 + k * 1024); } while (0)
#define PG8_LDB(dst, b, h) do { _Pragma("unroll") for (int n = 0; n < 2; ++n) _Pragma("unroll") for (int k = 0; k < 2; ++k) dst[n][k] = *(const PG8_LAS bf16x8*)(lds + PG8_SB(b, h) + boff + n * 2048 + k * 1024); } while (0)
#define PG8_MMA(ai, bj, At, Bt) do { __builtin_amdgcn_s_setprio(1); _Pragma("unroll") for (int m = 0; m < 4; ++m) _Pragma("unroll") for (int n = 0; n < 2; ++n) _Pragma("unroll") for (int k = 0; k < 2; ++k) \
        acc[ai][bj][m][n] = __builtin_amdgcn_mfma_f32_16x16x32_bf16(Bt[n][k], At[m][k], acc[ai][bj][m][n], 0, 0, 0); __builtin_amdgcn_s_setprio(0); } while (0)
#define PG8_WAIT_V(n) asm volatile("s_waitcnt vmcnt(" #n ")" ::: "memory")
#define PG8_WAIT_L(n) asm volatile("s_waitcnt lgkmcnt(" #n ")" ::: "memory")
#define PG8_BAR __builtin_amdgcn_s_barrier()
#define PG8_SCHED __builtin_amdgcn_sched_barrier(0)
    Unit cur, nxt; int ui = 0;
    if (!S.next(0, cur)) return;
    f32x4 acc[2][2][4][2];
#pragma unroll
    for (int a = 0; a < 2; ++a)
#pragma unroll
        for (int b = 0; b < 2; ++b)
#pragma unroll
            for (int m = 0; m < 4; ++m)
#pragma unroll
                for (int n = 0; n < 2; ++n) acc[a][b][m][n] = (f32x4){0.f, 0.f, 0.f, 0.f};
    bf16x8 At[4][2], B0[2][2], B1[2][2];
    const char* const gA = S.a_base();
    unsigned vC[2][2];
    S.a_off(cur, sR, sC, vC);
    const char* cB = S.b_ptr(cur);
    PG8_STAGE(PG8_SB(0, 0), cB, voffB); PG8_STAGE(PG8_SB(0, 1), cB + hstep, voffB); PG8_STAGE(PG8_SA(0, 0), gA, vC[0]); PG8_STAGE(PG8_SA(0, 1), gA, vC[1]);
    if (wr == 1) PG8_BAR;
    PG8_WAIT_V(2); PG8_BAR;
    PG8_STAGE(PG8_SB(1, 0), cB + kstep, voffB); PG8_STAGE(PG8_SA(1, 0), gA + kstep, vC[0]); PG8_STAGE(PG8_SB(1, 1), cB + hstep + kstep, voffB);
    PG8_WAIT_V(6); PG8_BAR;
    for (;;) {
        const bool has_next = S.next(ui + 1, nxt);
        const char* nB = has_next ? S.b_ptr(nxt) : cB;
        for (int t = 0; t < nt; t += 2) {
            const bool last = (t == nt - 2);
            const char* a1 = gA + (size_t)(t + 1) * kstep;
            const char* a2 = last ? gA : gA + (size_t)(t + 2) * kstep; const char* b2 = last ? nB : cB + (size_t)(t + 2) * kstep;
            const char* a3 = a2 + kstep; const char* b3 = b2 + kstep;
            PG8_LDB(B0, 0, 0); PG8_LDB(B1, 0, 1); PG8_SCHED; PG8_LDA(At, 0, 0); PG8_STAGE(PG8_SA(1, 1), a1, vC[1]);
            PG8_WAIT_V(8); PG8_WAIT_L(0); PG8_BAR; PG8_MMA(0, 0, At, B0); PG8_MMA(0, 1, At, B1); PG8_BAR; PG8_SCHED;
            if (last && has_next) S.a_off(nxt, sR, sC, vC);
            PG8_LDA(At, 0, 1); PG8_STAGE(PG8_SB(0, 0), b2, voffB); PG8_STAGE(PG8_SB(0, 1), b2 + hstep, voffB); PG8_STAGE(PG8_SA(0, 0), a2, vC[0]);
            PG8_WAIT_V(8); PG8_WAIT_L(0); PG8_BAR; PG8_MMA(1, 0, At, B0); PG8_MMA(1, 1, At, B1); PG8_BAR; PG8_SCHED;
            PG8_LDB(B0, 1, 0); PG8_LDB(B1, 1, 1); PG8_SCHED; PG8_LDA(At, 1, 0); PG8_STAGE(PG8_SA(0, 1), a2, vC[1]);
            PG8_WAIT_V(8); PG8_WAIT_L(0); PG8_BAR; PG8_MMA(0, 0, At, B0); PG8_MMA(0, 1, At, B1); PG8_BAR; PG8_SCHED;
            PG8_LDA(At, 1, 1); PG8_STAGE(PG8_SB(1, 0), b3, voffB); PG8_STAGE(PG8_SB(1, 1), b3 + hstep, voffB); PG8_STAGE(PG8_SA(1, 0), a3, vC[0]);
            PG8_WAIT_V(8); PG8_WAIT_L(0); PG8_BAR; PG8_MMA(1, 0, At, B0); PG8_MMA(1, 1, At, B1); PG8_BAR; PG8_SCHED;
        }
        if (wr == 0) PG8_BAR;
        E(acc, cur, wr, wc, fr, fq);
        if (!has_next) break;
#pragma unroll
        for (int a = 0; a < 2; ++a)
#pragma unroll
            for (int b = 0; b < 2; ++b)
#pragma unroll
                for (int m = 0; m < 4; ++m)
#pragma unroll
                    for (int n = 0; n < 2; ++n) acc[a][b][m][n] = (f32x4){0.f, 0.f, 0.f, 0.f};
        cur = nxt; cB = nB; ++ui;
        if (wr == 1) PG8_BAR;
    }
    PG8_WAIT_V(0);
    PG8_BAR;
#undef PG8_SA
#undef PG8_SB
#undef PG8_STAGE
#undef PG8_LDA
#undef PG8_LDB
#undef PG8_MMA
#undef PG8_WAIT_V
#undef PG8_WAIT_L
#undef PG8_BAR
#undef PG8_SCHED
}
}

template <class CM>
__device__ __forceinline__ void transpose_item(const float* W, int ldw, int K, bf16* WT, LAS float* scr, int k0, int n0, int lane, const CM& cmap) {
    const int kb = lane >> 3, ng = lane & 7;
    const float* src = W + cmap(n0 + 4 * ng) + (size_t)(k0 + 8 * kb) * ldw;
    f32x4 v[8];
#pragma unroll
    for (int i = 0; i < 8; ++i) v[i] = *(const f32x4*)(src + (size_t)i * ldw);
#pragma unroll
    for (int q = 0; q < 4; ++q) {
        uint4 o; o.x = f2bf(v[0][q]) | (f2bf(v[1][q]) << 16); o.y = f2bf(v[2][q]) | (f2bf(v[3][q]) << 16); o.z = f2bf(v[4][q]) | (f2bf(v[5][q]) << 16); o.w = f2bf(v[6][q]) | (f2bf(v[7][q]) << 16);
        *(uint4*)(WT + (size_t)(n0 + 4 * ng + q) * K + k0 + 8 * kb) = o;
    }
}
__device__ void ph_wprep(const Params& p, LAS float* lds, int bid, int nb) {
    const int tid = opaque_tid(), lane = tid & 63, wave = tid >> 6;
    LAS float* scr = lds + wave * 4096;
    bf16* WINT = (bf16*)(p.ws + WS_WINT); bf16* WOUTT = (bf16*)(p.ws + WS_WOUTT);
    constexpr int I_IN = (D_ / 64) * (PJ / 32), I_OUT = (D_ / 64) * (D_ / 32);
    for (int it = bid * 8 + wave; it < I_IN + I_OUT; it += nb * 8) {
        if (it < I_IN) { const int kb = it / (PJ / 32), nbk = it % (PJ / 32); transpose_item(p.in[6], INC, D_, WINT, scr, 64 * kb, 32 * nbk, lane, [](int n) { return n < 2048 ? n : n + 8; }); }
        else { const int r = it - I_IN, kb = r / (D_ / 32), nbk = r % (D_ / 32); transpose_item(p.in[16], D_, D_, WOUTT, scr, 64 * kb, 32 * nbk, lane, [](int n) { return n; }); }
    }
    float* W8T = (float*)(p.ws + WS_W8T); bf16* WRTH = (bf16*)(p.ws + WS_WRTH); bf16* WRTL = (bf16*)(p.ws + WS_WRTL);
    for (int i = bid * NTHR + tid; i < 8 * 1024 + 80 * 1024; i += nb * NTHR) {
        if (i < 8192) { const int j = i >> 10, c = i & 1023; W8T[i] = p.in[6][(size_t)c * INC + 2048 + j]; }
        else { const int q = i - 8192, n = q >> 10, c = q & 1023;
            const float w = n < 8 ? p.in[19][(size_t)c * 8 + n] : (n < 16 ? 0.f : p.in[21][(size_t)c * NE + (n - 16)]);
            const unsigned hi = f2bf(w); WRTH[q] = (bf16)hi; WRTL[q] = (bf16)f2bf(w - bf2f(hi)); }
    }
}
template <class CM>
__device__ __forceinline__ void transpose_item4(const float* W, int ldw, int K, bf16* WT, int k0, int n0, int lane, const CM& cmap) {
    const int kb = lane >> 3, ng = lane & 7;
    f32x4 v[4][8];
#pragma unroll
    for (int t = 0; t < 4; ++t) { const float* src = W + cmap(n0 + 32 * t + 4 * ng) + (size_t)(k0 + 8 * kb) * ldw;
#pragma unroll
        for (int i = 0; i < 8; ++i) v[t][i] = *(const f32x4*)(src + (size_t)i * ldw); }
#pragma unroll
    for (int t = 0; t < 4; ++t)
#pragma unroll
        for (int q = 0; q < 4; ++q) {
            uint4 o; o.x = f2bf(v[t][0][q]) | (f2bf(v[t][1][q]) << 16); o.y = f2bf(v[t][2][q]) | (f2bf(v[t][3][q]) << 16); o.z = f2bf(v[t][4][q]) | (f2bf(v[t][5][q]) << 16); o.w = f2bf(v[t][6][q]) | (f2bf(v[t][7][q]) << 16);
            *(uint4*)(WT + (size_t)(n0 + 32 * t + 4 * ng + q) * K + k0 + 8 * kb) = o;
        }
}
__device__ void ph_wprep_experts(const Params& p, int bid, int nb, int lo, int hi) {
    const int tid = opaque_tid(), lane = tid & 63, wave = tid >> 6;
    bf16* WGUT = (bf16*)(p.ws + WS_WGUT); bf16* WDNT = (bf16*)(p.ws + WS_WDNT);
    constexpr int I_GU = (D_ / 64) * (2 * DE / 128), I_DN = (DE / 64) * (D_ / 128);
    for (int it = lo + bid * 8 + wave; it < hi; it += nb * 8) {
        int r = it; const int e = r / (I_GU + I_DN); r -= e * (I_GU + I_DN);
        if (r < I_GU) { const int kb = r / (2 * DE / 128), nbk = r % (2 * DE / 128);
            const float* wg = p.in[23] + (size_t)e * D_ * DE; const long up_off = (long)(p.in[24] - p.in[23]);
            transpose_item4(wg, DE, D_, WGUT + (size_t)e * 2 * DE * D_, 64 * kb, 128 * nbk, lane, [up_off](int n) -> long { const int g = n >> 5, w = n & 31; return w < 16 ? (long)(16 * g + w) : up_off + (long)(16 * g + w - 16); }); }
        else { r -= I_GU; const int kb = r / (D_ / 128), nbk = r % (D_ / 128);
            transpose_item4(p.in[25] + (size_t)e * DE * D_, D_, DE, WDNT + (size_t)e * D_ * DE, 64 * kb, 128 * nbk, lane, [](int n) { return n; }); }
    }
}

__device__ void ph_mod(const Params& p, LAS float* lds, int bid, int nb) {
    const int tid = opaque_tid();
    const float* c = p.in[1]; const float* w_ada = p.in[2]; const float* b_ada = p.in[3];
    float* mod = (float*)(p.ws + WS_MOD);
    LAS float* cact = lds;
    LAS float* part = lds + 8192;
    for (int i = tid; i < 8192; i += NTHR) cact[i] = siluf_(c[i]);
    __syncthreads();
    for (int cg = bid; cg < 256; cg += nb) {
        const int n0 = cg * 24;
        const int kq = tid / 6, cq = tid % 6;
        float acc[8][4];
#pragma unroll
        for (int b = 0; b < 8; ++b) { acc[b][0] = acc[b][1] = acc[b][2] = acc[b][3] = 0.f; }
        if (kq < 85) {
            for (int k = kq; k < 1024; k += 85) {
                const float4 w = *(const float4*)(w_ada + (size_t)k * 6144 + n0 + 4 * cq);
#pragma unroll
                for (int b = 0; b < 8; ++b) { const float a = cact[b * 1024 + k]; acc[b][0] += a * w.x; acc[b][1] += a * w.y; acc[b][2] += a * w.z; acc[b][3] += a * w.w; }
            }
#pragma unroll
            for (int b = 0; b < 8; ++b)
#pragma unroll
                for (int j = 0; j < 4; ++j) part[(kq * 8 + b) * 24 + 4 * cq + j] = acc[b][j];
        }
        __syncthreads();
        if (tid < 192) {
            const int b = tid / 24, j = tid % 24; float s = 0.f;
            for (int q = 0; q < 85; ++q) s += part[(q * 8 + b) * 24 + j];
            mod[b * 6144 + n0 + j] = s + b_ada[n0 + j];
        }
        __syncthreads();
    }
}

__device__ void ph_h(const Params& p, LAS float* lds, int bid, int nb) {
    const int tid = opaque_tid(), lane = tid & 63, wave = tid >> 6;
    const float* x = p.in[0]; const float* npm = p.in[4];
    const float* mod = (const float*)(p.ws + WS_MOD); const float* W8T = (const float*)(p.ws + WS_W8T);
    bf16* H = (bf16*)(p.ws + WS_H); float* SM = (float*)(p.ws + WS_SMALL);
    for (int i = tid; i < 2048; i += NTHR) *(LAS f32x4*)(lds + 4 * i) = *(const f32x4*)(W8T + 4 * i);
    __syncthreads();
    for (int t = bid * 8 + wave; t < T_; t += nb * 8) {
        const int b = t / NS_;
        const float* xr = x + (size_t)t * D_;
        f32x4 v[4]; float ss = 0.f;
#pragma unroll
        for (int j = 0; j < 4; ++j) { v[j] = *(const f32x4*)(xr + 4 * lane + 256 * j); ss += v[j][0] * v[j][0] + v[j][1] * v[j][1] + v[j][2] * v[j][2] + v[j][3] * v[j][3]; }
        ss = wave_sum(ss);
        const float rstd = rsqrtf(ss * (1.f / D_) + EPS);
        float sm[8];
#pragma unroll
        for (int j = 0; j < 8; ++j) sm[j] = 0.f;
#pragma unroll
        for (int j = 0; j < 4; ++j) {
            const int c0 = 4 * lane + 256 * j;
            const f32x4 nw = *(const f32x4*)(npm + c0);
            const f32x4 sh = *(const f32x4*)(mod + b * 6144 + c0);
            const f32x4 sc = *(const f32x4*)(mod + b * 6144 + 1024 + c0);
            const f32x4 h = v[j] * rstd * nw * (sc + 1.f) + sh;
            uint2 o; o.x = f2bf(h[0]) | (f2bf(h[1]) << 16); o.y = f2bf(h[2]) | (f2bf(h[3]) << 16);
            *(uint2*)(H + (size_t)t * D_ + c0) = o;
#pragma unroll
            for (int q = 0; q < 8; ++q) { const f32x4 w = *(const LAS f32x4*)(lds + q * 1024 + c0); sm[q] += h[0] * w[0] + h[1] * w[1] + h[2] * w[2] + h[3] * w[3]; }
        }
#pragma unroll
        for (int j = 0; j < 8; ++j) sm[j] = wave_sum(sm[j]);
        if (lane == 0) { *(float4*)(SM + (size_t)t * 8) = make_float4(sm[0], sm[1], sm[2], sm[3]); *(float4*)(SM + (size_t)t * 8 + 4) = make_float4(sm[4], sm[5], sm[6], sm[7]); }
    }
}

template <class AF, class BF, class EF>
__device__ __forceinline__ void sgemm_tile(LAS float* lds, int K, const AF& af, const BF& bf, const EF& ef) {
    LAS float* As = lds; LAS float* Bs = lds + 16 * 132;
    const int tid = opaque_tid(), ty = tid >> 4, tx = tid & 15;
    float acc[4][4];
#pragma unroll
    for (int i = 0; i < 4; ++i)
#pragma unroll
        for (int j = 0; j < 4; ++j) acc[i][j] = 0.f;
    const int arow = tid >> 2, akq = tid & 3;
    const bf16* ap = af(arow);
    for (int k0 = 0; k0 < K; k0 += 16) {
        float a4[4] = {0.f, 0.f, 0.f, 0.f};
        if (ap) { const uint2 v = *(const uint2*)(ap + k0 + 4 * akq); a4[0] = bf2f(v.x & 0xffffu); a4[1] = bf2f(v.x >> 16); a4[2] = bf2f(v.y & 0xffffu); a4[3] = bf2f(v.y >> 16); }
        float4 b4 = make_float4(0.f, 0.f, 0.f, 0.f);
        if (tid < 256) b4 = *(const float4*)bf(k0 + (tid >> 4), 4 * (tid & 15));
        __syncthreads();
#pragma unroll
        for (int i = 0; i < 4; ++i) As[(4 * akq + i) * 132 + arow] = a4[i];
        if (tid < 256) { LAS float* bp = Bs + (tid >> 4) * 64 + 4 * (tid & 15); bp[0] = b4.x; bp[1] = b4.y; bp[2] = b4.z; bp[3] = b4.w; }
        __syncthreads();
#pragma unroll
        for (int kk = 0; kk < 16; ++kk) {
            float a[4], b[4];
#pragma unroll
            for (int i = 0; i < 4; ++i) { a[i] = As[kk * 132 + ty * 4 + i]; b[i] = Bs[kk * 64 + tx * 4 + i]; }
#pragma unroll
            for (int i = 0; i < 4; ++i)
#pragma unroll
                for (int j = 0; j < 4; ++j) acc[i][j] += a[i] * b[j];
        }
    }
    __syncthreads();
#pragma unroll
    for (int i = 0; i < 4; ++i) { f32x4 v = {acc[i][0], acc[i][1], acc[i][2], acc[i][3]}; ef(ty * 4 + i, tx * 4, v); }
}

__device__ __forceinline__ void ph_proj(const Params& p, LAS unsigned char* lds, int bid, int nb) {
    pg8::DenseSched S; S.init(p.ws + WS_H, p.ws + WS_WINT, T_, PJ, D_, nb, bid);
    pg8::EpiBf16 E{(bf16*)(p.ws + WS_PROJ), PJ};
    pg8::gemm_phase(lds, S, E);
}

typedef short bf16x8_t __attribute__((ext_vector_type(8)));
typedef unsigned u32x4_t __attribute__((ext_vector_type(4)));
typedef unsigned u32x2_t __attribute__((ext_vector_type(2)));
__device__ __forceinline__ int lds_off16(int row, int ch) { return row * 256 + ((ch ^ (row & 15)) << 4); }
__device__ __forceinline__ int lds_off8(int row, int ch) { return row * 128 + ((ch ^ ((row >> 1) & 7)) << 4); }
__device__ __forceinline__ unsigned pk2bf(float lo, float hi) { return f2bf(lo) | (f2bf(hi) << 16); }
__device__ __forceinline__ bf16x8_t ldfrag(const LAS unsigned char* p) { return *(const LAS bf16x8_t*)p; }

__device__ void ph_dnprep(const Params& p, LAS unsigned char* lds, int bid, int nb) {
    int tid_ = threadIdx.x; asm volatile("" : "+v"(tid_));
    const int tid = tid_, lane = tid & 63, wave = tid >> 6, fr = lane & 15, fq = lane >> 4;
    const bf16* PROJ = (const bf16*)(p.ws + WS_PROJ); const float* cw = p.in[7]; const float* a_log = p.in[8]; const float* dt_bias = p.in[9];
    const float* SM = (const float*)(p.ws + WS_SMALL);
    bf16* DW = (bf16*)(p.ws + WS_DW); bf16* DQG = (bf16*)(p.ws + WS_DQG); bf16* DKDT = (bf16*)(p.ws + WS_DKDT); bf16* DATT = (bf16*)(p.ws + WS_DATT);
    float* DU = (float*)(p.ws + WS_DU); float* DEGL = (float*)(p.ws + WS_DEGL);
    constexpr int O_KN = 0, O_QS = 16384, O_KD = 32768, O_AM = 50176, O_RHS = 66560, O_GC = 132096;
    LAS float* AM = (LAS float*)(lds + O_AM); LAS float* RHS = (LAS float*)(lds + O_RHS); LAS float* GC = (LAS float*)(lds + O_GC);
    LAS unsigned short* KD = (LAS unsigned short*)(lds + O_KD);
    const float qscale = 0.08838834764831845f;
    for (int item = bid; item < 1024; item += nb) {
        const int b = item >> 7, h = (item >> 5) & 3, n = item & 31, t0 = b * NS_ + n * 64, tl0 = n * 64;
        if (wave == 0) {
            const int t = t0 + lane;
            const float bl = SM[(size_t)t * 8 + h], al = SM[(size_t)t * 8 + 4 + h];
            const float beta = sigmoidf_(bl);
            const float xx = al + dt_bias[h];
            const float sp = xx > 20.f ? xx : log1pf(expf(xx));
            float gc = -expf(a_log[h]) * sp;
#pragma unroll
            for (int o = 1; o < 64; o <<= 1) { const float y = __shfl_up(gc, o); if (lane >= o) gc += y; }
            const float glast = __shfl(gc, 63);
            GC[lane] = gc; GC[64 + lane] = beta; GC[128 + lane] = expf(gc); GC[192 + lane] = expf(glast - gc);
            if (lane == 63) DEGL[item] = expf(gc);
        }
        __syncthreads();
        {
            const int r = tid >> 3, seg = tid & 7;
            const float beta = GC[64 + r], egc = GC[128 + r], edec = GC[192 + r];
            float v3[3][16];
#pragma unroll
            for (int part = 0; part < 3; ++part) {
                const int ch = part * 512 + h * 128 + seg * 16;
#pragma unroll
                for (int i = 0; i < 16; ++i) v3[part][i] = 0.f;
#pragma unroll
                for (int j = 0; j < 4; ++j) {
                    const bool ok = tl0 + r - 3 + j >= 0;
                    const size_t srow = (size_t)(ok ? t0 + r - 3 + j : t0);
                    const u32x4_t x0 = *(const u32x4_t*)(PROJ + srow * PJ + ch), x1 = *(const u32x4_t*)(PROJ + srow * PJ + ch + 8);
                    const unsigned xs[8] = {x0.x, x0.y, x0.z, x0.w, x1.x, x1.y, x1.z, x1.w};
#pragma unroll
                    for (int i = 0; i < 8; ++i) { float2 w = *(const float2*)(cw + j * 1536 + ch + 2 * i); if (!ok) { w.x = 0.f; w.y = 0.f; } v3[part][2 * i] += w.x * bf2f(xs[i] & 0xffffu); v3[part][2 * i + 1] += w.y * bf2f(xs[i] >> 16); }
                }
                asm volatile("" ::: "memory");
                float ss = 0.f;
#pragma unroll
                for (int i = 0; i < 16; ++i) { v3[part][i] = siluf_(v3[part][i]); ss += v3[part][i] * v3[part][i]; }
                if (part < 2) {
                    ss += __shfl_xor(ss, 1); ss += __shfl_xor(ss, 2); ss += __shfl_xor(ss, 4);
                    const float rn = rsqrtf(ss + EPS);
#pragma unroll
                    for (int i = 0; i < 16; ++i) v3[part][i] *= rn;
                }
            }
            {
                u32x4_t a0, a1, g0, g1; const float* q = v3[0]; const float s = qscale, sg = qscale * egc;
                a0.x = pk2bf(q[0] * s, q[1] * s); a0.y = pk2bf(q[2] * s, q[3] * s); a0.z = pk2bf(q[4] * s, q[5] * s); a0.w = pk2bf(q[6] * s, q[7] * s);
                a1.x = pk2bf(q[8] * s, q[9] * s); a1.y = pk2bf(q[10] * s, q[11] * s); a1.z = pk2bf(q[12] * s, q[13] * s); a1.w = pk2bf(q[14] * s, q[15] * s);
                g0.x = pk2bf(q[0] * sg, q[1] * sg); g0.y = pk2bf(q[2] * sg, q[3] * sg); g0.z = pk2bf(q[4] * sg, q[5] * sg); g0.w = pk2bf(q[6] * sg, q[7] * sg);
                g1.x = pk2bf(q[8] * sg, q[9] * sg); g1.y = pk2bf(q[10] * sg, q[11] * sg); g1.z = pk2bf(q[12] * sg, q[13] * sg); g1.w = pk2bf(q[14] * sg, q[15] * sg);
                *(LAS u32x4_t*)(lds + O_QS + lds_off16(r, 2 * seg)) = a0; *(LAS u32x4_t*)(lds + O_QS + lds_off16(r, 2 * seg + 1)) = a1;
                bf16* dst = DQG + (size_t)item * 8192 + r * 128 + seg * 16; *(u32x4_t*)dst = g0; *(u32x4_t*)(dst + 8) = g1;
            }
            {
                u32x4_t a0, a1; const float* k = v3[1];
                a0.x = pk2bf(k[0], k[1]); a0.y = pk2bf(k[2], k[3]); a0.z = pk2bf(k[4], k[5]); a0.w = pk2bf(k[6], k[7]);
                a1.x = pk2bf(k[8], k[9]); a1.y = pk2bf(k[10], k[11]); a1.z = pk2bf(k[12], k[13]); a1.w = pk2bf(k[14], k[15]);
                *(LAS u32x4_t*)(lds + O_KN + lds_off16(r, 2 * seg)) = a0; *(LAS u32x4_t*)(lds + O_KN + lds_off16(r, 2 * seg + 1)) = a1;
                u32x4_t d0, d1;
                d0.x = pk2bf(k[0] * edec, k[1] * edec); d0.y = pk2bf(k[2] * edec, k[3] * edec); d0.z = pk2bf(k[4] * edec, k[5] * edec); d0.w = pk2bf(k[6] * edec, k[7] * edec);
                d1.x = pk2bf(k[8] * edec, k[9] * edec); d1.y = pk2bf(k[10] * edec, k[11] * edec); d1.z = pk2bf(k[12] * edec, k[13] * edec); d1.w = pk2bf(k[14] * edec, k[15] * edec);
                *(LAS u32x4_t*)(KD + r * 136 + seg * 16) = d0; *(LAS u32x4_t*)(KD + r * 136 + seg * 16 + 8) = d1;
                const float bw = beta * egc;
#pragma unroll
                for (int i = 0; i < 4; ++i) *(LAS f32x4*)(RHS + r * 256 + 128 + seg * 16 + 4 * i) = (f32x4){k[4 * i] * bw, k[4 * i + 1] * bw, k[4 * i + 2] * bw, k[4 * i + 3] * bw};
            }
            {
                const float* v = v3[2];
#pragma unroll
                for (int i = 0; i < 4; ++i) *(LAS f32x4*)(RHS + r * 256 + seg * 16 + 4 * i) = (f32x4){v[4 * i] * beta, v[4 * i + 1] * beta, v[4 * i + 2] * beta, v[4 * i + 3] * beta};
            }
        }
        __syncthreads();
        {
            const int rb = wave & 3;
            bf16x8_t xf[4];
#pragma unroll
            for (int s4 = 0; s4 < 4; ++s4) xf[s4] = ldfrag(lds + O_KN + lds_off16(16 * rb + fr, 4 * s4 + fq));
#pragma unroll
            for (int cb = 0; cb < 4; ++cb) {
                f32x4 acc = {0.f, 0.f, 0.f, 0.f};
                const int yoff = (wave < 4) ? O_KN : O_QS;
#pragma unroll
                for (int s4 = 0; s4 < 4; ++s4) { const bf16x8_t yf = ldfrag(lds + yoff + lds_off16(16 * cb + fr, 4 * s4 + fq)); acc = __builtin_amdgcn_mfma_f32_16x16x32_bf16(xf[s4], yf, acc, 0, 0, 0); }
                const int xr0 = 16 * rb + 4 * fq, yr = 16 * cb + fr;
                const f32x4 gx = *(const LAS f32x4*)(GC + xr0); const float gy = GC[yr];
                if (wave < 4) {
                    const f32x4 bx = *(const LAS f32x4*)(GC + 64 + xr0);
                    f32x4 o;
#pragma unroll
                    for (int r = 0; r < 4; ++r) { const bool m = xr0 + r > yr; const float dec = __expf(m ? gx[r] - gy : 0.f); o[r] = m ? bx[r] * acc[r] * dec : 0.f; }
                    *(LAS f32x4*)(AM + ((xr0 >> 2) * 64 + yr) * 4) = o;
                } else {
                    float o[4];
#pragma unroll
                    for (int r = 0; r < 4; ++r) { const bool m = yr >= xr0 + r; const float dec = __expf(m ? gy - gx[r] : 0.f); o[r] = m ? acc[r] * dec : 0.f; }
                    u32x2_t w; w.x = pk2bf(o[0], o[1]); w.y = pk2bf(o[2], o[3]);
                    *(u32x2_t*)(DATT + (size_t)item * 4096 + yr * 64 + xr0) = w;
                }
            }
        }
        __syncthreads();
        if (tid < 256) {
            const int c = tid;
            float x[64];
#pragma unroll
            for (int blk = 0; blk < 16; ++blk) {
                float s0 = RHS[(4 * blk + 0) * 256 + c], s1 = RHS[(4 * blk + 1) * 256 + c], s2 = RHS[(4 * blk + 2) * 256 + c], s3 = RHS[(4 * blk + 3) * 256 + c];
#pragma unroll
                for (int j0 = 0; j0 < 4 * blk; j0 += 16) {
                    f32x4 a[16];
#pragma unroll
                    for (int q = 0; q < 16; ++q) if (j0 + q < 4 * blk) a[q] = *(const LAS f32x4*)(AM + (blk * 64 + j0 + q) * 4);
#pragma unroll
                    for (int q = 0; q < 16; ++q) if (j0 + q < 4 * blk) { const float xv = x[j0 + q]; s0 -= a[q][0] * xv; s1 -= a[q][1] * xv; s2 -= a[q][2] * xv; s3 -= a[q][3] * xv; }
                }
                const f32x4 t0 = *(const LAS f32x4*)(AM + (blk * 64 + 4 * blk) * 4), t1 = *(const LAS f32x4*)(AM + (blk * 64 + 4 * blk + 1) * 4), t2 = *(const LAS f32x4*)(AM + (blk * 64 + 4 * blk + 2) * 4);
                x[4 * blk] = s0;
                s1 -= t0[1] * s0; s2 -= t0[2] * s0; s3 -= t0[3] * s0;
                x[4 * blk + 1] = s1;
                s2 -= t1[2] * s1; s3 -= t1[3] * s1;
                x[4 * blk + 2] = s2;
                s3 -= t2[3] * s2;
                x[4 * blk + 3] = s3;
            }
            if (c < 128) {
#pragma unroll
                for (int i = 0; i < 64; ++i) DU[(size_t)item * 8192 + i * 128 + c] = x[i];
            } else {
#pragma unroll
                for (int i = 0; i < 64; ++i) DW[(size_t)item * 8192 + i * 128 + (c - 128)] = (bf16)f2bf(x[i]);
            }
        } else {
            const int tt = tid - 256, d = tt >> 1, c0 = (tt & 1) * 32;
            unsigned w[16];
#pragma unroll
            for (int i = 0; i < 16; ++i) w[i] = (unsigned)KD[(c0 + 2 * i) * 136 + d] | ((unsigned)KD[(c0 + 2 * i + 1) * 136 + d] << 16);
            bf16* dst = DKDT + (size_t)item * 8192 + d * 64 + c0;
#pragma unroll
            for (int i = 0; i < 4; ++i) *(u32x4_t*)(dst + 8 * i) = (u32x4_t){w[4 * i], w[4 * i + 1], w[4 * i + 2], w[4 * i + 3]};
        }
        __syncthreads();
    }
}

__device__ void ph_dnscan(const Params& p, LAS unsigned char* lds, int sbid, int nsb) {
    int tid_ = threadIdx.x; asm volatile("" : "+v"(tid_));
    const int tid = tid_, lane = tid & 63, wave = __builtin_amdgcn_readfirstlane(tid >> 6), fr = lane & 15, fq = lane >> 4;
    const bf16* DW = (const bf16*)(p.ws + WS_DW); const bf16* DQG = (const bf16*)(p.ws + WS_DQG); const bf16* DKDT = (const bf16*)(p.ws + WS_DKDT); const bf16* DATT = (const bf16*)(p.ws + WS_DATT);
    const float* DU = (const float*)(p.ws + WS_DU); const float* DEGL = (const float*)(p.ws + WS_DEGL);
    float* ORAW = (float*)(p.ws + WS_ORAW);
    constexpr int BUF = 57344, O_W = 0, O_QG = 16384, O_KDT = 32768, O_ATT = 49152, O_SB = 114688, O_VNT = 131072;
    const int cb = wave >> 1, eb = wave & 1;
    for (int it = sbid; it < 128; it += nsb) {
        const int bh = (it & 7) * 4 + (it >> 5), es = (it >> 3) & 3, b = bh >> 2, h = bh & 3, e0 = es * 32, item0 = bh * 32;
        f32x4 st[2] = {{0.f, 0.f, 0.f, 0.f}, {0.f, 0.f, 0.f, 0.f}};
        *(LAS u32x4_t*)(lds + O_SB + tid * 16) = (u32x4_t){0u, 0u, 0u, 0u};
        u32x4_t rg[7]; float un[4]; float egl_n;
#define DN_LOAD(itm) do { const size_t _o = (size_t)(itm) * 8192; \
            rg[0] = *(const u32x4_t*)(DW + _o + (size_t)tid * 8); rg[1] = *(const u32x4_t*)(DW + _o + (size_t)(tid + 512) * 8); \
            rg[2] = *(const u32x4_t*)(DQG + _o + (size_t)tid * 8); rg[3] = *(const u32x4_t*)(DQG + _o + (size_t)(tid + 512) * 8); \
            rg[4] = *(const u32x4_t*)(DKDT + _o + (size_t)tid * 8); rg[5] = *(const u32x4_t*)(DKDT + _o + (size_t)(tid + 512) * 8); \
            rg[6] = *(const u32x4_t*)(DATT + (size_t)(itm) * 4096 + (size_t)tid * 8); \
            _Pragma("unroll") for (int _r = 0; _r < 4; ++_r) un[_r] = DU[_o + (size_t)(16 * cb + 4 * fq + _r) * 128 + e0 + 16 * eb + fr]; \
            egl_n = DEGL[(itm)]; } while (0)
#define DN_STORE(bufo) do { LAS unsigned char* _b = lds + (bufo); \
            *(LAS u32x4_t*)(_b + O_W + lds_off16(tid >> 4, tid & 15)) = rg[0]; *(LAS u32x4_t*)(_b + O_W + lds_off16((tid + 512) >> 4, tid & 15)) = rg[1]; \
            *(LAS u32x4_t*)(_b + O_QG + lds_off16(tid >> 4, tid & 15)) = rg[2]; *(LAS u32x4_t*)(_b + O_QG + lds_off16((tid + 512) >> 4, tid & 15)) = rg[3]; \
            *(LAS u32x4_t*)(_b + O_KDT + lds_off8(tid >> 3, tid & 7)) = rg[4]; *(LAS u32x4_t*)(_b + O_KDT + lds_off8((tid + 512) >> 3, tid & 7)) = rg[5]; \
            *(LAS u32x4_t*)(_b + O_ATT + lds_off8(tid >> 3, tid & 7)) = rg[6]; } while (0)
        DN_LOAD(item0);
        DN_STORE(0);
        float u[4] = {un[0], un[1], un[2], un[3]}; float egl = egl_n;
        __syncthreads();
        for (int n = 0; n < 32; ++n) {
            const int bufo = (n & 1) * BUF, sbo = O_SB + (n & 1) * 8192, sbn = O_SB + ((n + 1) & 1) * 8192;
            if (n < 31) DN_LOAD(item0 + n + 1);
            f32x4 acc = {0.f, 0.f, 0.f, 0.f};
            bf16x8_t sf[4];
#pragma unroll
            for (int s4 = 0; s4 < 4; ++s4) sf[s4] = ldfrag(lds + sbo + lds_off16(16 * eb + fr, 4 * s4 + fq));
#pragma unroll
            for (int s4 = 0; s4 < 4; ++s4) acc = __builtin_amdgcn_mfma_f32_16x16x32_bf16(ldfrag(lds + bufo + O_W + lds_off16(16 * cb + fr, 4 * s4 + fq)), sf[s4], acc, 0, 0, 0);
            {
                const float v0 = u[0] - acc[0], v1 = u[1] - acc[1], v2 = u[2] - acc[2], v3 = u[3] - acc[3];
                u32x2_t w; w.x = pk2bf(v0, v1); w.y = pk2bf(v2, v3);
                *(LAS u32x2_t*)(lds + O_VNT + lds_off8(16 * eb + fr, 2 * cb + (fq >> 1)) + 8 * (fq & 1)) = w;
            }
            __syncthreads();
            f32x4 oacc = {0.f, 0.f, 0.f, 0.f};
#pragma unroll
            for (int s4 = 0; s4 < 4; ++s4) oacc = __builtin_amdgcn_mfma_f32_16x16x32_bf16(ldfrag(lds + bufo + O_QG + lds_off16(16 * cb + fr, 4 * s4 + fq)), sf[s4], oacc, 0, 0, 0);
            bf16x8_t vf[2][2];
#pragma unroll
            for (int e2 = 0; e2 < 2; ++e2)
#pragma unroll
                for (int s2 = 0; s2 < 2; ++s2) vf[e2][s2] = ldfrag(lds + O_VNT + lds_off8(16 * e2 + fr, 4 * s2 + fq));
#pragma unroll
            for (int s2 = 0; s2 < 2; ++s2) oacc = __builtin_amdgcn_mfma_f32_16x16x32_bf16(ldfrag(lds + bufo + O_ATT + lds_off8(16 * cb + fr, 4 * s2 + fq)), ldfrag(lds + O_VNT + lds_off8(16 * eb + fr, 4 * s2 + fq)), oacc, 0, 0, 0);
            {
                const size_t t0 = (size_t)b * NS_ + n * 64;
#pragma unroll
                for (int r = 0; r < 4; ++r) ORAW[(t0 + 16 * cb + 4 * fq + r) * 512 + h * 128 + e0 + 16 * eb + fr] = oacc[r];
            }
#pragma unroll
            for (int e2 = 0; e2 < 2; ++e2) {
                st[e2] = st[e2] * egl;
#pragma unroll
                for (int s2 = 0; s2 < 2; ++s2) st[e2] = __builtin_amdgcn_mfma_f32_16x16x32_bf16(ldfrag(lds + bufo + O_KDT + lds_off8(16 * wave + fr, 4 * s2 + fq)), vf[e2][s2], st[e2], 0, 0, 0);
                u32x2_t w; w.x = pk2bf(st[e2][0], st[e2][1]); w.y = pk2bf(st[e2][2], st[e2][3]);
                *(LAS u32x2_t*)(lds + sbn + lds_off16(16 * e2 + fr, 2 * wave + (fq >> 1)) + 8 * (fq & 1)) = w;
            }
            if (n < 31) { DN_STORE(((n + 1) & 1) * BUF); u[0] = un[0]; u[1] = un[1]; u[2] = un[2]; u[3] = un[3]; egl = egl_n; }
            __syncthreads();
        }
#undef DN_LOAD
#undef DN_STORE
        {
            unsigned* flag = (unsigned*)(p.ws + WS_CTL) + CW_DNF + 64 * bh;
            asm volatile("s_waitcnt vmcnt(0)" ::: "memory");
            __syncthreads();
            if (threadIdx.x == 0) {
                __builtin_amdgcn_fence(__ATOMIC_RELEASE, "agent");
                asm volatile("s_waitcnt vmcnt(0)" ::: "memory");
                __hip_atomic_fetch_add(flag, 1u, __ATOMIC_RELAXED, __HIP_MEMORY_SCOPE_AGENT);
                unsigned sp = 0;
                while (__hip_atomic_load(flag, __ATOMIC_RELAXED, __HIP_MEMORY_SCOPE_AGENT) < 4u) { __builtin_amdgcn_s_sleep(2); if (++sp > (1u << 22)) break; }
                __builtin_amdgcn_fence(__ATOMIC_ACQUIRE, "agent");
                asm volatile("s_waitcnt vmcnt(0)" ::: "memory");
            }
            __syncthreads();
            const bf16* PROJ = (const bf16*)(p.ws + WS_PROJ); bf16* MIXED = (bf16*)(p.ws + WS_MIXED);
            const float2 nw = *(const float2*)(p.in[10] + 2 * lane);
            const int tq0 = b * NS_ + es * 512 + (tid >> 6) * 64;
#pragma unroll 1
            for (int i0 = 0; i0 < 64; i0 += 8) {
                float2 o[8]; unsigned zz[8];
#pragma unroll
                for (int q = 0; q < 8; ++q) { const size_t t = (size_t)(tq0 + i0 + q); o[q] = *(const float2*)(ORAW + t * 512 + h * 128 + 2 * lane); zz[q] = *(const unsigned*)(PROJ + t * PJ + 1536 + h * 128 + 2 * lane); }
#pragma unroll
                for (int q = 0; q < 8; ++q) {
                    const float ss = wave_sum(o[q].x * o[q].x + o[q].y * o[q].y);
                    const float r = rsqrtf(ss * (1.f / 128.f) + EPS);
                    const float m0 = o[q].x * r * nw.x * siluf_(bf2f(zz[q] & 0xffffu)), m1 = o[q].y * r * nw.y * siluf_(bf2f(zz[q] >> 16));
                    *(unsigned*)(MIXED + (size_t)(tq0 + i0 + q) * D_ + h * 128 + 2 * lane) = f2bf(m0) | (f2bf(m1) << 16);
                }
            }
        }
    }
}

__device__ void ph_mixed(const Params& p, int bid, int nb) {
    const int tid = opaque_tid(), lane = tid & 63, wave = tid >> 6;
    const float* ORAW = (const float*)(p.ws + WS_ORAW); const bf16* PROJ = (const bf16*)(p.ws + WS_PROJ); const float* nw = p.in[10];
    bf16* MIXED = (bf16*)(p.ws + WS_MIXED);
    for (int t = bid * 8 + wave; t < T_; t += nb * 8) {
#pragma unroll
        for (int hh = 0; hh < 4; ++hh) {
            const float2 o = *(const float2*)(ORAW + (size_t)t * 512 + hh * 128 + 2 * lane);
            const float ss = wave_sum(o.x * o.x + o.y * o.y);
            const float r = rsqrtf(ss * (1.f / 128.f) + EPS);
            const unsigned zz = *(const unsigned*)(PROJ + (size_t)t * PJ + 1536 + hh * 128 + 2 * lane);
            const float m0 = o.x * r * nw[2 * lane] * siluf_(bf2f(zz & 0xffffu)), m1 = o.y * r * nw[2 * lane + 1] * siluf_(bf2f(zz >> 16));
            *(unsigned*)(MIXED + (size_t)t * D_ + hh * 128 + 2 * lane) = f2bf(m0) | (f2bf(m1) << 16);
        }
    }
}

__device__ void ph_cf(const Params& p, LAS float* lds, int bid, int nb) {
    const int tid = opaque_tid(), lane = tid & 63, wave = tid >> 6;
    const bf16* PROJ = (const bf16*)(p.ws + WS_PROJ);
    const float* pwb = p.in[11]; const float* dww = p.in[12]; const float* dwb = p.in[13]; const float* lnw = p.in[14]; const float* lnb = p.in[15];
    bf16* MIXED = (bf16*)(p.ws + WS_MIXED);
    constexpr int TT = 32;
    const int c = tid;
    float w[CFK];
#pragma unroll
    for (int j = 0; j < CFK; ++j) w[j] = dww[j * CFW + c];
    const float ba = pwb[c], bg = pwb[512 + c], cb = dwb[c];
    for (int it = bid; it < T_ / TT; it += nb) {
        const int t0 = it * TT, tl0 = t0 % NS_;
        float xg[TT + CFK - 1];
#pragma unroll
        for (int i0 = 0; i0 < TT + CFK - 1; i0 += 16) {
            unsigned ra[16], rg[16];
#pragma unroll
            for (int q = 0; q < 16; ++q) if (i0 + q < TT + CFK - 1) {
                const int tl = tl0 - (CFK - 1) + i0 + q;
                const size_t row = (size_t)(t0 - (CFK - 1) + i0 + q + (tl < 0 ? -tl : 0));
                ra[q] = PROJ[row * PJ + 2048 + c]; rg[q] = PROJ[row * PJ + 2560 + c];
            } else { ra[q] = 0; rg[q] = 0; }
            asm volatile("" : "+v"(ra[0]), "+v"(ra[1]), "+v"(ra[2]), "+v"(ra[3]), "+v"(ra[4]), "+v"(ra[5]), "+v"(ra[6]), "+v"(ra[7]), "+v"(ra[8]), "+v"(ra[9]), "+v"(ra[10]), "+v"(ra[11]), "+v"(ra[12]), "+v"(ra[13]), "+v"(ra[14]), "+v"(ra[15]));
            asm volatile("" : "+v"(rg[0]), "+v"(rg[1]), "+v"(rg[2]), "+v"(rg[3]), "+v"(rg[4]), "+v"(rg[5]), "+v"(rg[6]), "+v"(rg[7]), "+v"(rg[8]), "+v"(rg[9]), "+v"(rg[10]), "+v"(rg[11]), "+v"(rg[12]), "+v"(rg[13]), "+v"(rg[14]), "+v"(rg[15]));
#pragma unroll
            for (int q = 0; q < 16; ++q) if (i0 + q < TT + CFK - 1) {
                const int tl = tl0 - (CFK - 1) + i0 + q;
                const float a = bf2f(ra[q]) + ba, gt = bf2f(rg[q]) + bg;
                xg[i0 + q] = tl >= 0 ? a * sigmoidf_(gt) : 0.f;
            }
        }
        __syncthreads();
#pragma unroll
        for (int r = 0; r < TT; ++r) {
            float s = cb;
#pragma unroll
            for (int j = 0; j < CFK; ++j) s += w[j] * xg[r + j];
            lds[r * 512 + c] = s;
        }
        __syncthreads();
#pragma unroll
        for (int rr = 0; rr < 4; ++rr) {
            const int r = wave * 4 + rr;
            float v[8]; float s = 0.f;
#pragma unroll
            for (int j = 0; j < 8; ++j) { v[j] = lds[r * 512 + lane + 64 * j]; s += v[j]; }
            const float mu = wave_sum(s) * (1.f / 512.f);
            float q = 0.f;
#pragma unroll
            for (int j = 0; j < 8; ++j) { v[j] -= mu; q += v[j] * v[j]; }
            const float rstd = rsqrtf(wave_sum(q) * (1.f / 512.f) + EPS);
#pragma unroll
            for (int j = 0; j < 8; ++j) { const int cc = lane + 64 * j; const float y = v[j] * rstd * lnw[cc] + lnb[cc]; MIXED[(size_t)(t0 + r) * D_ + 512 + cc] = (bf16)f2bf(siluf_(y)); }
        }
    }
}

__device__ __forceinline__ void ph_outproj(const Params& p, LAS unsigned char* lds, int bid, int nb) {
    pg8::DenseSched S; S.init(p.ws + WS_MIXED, p.ws + WS_WOUTT, T_, D_, D_, nb, bid);
    pg8::EpiF32 E{(float*)(p.ws + WS_HMIX), D_};
    pg8::gemm_phase(lds, S, E);
}

struct Row2Par { f32x4 g1n[4], a2[4], b2[4]; };
__device__ __forceinline__ void row2_front(const Params& p, LAS unsigned char* lds, int t, int lr, int lane, const f32x4 (&hm)[4], const f32x4 (&xv)[4], const Row2Par& P) {
    bf16* H2 = (bf16*)(p.ws + WS_H);
    float ss = 0.f;
#pragma unroll
    for (int j = 0; j < 4; ++j) ss += hm[j][0] * hm[j][0] + hm[j][1] * hm[j][1] + hm[j][2] * hm[j][2] + hm[j][3] * hm[j][3];
    ss = wave_sum(ss);
    const float r1 = rsqrtf(ss * (1.f / D_) + EPS);
    f32x4 x1[4]; float s2 = 0.f;
#pragma unroll
    for (int j = 0; j < 4; ++j) {
        const int c0 = 4 * lane + 256 * j;
        x1[j] = xv[j] + P.g1n[j] * (hm[j] * r1);
        s2 += x1[j][0] * x1[j][0] + x1[j][1] * x1[j][1] + x1[j][2] * x1[j][2] + x1[j][3] * x1[j][3];
        *(f32x4*)(p.out + (size_t)t * D_ + c0) = x1[j];
    }
    s2 = wave_sum(s2);
    const float r2 = rsqrtf(s2 * (1.f / D_) + EPS);
#pragma unroll
    for (int j = 0; j < 4; ++j) {
        const int c0 = 4 * lane + 256 * j;
        const f32x4 h = x1[j] * r2 * P.a2[j] + P.b2[j];
        unsigned hi[4]; float lo[4];
#pragma unroll
        for (int i = 0; i < 4; ++i) { hi[i] = f2bf(h[i]); lo[i] = h[i] - bf2f(hi[i]); }
        u32x2_t wh; wh.x = hi[0] | (hi[1] << 16); wh.y = hi[2] | (hi[3] << 16);
        u32x2_t wl; wl.x = pk2bf(lo[0], lo[1]); wl.y = pk2bf(lo[2], lo[3]);
        *(u32x2_t*)(H2 + (size_t)t * D_ + c0) = wh;
        const int ch = c0 >> 3, off = lr * 2048 + ((ch ^ (lr & 15)) << 4) + (c0 & 7) * 2;
        *(LAS u32x2_t*)(lds + off) = wh; *(LAS u32x2_t*)(lds + 65536 + off) = wl;
    }
}
__device__ void ph_row2(const Params& p, LAS unsigned char* lds, int bid, int nb) {
    const int tid = opaque_tid(), lane = tid & 63, wave = __builtin_amdgcn_readfirstlane(tid >> 6), fr = lane & 15, fq = lane >> 4;
    const float* x = p.in[0]; const float* brg = p.in[20]; const float* bre = p.in[22];
    const float* HMIX = (const float*)(p.ws + WS_HMIX);
    const bf16* WRTH = (const bf16*)(p.ws + WS_WRTH); const bf16* WRTL = (const bf16*)(p.ws + WS_WRTL);
    int* ROUTE = (int*)(p.ws + WS_ROUTE); int* POS = (int*)(p.ws + WS_POS); int* TOKL = (int*)(p.ws + WS_TOKL); float* WL = (float*)(p.ws + WS_WL);
    unsigned* cnt = (unsigned*)(p.ws + WS_CTL) + CW_CNT;
    LAS float* PART = (LAS float*)lds;
    LAS float* LOG = (LAS float*)(lds + 131072);
    LAS int* rte = (LAS int*)(lds + 131072 + 10240); LAS int* rtr = rte + 128; LAS float* rtw = (LAS float*)(rtr + 128); LAS int* lcnt = (LAS int*)(rtw + 128); LAS int* lbase = lcnt + 64;
    if (tid < 64) lcnt[tid] = 0;
    __syncthreads();
    for (int chunk = bid; chunk < T_ / 64; chunk += nb) {
#pragma unroll 1
        for (int pass = 0; pass < 2; ++pass) {
            Row2Par P;
            { int lo_ = lane; asm volatile("" : "+v"(lo_));
              const float* mod = (const float*)(p.ws + WS_MOD) + ((chunk * 64) / NS_) * 6144;
#pragma unroll
              for (int j = 0; j < 4; ++j) { const int c0 = 4 * lo_ + 256 * j;
                  P.g1n[j] = *(const f32x4*)(mod + 2048 + c0) * *(const f32x4*)(p.in[5] + c0);
                  P.a2[j] = *(const f32x4*)(p.in[17] + c0) * (*(const f32x4*)(mod + 4096 + c0) + 1.f);
                  P.b2[j] = *(const f32x4*)(mod + 3072 + c0); } }
            const int tb = chunk * 64 + pass * 32 + wave * 4;
            f32x4 hmA[4], xvA[4], hmB[4], xvB[4];
#define R2_LOAD(hm, xv, t) do { _Pragma("unroll") for (int j = 0; j < 4; ++j) { hm[j] = *(const f32x4*)(HMIX + (size_t)(t) * D_ + 4 * lane + 256 * j); xv[j] = *(const f32x4*)(x + (size_t)(t) * D_ + 4 * lane + 256 * j); } } while (0)
            R2_LOAD(hmA, xvA, tb); R2_LOAD(hmB, xvB, tb + 1);
            row2_front(p, lds, tb, wave * 4, lane, hmA, xvA, P);
            R2_LOAD(hmA, xvA, tb + 2);
            row2_front(p, lds, tb + 1, wave * 4 + 1, lane, hmB, xvB, P);
            R2_LOAD(hmB, xvB, tb + 3);
            row2_front(p, lds, tb + 2, wave * 4 + 2, lane, hmA, xvA, P);
            row2_front(p, lds, tb + 3, wave * 4 + 3, lane, hmB, xvB, P);
#undef R2_LOAD
            __syncthreads();
            f32x4 acc[2][5];
#pragma unroll
            for (int mb = 0; mb < 2; ++mb)
#pragma unroll
                for (int n5 = 0; n5 < 5; ++n5) acc[mb][n5] = (f32x4){0.f, 0.f, 0.f, 0.f};
            bf16x8_t bh[1][5], bl[1][5];
#define R2_BLOAD(buf, s4) do { const int _ks = wave * 4 + (s4); _Pragma("unroll") for (int n5 = 0; n5 < 5; ++n5) { \
                bh[buf][n5] = *(const bf16x8_t*)(WRTH + (size_t)(16 * n5 + fr) * 1024 + _ks * 32 + fq * 8); bl[buf][n5] = *(const bf16x8_t*)(WRTL + (size_t)(16 * n5 + fr) * 1024 + _ks * 32 + fq * 8); } } while (0)
#define R2_BFORCE(buf) do { asm volatile("" : "+v"(bh[buf][0]), "+v"(bh[buf][1]), "+v"(bh[buf][2]), "+v"(bh[buf][3]), "+v"(bh[buf][4]), "+v"(bl[buf][0]), "+v"(bl[buf][1]), "+v"(bl[buf][2]), "+v"(bl[buf][3]), "+v"(bl[buf][4])); } while (0)
#pragma unroll
            for (int s4 = 0; s4 < 4; ++s4) {
                const int ks = wave * 4 + s4;
                R2_BLOAD(0, s4);
                bf16x8_t ah[2], al[2];
#pragma unroll
                for (int mb = 0; mb < 2; ++mb) { const int r = 16 * mb + fr, off = r * 2048 + (((4 * ks + fq) ^ (r & 15)) << 4); ah[mb] = ldfrag(lds + off); al[mb] = ldfrag(lds + 65536 + off); }
                R2_BFORCE(0);
#pragma unroll
                for (int n5 = 0; n5 < 5; ++n5) {
#pragma unroll
                    for (int mb = 0; mb < 2; ++mb) {
                        acc[mb][n5] = __builtin_amdgcn_mfma_f32_16x16x32_bf16(ah[mb], bh[0][n5], acc[mb][n5], 0, 0, 0);
                        acc[mb][n5] = __builtin_amdgcn_mfma_f32_16x16x32_bf16(al[mb], bh[0][n5], acc[mb][n5], 0, 0, 0);
                        acc[mb][n5] = __builtin_amdgcn_mfma_f32_16x16x32_bf16(ah[mb], bl[0][n5], acc[mb][n5], 0, 0, 0);
                    }
                }
            }
#undef R2_BLOAD
#undef R2_BFORCE
            __syncthreads();
#pragma unroll
            for (int mb = 0; mb < 2; ++mb)
#pragma unroll
                for (int n5 = 0; n5 < 5; ++n5)
#pragma unroll
                    for (int r = 0; r < 4; ++r) PART[(wave * 32 + 16 * mb + 4 * fq + r) * 80 + 16 * n5 + fr] = acc[mb][n5][r];
            __syncthreads();
            for (int i = tid; i < 2560; i += NTHR) { float a = 0.f;
#pragma unroll
                for (int w = 0; w < 8; ++w) a += PART[w * 2560 + i];
                LOG[i] = a; }
            __syncthreads();
            if (tid < 32) {
                const LAS float* lg = LOG + tid * 80;
                float gmax = -3.0e38f; int gi = 0; float gl[8];
#pragma unroll
                for (int o = 0; o < 8; ++o) { gl[o] = lg[o] + brg[o]; if (gl[o] > gmax) { gmax = gl[o]; gi = o; } }
                float gden = 0.f;
#pragma unroll
                for (int o = 0; o < 8; ++o) gden += __expf(gl[o] - gmax);
                const float gp = 1.f / gden;
                float m1 = -3.0e38f, m2 = -3.0e38f; int i1 = 0, i2 = 0; float el[8];
#pragma unroll
                for (int o = 0; o < 8; ++o) el[o] = lg[16 + gi * 8 + o] + bre[gi * 8 + o];
#pragma unroll
                for (int o = 0; o < 8; ++o) { if (el[o] > m1) { m1 = el[o]; i1 = o; } }
#pragma unroll
                for (int o = 0; o < 8; ++o) { if (o != i1 && el[o] > m2) { m2 = el[o]; i2 = o; } }
                const float e2 = __expf(m2 - m1);
                const int lr = pass * 32 + tid, ea = gi * 8 + i1, eb = gi * 8 + i2;
                rte[2 * lr] = ea; rte[2 * lr + 1] = eb;
                rtw[2 * lr] = gp * (1.f / (1.f + e2)); rtw[2 * lr + 1] = gp * (e2 / (1.f + e2));
                rtr[2 * lr] = __hip_atomic_fetch_add(lcnt + ea, 1, __ATOMIC_RELAXED, __HIP_MEMORY_SCOPE_WORKGROUP); rtr[2 * lr + 1] = __hip_atomic_fetch_add(lcnt + eb, 1, __ATOMIC_RELAXED, __HIP_MEMORY_SCOPE_WORKGROUP);
            }
            __syncthreads();
        }
        const int tq = opaque_tid();
        if (tq < 64) { const int c = lcnt[tq]; lbase[tq] = c > 0 ? (int)atomicAdd(cnt + tq, (unsigned)c) : 0; }
        __syncthreads();
        if (tq < 128) {
            const int e = rte[tq], pos = lbase[e] + rtr[tq], t = chunk * 64 + (tq >> 1);
            ROUTE[(size_t)t * 4 + (tq & 1)] = e; POS[(size_t)t * 2 + (tq & 1)] = pos;
            TOKL[(size_t)e * T_ + pos] = t; WL[(size_t)e * T_ + pos] = rtw[tq];
        }
        __syncthreads();
        if (tq < 64) lcnt[tq] = 0;
        __syncthreads();
    }
}

struct MoeMap { LAS int* tstart; LAS int* cnt; int total_tiles; };
__device__ __forceinline__ MoeMap moe_map(const Params& p, LAS int* l) {
    const unsigned* cnt = (const unsigned*)(p.ws + WS_CTL) + CW_CNT;
    __syncthreads();
    if (threadIdx.x < 64) {
        const int e = threadIdx.x;
        const int c = (int)__hip_atomic_load(cnt + e, __ATOMIC_RELAXED, __HIP_MEMORY_SCOPE_AGENT);
        const int nt = (c + TM - 1) / TM; int incl = nt;
#pragma unroll
        for (int o = 1; o < 64; o <<= 1) { const int y = __shfl_up(incl, o); if (e >= o) incl += y; }
        l[e] = incl - nt; l[128 + e] = c; if (e == 63) l[NE] = incl;
    }
    __syncthreads();
    MoeMap m; m.tstart = l; m.cnt = l + 128; m.total_tiles = l[NE];
    return m;
}
__device__ __forceinline__ int moe_find(const MoeMap& m, int tile) { int e = 0; while (e < NE - 1 && m.tstart[e + 1] <= tile) ++e; return e; }

__device__ __forceinline__ void ph_moe_gu(const Params& p, LAS unsigned char* lds, int bid, int nb) {
    MoeMap mm = moe_map(p, (LAS int*)(lds + pg8::STAGE_BYTES));
    pg8::GroupSched S{(const char*)(p.ws + WS_H), (const char*)(p.ws + WS_WGUT), D_, 4, (size_t)2 * DE * D_ * 2, mm.tstart, mm.cnt, mm.total_tiles, nb, bid, (const int*)(p.ws + WS_TOKL)};
    pg8::EpiGU E{(bf16*)(p.ws + WS_HID)};
    pg8::gemm_phase(lds, S, E);
}
__device__ __forceinline__ void ph_moe_down(const Params& p, LAS unsigned char* lds, int bid, int nb) {
    MoeMap mm = moe_map(p, (LAS int*)(lds + pg8::STAGE_BYTES));
    pg8::GroupSched S{(const char*)(p.ws + WS_HID), (const char*)(p.ws + WS_WDNT), DE, 4, (size_t)D_ * DE * 2, mm.tstart, mm.cnt, mm.total_tiles, nb, bid, nullptr};
    pg8::EpiDown E{(bf16*)(p.ws + WS_Y), (const float*)(p.ws + WS_WL), mm.cnt};
    pg8::gemm_phase(lds, S, E);
}

__device__ void ph_final(const Params& p, LAS float* lds, int bid, int nb) {
    const int tid = opaque_tid(), lane = tid & 63, wave = tid >> 6;
    const float* npf = p.in[18]; const float* mod = (const float*)(p.ws + WS_MOD);
    const bf16* Y = (const bf16*)(p.ws + WS_Y); const int* ROUTE = (const int*)(p.ws + WS_ROUTE); const int* POS = (const int*)(p.ws + WS_POS);
    MoeMap mm = moe_map(p, (LAS int*)lds);
    for (int t = bid * 8 + wave; t < T_; t += nb * 8) {
        const int b = t / NS_;
        const int ea = ROUTE[(size_t)t * 4], eb = ROUTE[(size_t)t * 4 + 1];
        const size_t ga = (size_t)mm.tstart[ea] * TM + POS[(size_t)t * 2], gb = (size_t)mm.tstart[eb] * TM + POS[(size_t)t * 2 + 1];
        float m[16]; float ss = 0.f;
#pragma unroll
        for (int j = 0; j < 4; ++j) {
            const uint2 a = *(const uint2*)(Y + ga * D_ + 4 * lane + 256 * j), bb = *(const uint2*)(Y + gb * D_ + 4 * lane + 256 * j);
            m[4 * j] = bf2f(a.x & 0xffffu) + bf2f(bb.x & 0xffffu); m[4 * j + 1] = bf2f(a.x >> 16) + bf2f(bb.x >> 16);
            m[4 * j + 2] = bf2f(a.y & 0xffffu) + bf2f(bb.y & 0xffffu); m[4 * j + 3] = bf2f(a.y >> 16) + bf2f(bb.y >> 16);
#pragma unroll
            for (int i = 0; i < 4; ++i) ss += m[4 * j + i] * m[4 * j + i];
        }
        ss = wave_sum(ss);
        const float r = rsqrtf(ss * (1.f / D_) + EPS);
#pragma unroll
        for (int j = 0; j < 4; ++j) {
            const int c0 = 4 * lane + 256 * j;
            float4 o = *(float4*)(p.out + (size_t)t * D_ + c0);
            o.x += mod[b * 6144 + 5120 + c0] * (m[4 * j] * r * npf[c0]);
            o.y += mod[b * 6144 + 5120 + c0 + 1] * (m[4 * j + 1] * r * npf[c0 + 1]);
            o.z += mod[b * 6144 + 5120 + c0 + 2] * (m[4 * j + 2] * r * npf[c0 + 2]);
            o.w += mod[b * 6144 + 5120 + c0 + 3] * (m[4 * j + 3] * r * npf[c0 + 3]);
            *(float4*)(p.out + (size_t)t * D_ + c0) = o;
        }
    }
}

constexpr int LDS_BYTES = 147456;
#define XB_TMO      128
#define XB_XCNT(j)  (256  + 64 * (j))
#define XB_XSUB(j)  (1280 + 64 * (j))
#define XB_XGEN(j)  (2304 + 64 * (j))
#define XB_TOP      3328
#define XB_TOPGEN   3392
#define XCD_BAR_WORDS 3456
#define XB_SPIN_CAP (1u << 22)
__device__ __forceinline__ unsigned xb_ld(unsigned* p)              { return __hip_atomic_load(p, __ATOMIC_RELAXED, __HIP_MEMORY_SCOPE_AGENT); }
__device__ __forceinline__ unsigned xb_add(unsigned* p, unsigned v) { return __hip_atomic_fetch_add(p, v, __ATOMIC_RELAXED, __HIP_MEMORY_SCOPE_AGENT); }
__device__ __forceinline__ unsigned xb_xcc_id() { return (unsigned)__builtin_amdgcn_s_getreg((3 << 11) | 20) & 0xFu; }
#define XB_SPIN(cond, bar) do { unsigned _sp = 0; while (cond) { __builtin_amdgcn_s_sleep(1); \
    if ((++_sp & 255u) == 0u) { if (xb_ld(&(bar)[XB_TMO])) break; if (_sp > XB_SPIN_CAP) { atomicAdd(&(bar)[XB_TMO], 1u); break; } } } } while (0)
struct XcdBarrier { unsigned* bar; unsigned x; volatile LAS unsigned* st; };
__device__ __forceinline__ XcdBarrier xcd_barrier_post(unsigned* bar, volatile LAS unsigned* st) {
    XcdBarrier b; b.bar = bar; b.x = xb_xcc_id(); b.st = st;
    if (threadIdx.x == 0) (void)xb_add(&bar[XB_XCNT(b.x)], 1u);
    return b;
}
__device__ __forceinline__ void xcd_barrier_complete(unsigned* bar, unsigned x, unsigned& nloc, unsigned& nx) {
    const unsigned G = gridDim.x * gridDim.y * gridDim.z;
    unsigned sum, cnt, mine, sp = 0u;
    for (;;) {
        sum = 0u; cnt = 0u; mine = 0u;
#pragma unroll
        for (unsigned j = 0; j < 16; ++j) { const unsigned c = xb_ld(&bar[XB_XCNT(j)]); sum += c; cnt += (c > 0u) ? 1u : 0u; mine = (j == x) ? c : mine; }
        if (sum == G) break;
        __builtin_amdgcn_s_sleep(1);
        if ((++sp & 255u) == 0u) { if (xb_ld(&bar[XB_TMO])) break; if (sp > XB_SPIN_CAP) { atomicAdd(&bar[XB_TMO], 1u); break; } }
    }
    nloc = mine > 0u ? mine : 1u; nx = cnt > 0u ? cnt : 1u;
}
__device__ __forceinline__ void xcd_barrier(unsigned char* ws, volatile LAS unsigned* st) {
    XcdBarrier b; b.bar = (unsigned*)(ws + WS_CTL) + 4096; b.x = xb_xcc_id(); b.st = st;
    asm volatile("s_waitcnt vmcnt(0)" ::: "memory");
    __syncthreads();
    if (threadIdx.x == 0) {
        unsigned* bar = b.bar;
        __builtin_amdgcn_s_waitcnt(0);
        unsigned nloc = b.st[0], nx = b.st[1];
        if (nloc == 0u) { xcd_barrier_complete(bar, b.x, nloc, nx); b.st[0] = nloc; b.st[1] = nx; }
        const unsigned old = xb_add(&bar[XB_XSUB(b.x)], 1u);
        const unsigned gen = old / nloc;
        if (old + 1u == (gen + 1u) * nloc) {
            __builtin_amdgcn_fence(__ATOMIC_RELEASE, "agent");
            asm volatile("s_waitcnt vmcnt(0)" ::: "memory");
            const unsigned og = xb_add(&bar[XB_TOP], 1u);
            const unsigned tg = og / nx;
            if (og + 1u == (tg + 1u) * nx) xb_add(&bar[XB_TOPGEN], 1u);
            else XB_SPIN(xb_ld(&bar[XB_TOPGEN]) == tg, bar);
            __builtin_amdgcn_fence(__ATOMIC_ACQUIRE, "agent");
            xb_add(&bar[XB_XGEN(b.x)], 1u);
            asm volatile("s_waitcnt vmcnt(0)" ::: "memory");
        } else {
            XB_SPIN(xb_ld(&bar[XB_XGEN(b.x)]) == gen, bar);
            __builtin_amdgcn_fence(__ATOMIC_ACQUIRE, "agent");
            asm volatile("s_waitcnt vmcnt(0)" ::: "memory");
        }
    }
    __syncthreads();
}
constexpr int CW_BAR = 4096;
constexpr int LDS_ST_OFF = LDS_BYTES - 64;

__global__ void __launch_bounds__(NTHR, 2) mk_all(Params p) {
    extern __shared__ __attribute__((aligned(16))) unsigned char lds_raw[];
    LAS float* lds = (LAS float*)lds_raw;
    const int bid = blockIdx.x, nb = gridDim.x;
    volatile LAS unsigned* st = (volatile LAS unsigned*)((LAS unsigned char*)lds_raw + LDS_ST_OFF);
    if (threadIdx.x < 16) st[threadIdx.x] = 0u;
    __syncthreads();
    (void)xcd_barrier_post((unsigned*)(p.ws + WS_CTL) + CW_BAR, st);
#ifndef STAMP_SEL
#define STAMP_SEL -1
#endif
    unsigned long long t_prev = 0, dt_sel = 0;
    if (STAMP_SEL >= 0) t_prev = __builtin_amdgcn_s_memrealtime();
#define STAMP(k) do { if (STAMP_SEL >= 0) { const unsigned long long now_ = __builtin_amdgcn_s_memrealtime(); if ((k) == STAMP_SEL && bid == 0) dt_sel = now_ - t_prev; t_prev = now_; } } while (0)
    ph_wprep(p, lds, bid, nb); __syncthreads();
    ph_mod(p, lds, bid, nb);            xcd_barrier(p.ws, st); STAMP(0);
    ph_h(p, lds, bid, nb);              xcd_barrier(p.ws, st); STAMP(1);
    ph_proj(p, (LAS unsigned char*)lds_raw, bid, nb);           xcd_barrier(p.ws, st); STAMP(2);
    ph_dnprep(p, (LAS unsigned char*)lds_raw, bid, nb);    xcd_barrier(p.ws, st); STAMP(3);
    {
        constexpr int CONV_ITEMS = NE * ((D_ / 64) * (2 * DE / 128) + (DE / 64) * (D_ / 128)), CONV_SPLIT = (CONV_ITEMS * 4 / 10) & ~7;
        if (bid < nb / 2) { ph_dnscan(p, (LAS unsigned char*)lds_raw, bid, nb / 2); ph_wprep_experts(p, bid, nb / 2, 0, CONV_SPLIT); }
        else { ph_cf(p, lds, bid - nb / 2, nb - nb / 2); ph_wprep_experts(p, bid - nb / 2, nb - nb / 2, CONV_SPLIT, CONV_ITEMS); }
    }
    if (STAMP_SEL == 40 && bid == 0) { const unsigned long long now_ = __builtin_amdgcn_s_memrealtime(); dt_sel = now_ - t_prev; }
    xcd_barrier(p.ws, st); STAMP(4);
    ph_outproj(p, (LAS unsigned char*)lds_raw, bid, nb);        xcd_barrier(p.ws, st); STAMP(6);
    ph_row2(p, (LAS unsigned char*)lds_raw, bid, nb);           xcd_barrier(p.ws, st); STAMP(7);
    ph_moe_gu(p, (LAS unsigned char*)lds_raw, bid, nb);      xcd_barrier(p.ws, st); STAMP(8);
    ph_moe_down(p, (LAS unsigned char*)lds_raw, bid, nb);    xcd_barrier(p.ws, st); STAMP(9);
    ph_final(p, lds, bid, nb);
    if (STAMP_SEL >= 0) {
        __syncthreads(); STAMP(10);
        { const unsigned long long t0 = __builtin_amdgcn_s_memrealtime(); while (__builtin_amdgcn_s_memrealtime() - t0 < 8ull * dt_sel) __builtin_amdgcn_s_sleep(8); }
    }
}

extern "C" void kernel_launch(void* const* d_in, const int* in_sizes, int n_in, void* d_out, int out_size, void* d_ws, size_t ws_size, hipStream_t stream) {
    static int inited = 0;
    if (!inited) {
        if (n_in != 26 || out_size != T_ * D_ || ws_size < WS_END) { fprintf(stderr, "kernel_launch: unexpected shapes n_in %d out %d ws %zu\n", n_in, out_size, ws_size); inited = -1; return; }
        if (hipFuncSetAttribute((const void*)mk_all, hipFuncAttributeMaxDynamicSharedMemorySize, LDS_BYTES) != hipSuccess) { fprintf(stderr, "hipFuncSetAttribute failed\n"); inited = -1; return; }
        inited = 1;
    }
    if (inited < 0) return;
    (void)hipMemsetAsync((char*)d_ws + WS_CTL, 0, 1 * MiB, stream);
    Params p{};
    for (int i = 0; i < 26; ++i) p.in[i] = (const float*)d_in[i];
    p.out = (float*)d_out; p.ws = (unsigned char*)d_ws;
    hipLaunchKernelGGL(mk_all, dim3(256), dim3(NTHR), LDS_BYTES, stream, p);
}
```

```cpp
#include <hip/hip_runtime.h>
#include <cstdio>
#include <cstdint>

#define LAS __attribute__((address_space(3)))
typedef unsigned short bf16;
typedef float f32x4 __attribute__((ext_vector_type(4)));

constexpr int NB_ = 8, NS_ = 2048, D_ = 1024, T_ = NB_ * NS_;
constexpr int DNW = 512, NH = 4, HD = 128;
constexpr int CFW = 512, CFK = 31;
constexpr int INC = 3080;
constexpr int PJ = 3072;
constexpr int NE = 64, DE = 512;
constexpr int NTHR = 512;
constexpr float EPS = 1e-6f;
constexpr int TM = 256;
constexpr int MAXROWS = 2 * T_ + NE * TM;

constexpr size_t MiB = 1u << 20;
constexpr size_t WS_CTL = 0;
constexpr size_t WS_MOD = 1 * MiB;
constexpr size_t WS_SMALL = 1 * MiB + 512 * 1024;
constexpr size_t WS_ROUTE = 2 * MiB;
constexpr size_t WS_POS = 2 * MiB + 512 * 1024;
constexpr size_t WS_TOKL = 3 * MiB;
constexpr size_t WS_WL = 7 * MiB;
constexpr size_t WS_W8T = 11 * MiB;
constexpr size_t WS_WRTH = 12 * MiB;
constexpr size_t WS_WRTL = 12 * MiB + 256 * 1024;
constexpr size_t WS_WINT = 16 * MiB;
constexpr size_t WS_WOUTT = 22 * MiB;
constexpr size_t WS_WGUT = 24 * MiB;
constexpr size_t WS_WDNT = 152 * MiB;
constexpr size_t WS_H = 216 * MiB;
constexpr size_t WS_PROJ = 248 * MiB;
constexpr size_t WS_HMIX = 248 * MiB;
constexpr size_t WS_HID = 248 * MiB;
constexpr size_t WS_DW = 344 * MiB;
constexpr size_t WS_DQG = 360 * MiB;
constexpr size_t WS_DKDT = 376 * MiB;
constexpr size_t WS_DATT = 392 * MiB;
constexpr size_t WS_DU = 400 * MiB;
constexpr size_t WS_DEGL = 432 * MiB;
constexpr size_t WS_Y = 344 * MiB;
constexpr size_t WS_ORAW = 440 * MiB;
constexpr size_t WS_MIXED = 472 * MiB;
constexpr size_t WS_END = 504 * MiB;
constexpr int CW_CNT = 1024;
constexpr int CW_DNF = 2048;

__device__ __forceinline__ unsigned f2bf(float f) { unsigned u = __builtin_bit_cast(unsigned, f); return (u + 0x7fffu + ((u >> 16) & 1u)) >> 16; }
__device__ __forceinline__ float bf2f(unsigned b) { return __builtin_bit_cast(float, b << 16); }
template <int CTRL, int ROWMASK> __device__ __forceinline__ float dpp_f(float v) {
    return __builtin_bit_cast(float, __builtin_amdgcn_update_dpp(0, __builtin_bit_cast(int, v), CTRL, ROWMASK, 0xF, true));
}
__device__ __forceinline__ float wave_sum(float v) {
    v += dpp_f<0xB1, 0xF>(v);
    v += dpp_f<0x4E, 0xF>(v);
    v += dpp_f<0x141, 0xF>(v);
    v += dpp_f<0x140, 0xF>(v);
    v += dpp_f<0x142, 0xA>(v);
    v += dpp_f<0x143, 0xC>(v);
    return __builtin_bit_cast(float, __builtin_amdgcn_readlane(__builtin_bit_cast(int, v), 63));
}
__device__ __forceinline__ float sigmoidf_(float x) { return 1.f / (1.f + __expf(-x)); }
__device__ __forceinline__ float siluf_(float x) { return x / (1.f + __expf(-x)); }

__device__ __forceinline__ int lane_id_v() { int l; asm volatile("v_mbcnt_lo_u32_b32 %0, -1, 0\n\tv_mbcnt_hi_u32_b32 %0, -1, %0" : "=v"(l)); return l; }
__device__ __forceinline__ int opaque_tid_w(int wv) { return (wv << 6) | lane_id_v(); }
#define opaque_tid() opaque_tid_w(wv)

struct Params {
    const float* in[26];
    float* out;
    unsigned char* ws;
};


namespace pg8 {
#define PG8_LAS __attribute__((address_space(3)))
typedef unsigned short bf16_t;
typedef short bf16x8 __attribute__((ext_vector_type(8)));
typedef float f32x4 __attribute__((ext_vector_type(4)));
typedef unsigned u32x4 __attribute__((ext_vector_type(4)));
typedef unsigned u32x2 __attribute__((ext_vector_type(2)));
constexpr int BM = 256, BK = 64, HALF = 128, HTB = HALF * BK * 2, STAGE_BYTES = 8 * HTB, NXCD = 8, WGM = 8;
__host__ __device__ __forceinline__ int lds_byte(int r, int c) { const int st = (r >> 4) * 2 + (c >> 5), rr = r & 15, cc = c & 31, ob = rr * 64 + cc * 2; return st * 1024 + (ob ^ (((ob >> 9) & 1) << 5)); }
__host__ __device__ __forceinline__ void stage_rc(int b, int& R, int& C) { const int st = b / 1024, sb = b % 1024, swz = sb ^ (((sb >> 9) & 1) << 5); R = (st >> 1) * 16 + swz / 64; C = (st & 1) * 32 + (swz % 64) / 2; }
__host__ __device__ __forceinline__ int perm32(int rho) { const int n = rho >> 4, i = rho & 15; return 8 * (i >> 2) + 4 * n + (i & 3); }
struct Unit { int pm, pn, e, r0; };
__device__ __forceinline__ void st_wt16(void* p, u32x4 v) { asm volatile("global_store_dwordx4 %0, %1, off sc1\n\ts_nop 1" :: "v"(p), "v"(v) : "memory"); }
__device__ __forceinline__ unsigned cvt_pk_bf16(float lo, float hi) { unsigned r; asm volatile("v_cvt_pk_bf16_f32 %0, %1, %2" : "=v"(r) : "v"(lo), "v"(hi)); return r; }

struct DenseSched {
    const char* A; const char* Bt; int K; int nM, nN, nwg, G, c;
    __device__ void init(const void* A_, const void* Bt_, int M, int N, int K_, int G_, int c_) { A = (const char*)A_; Bt = (const char*)Bt_; K = K_; nM = M / BM; nN = N / BM; nwg = nM * nN; G = G_; c = c_; }
    __device__ bool next(int i, Unit& u) const {
        const long L = (long)i * G + c; if (L >= nwg) return false;
        int wgid = (int)L; { const int q = nwg / NXCD, r = nwg % NXCD, xcd = wgid % NXCD, off = wgid / NXCD; wgid = (xcd < r ? xcd * (q + 1) : r * (q + 1) + (xcd - r) * q) + off; }
        const int nig = WGM * nN, gid = wgid / nig, fm = gid * WGM, gsz = (nM - fm) < WGM ? (nM - fm) : WGM;
        u.pm = fm + ((wgid % nig) % gsz); u.pn = (wgid % nig) / gsz; u.e = 0; u.r0 = 0; return true;
    }
    __device__ __forceinline__ const char* a_base() const { return A; }
    __device__ __forceinline__ const char* b_ptr(const Unit& u) const { return Bt + (size_t)u.pn * BM * K * 2; }
    __device__ __forceinline__ void a_off(const Unit& u, const int (&R)[2], const int (&C)[2], unsigned (&v)[2][2]) const {
#pragma unroll
        for (int h = 0; h < 2; ++h)
#pragma unroll
            for (int i = 0; i < 2; ++i) v[h][i] = (unsigned)(((u.pm * BM + h * HALF + R[i]) * K + C[i]) * 2);
    }
};

struct EpiBf16 {
    static constexpr bool PERM = true;
    bf16_t* O; int ldc;
    __device__ __forceinline__ void operator()(const f32x4 (&acc)[2][2][4][2], const Unit& u, int wr, int wc, int fr, int fq) const {
        const int row0 = u.pm * BM + wr * 64 + fr, col0 = u.pn * BM + wc * 32 + 8 * fq;
#pragma unroll
        for (int ai = 0; ai < 2; ++ai)
#pragma unroll
            for (int m = 0; m < 4; ++m) { bf16_t* rowp = O + (size_t)(row0 + ai * HALF + m * 16) * ldc + col0;
#pragma unroll
                for (int bj = 0; bj < 2; ++bj) { const f32x4 v0 = acc[ai][bj][m][0], v1 = acc[ai][bj][m][1];
                    u32x4 w; w.x = cvt_pk_bf16(v0[0], v0[1]); w.y = cvt_pk_bf16(v0[2], v0[3]); w.z = cvt_pk_bf16(v1[0], v1[1]); w.w = cvt_pk_bf16(v1[2], v1[3]);
                    st_wt16(rowp + bj * HALF, w); } }
    }
};
struct EpiF32 {
    static constexpr bool PERM = false;
    float* C; int ldc;
    __device__ __forceinline__ void operator()(const f32x4 (&acc)[2][2][4][2], const Unit& u, int wr, int wc, int fr, int fq) const {
        const int row0 = u.pm * BM + wr * 64 + fr, col0 = u.pn * BM + wc * 32 + 4 * fq;
#pragma unroll
        for (int ai = 0; ai < 2; ++ai)
#pragma unroll
            for (int m = 0; m < 4; ++m) { float* rowp = C + (size_t)(row0 + ai * HALF + m * 16) * ldc + col0;
#pragma unroll
                for (int bj = 0; bj < 2; ++bj)
#pragma unroll
                    for (int n = 0; n < 2; ++n) *(f32x4*)(rowp + bj * HALF + n * 16) = acc[ai][bj][m][n]; }
    }
};

struct GroupSched {
    const char* A; const char* Bt; int K; int nN; size_t bstride; LAS int* tstart; LAS int* cnt; int total; int G, c; const int* tokl;
    __device__ __forceinline__ bool next(int i, Unit& u) const {
        const int L = i * G + c; if (L >= total * nN) return false;
        const int tile = L / nN; u.pn = L % nN; int e = 0; while (e < NE - 1 && tstart[e + 1] <= tile) ++e;
        u.e = e; u.pm = tile; u.r0 = (tile - tstart[e]) * BM; return true;
    }
    __device__ __forceinline__ const char* a_base() const { return A; }
    __device__ __forceinline__ const char* b_ptr(const Unit& u) const { return Bt + (size_t)u.e * bstride + (size_t)u.pn * BM * K * 2; }
    __device__ __forceinline__ void a_off(const Unit& u, const int (&R)[2], const int (&C)[2], unsigned (&v)[2][2]) const {
        const int ce = cnt[u.e];
#pragma unroll
        for (int h = 0; h < 2; ++h)
#pragma unroll
            for (int i = 0; i < 2; ++i) {
                const int r = u.r0 + h * HALF + R[i];
                int grow = u.pm * BM + h * HALF + R[i];
                if (tokl) grow = (r < ce) ? tokl[(size_t)u.e * T_ + r] : 0;
                v[h][i] = (unsigned)((grow * K + C[i]) * 2);
            }
    }
};
struct EpiGU {
    static constexpr bool PERM = false;
    bf16_t* HID;
    __device__ __forceinline__ void operator()(const f32x4 (&acc)[2][2][4][2], const Unit& u, int wr, int wc, int fr, int fq) const {
        const int row0 = u.pm * BM + wr * 64 + fr;
#pragma unroll
        for (int ai = 0; ai < 2; ++ai)
#pragma unroll
            for (int m = 0; m < 4; ++m) { bf16_t* rowp = HID + (size_t)(row0 + ai * HALF + m * 16) * DE;
#pragma unroll
                for (int bj = 0; bj < 2; ++bj) { const f32x4 g = acc[ai][bj][m][0], up = acc[ai][bj][m][1];
                    float h[4];
#pragma unroll
                    for (int i = 0; i < 4; ++i) h[i] = g[i] / (1.f + __expf(-g[i])) * up[i];
                    u32x2 w; w.x = cvt_pk_bf16(h[0], h[1]); w.y = cvt_pk_bf16(h[2], h[3]);
                    *(u32x2*)(rowp + 16 * (u.pn * 8 + 4 * bj + wc) + 4 * fq) = w; } }
    }
};
struct EpiDown {
    static constexpr bool PERM = true;
    bf16_t* Y; const float* wl; LAS int* cnt;
    __device__ __forceinline__ void operator()(const f32x4 (&acc)[2][2][4][2], const Unit& u, int wr, int wc, int fr, int fq) const {
        const int rloc = wr * 64 + fr, col0 = u.pn * BM + wc * 32 + 8 * fq, ce = cnt[u.e];
#pragma unroll
        for (int ai = 0; ai < 2; ++ai) {
            float w4[4];
#pragma unroll
            for (int m = 0; m < 4; ++m) { const int r = u.r0 + rloc + ai * HALF + m * 16; w4[m] = wl[(size_t)u.e * T_ + (r < ce ? r : 0)]; }
            asm volatile("" : "+v"(w4[0]), "+v"(w4[1]), "+v"(w4[2]), "+v"(w4[3]));
#pragma unroll
            for (int m = 0; m < 4; ++m) { const int r = u.r0 + rloc + ai * HALF + m * 16;
                if (r < ce) {
                    const float w = w4[m];
                    bf16_t* rowp = Y + (size_t)(u.pm * BM + rloc + ai * HALF + m * 16) * D_ + col0;
#pragma unroll
                    for (int bj = 0; bj < 2; ++bj) { const f32x4 v0 = acc[ai][bj][m][0] * w, v1 = acc[ai][bj][m][1] * w;
                        u32x4 o; o.x = cvt_pk_bf16(v0[0], v0[1]); o.y = cvt_pk_bf16(v0[2], v0[3]); o.z = cvt_pk_bf16(v1[0], v1[1]); o.w = cvt_pk_bf16(v1[2], v1[3]);
                        *(u32x4*)(rowp + bj * HALF) = o; } } }
        }
    }
};

template <class Epi, class Sched>
__device__ __forceinline__ void gemm_phase(int wv, PG8_LAS unsigned char* lds, const Sched& S, const Epi& E) {
    int tid_ = opaque_tid();
    const int tid = tid_, wid = __builtin_amdgcn_readfirstlane(tid >> 6), lane = tid & 63, wr = wid >> 2, wc = wid & 3, fr = lane & 15, fq = lane >> 4;
    const int K = S.K, nt = K / BK;
    int sR[2], sC[2]; unsigned voffB[2];
#pragma unroll
    for (int i = 0; i < 2; ++i) { int R, C; stage_rc(tid * 16 + i * 8192, R, C); sR[i] = R; sC[i] = C; const int Rb = Epi::PERM ? ((R & ~31) + perm32(R & 31)) : R; voffB[i] = (unsigned)(Rb * K + C) * 2u; }
    const size_t kstep = (size_t)(BK * 2);
    const size_t hstep = (size_t)HALF * K * 2;
    const unsigned ldsw = (unsigned)wid * 1024u;
    const int aoff = lds_byte(wr * 64 + fr, fq * 8), boff = lds_byte(wc * 32 + fr, fq * 8);
#define PG8_SA(b, h) (((b) * 2 + (h)) * HTB)
#define PG8_SB(b, h) ((4 + (b) * 2 + (h)) * HTB)
#define PG8_STAGE(bufoff, gbase, voff) do { _Pragma("unroll") for (int _i = 0; _i < 2; ++_i) \
        __builtin_amdgcn_global_load_lds((const unsigned*)((const char*)(gbase) + (voff)[_i]), (PG8_LAS unsigned*)(lds + (bufoff) + ldsw + _i * 8192), 16, 0, 0); } while (0)
#define PG8_LDA(dst, b, h) do { _Pragma("unroll") for (int m = 0; m < 4; ++m) _Pragma("unroll") for (int k = 0; k < 2; ++k) dst[m][k] = *(const PG8_LAS bf16x8*)(lds + PG8_SA(b, h) + aoff + m * 2048 + k * 1024); } while (0)
#define PG8_LDB(dst, b, h) do { _Pragma("unroll") for (int n = 0; n < 2; ++n) _Pragma("unroll") for (int k = 0; k < 2; ++k) dst[n][k] = *(const PG8_LAS bf16x8*)(lds + PG8_SB(b, h) + boff + n * 2048 + k * 1024); } while (0)
#define PG8_MMA(ai, bj, At, Bt) do { __builtin_amdgcn_s_setprio(1); _Pragma("unroll") for (int m = 0; m < 4; ++m) _Pragma("unroll") for (int n = 0; n < 2; ++n) _Pragma("unroll") for (int k = 0; k < 2; ++k) \
        acc[ai][bj][m][n] = __builtin_amdgcn_mfma_f32_16x16x32_bf16(Bt[n][k], At[m][k], acc[ai][bj][m][n], 0, 0, 0); __builtin_amdgcn_s_setprio(0); } while (0)
#define PG8_WAIT_V(n) asm volatile("s_waitcnt vmcnt(" #n ")" ::: "memory")
#define PG8_WAIT_L(n) asm volatile("s_waitcnt lgkmcnt(" #n ")" ::: "memory")
#define PG8_BAR __builtin_amdgcn_s_barrier()
#define PG8_SCHED __builtin_amdgcn_sched_barrier(0)
    Unit cur, nxt; int ui = 0;
    if (!S.next(0, cur)) return;
    f32x4 acc[2][2][4][2];
#pragma unroll
    for (int a = 0; a < 2; ++a)
#pragma unroll
        for (int b = 0; b < 2; ++b)
#pragma unroll
            for (int m = 0; m < 4; ++m)
#pragma unroll
                for (int n = 0; n < 2; ++n) acc[a][b][m][n] = (f32x4){0.f, 0.f, 0.f, 0.f};
    bf16x8 At[4][2], B0[2][2], B1[2][2];
    const char* const gA = S.a_base();
    unsigned vC[2][2];
    S.a_off(cur, sR, sC, vC);
    const char* cB = S.b_ptr(cur);
    PG8_STAGE(PG8_SB(0, 0), cB, voffB); PG8_STAGE(PG8_SB(0, 1), cB + hstep, voffB); PG8_STAGE(PG8_SA(0, 0), gA, vC[0]); PG8_STAGE(PG8_SA(0, 1), gA, vC[1]);
    if (wr == 1) PG8_BAR;
    PG8_WAIT_V(2); PG8_BAR;
    PG8_STAGE(PG8_SB(1, 0), cB + kstep, voffB); PG8_STAGE(PG8_SA(1, 0), gA + kstep, vC[0]); PG8_STAGE(PG8_SB(1, 1), cB + hstep + kstep, voffB);
    PG8_WAIT_V(6); PG8_BAR;
    for (;;) {
        const bool has_next = S.next(ui + 1, nxt);
        const char* nB = has_next ? S.b_ptr(nxt) : cB;
        for (int t = 0; t < nt; t += 2) {
            const bool last = (t == nt - 2);
            const char* a1 = gA + (size_t)(t + 1) * kstep;
            const char* a2 = last ? gA : gA + (size_t)(t + 2) * kstep; const char* b2 = last ? nB : cB + (size_t)(t + 2) * kstep;
            const char* a3 = a2 + kstep; const char* b3 = b2 + kstep;
            PG8_LDB(B0, 0, 0); PG8_LDB(B1, 0, 1); PG8_SCHED; PG8_LDA(At, 0, 0); PG8_STAGE(PG8_SA(1, 1), a1, vC[1]);
            PG8_WAIT_V(8); PG8_WAIT_L(0); PG8_BAR; PG8_MMA(0, 0, At, B0); PG8_MMA(0, 1, At, B1); PG8_BAR; PG8_SCHED;
            if (last && has_next) S.a_off(nxt, sR, sC, vC);
            PG8_LDA(At, 0, 1); PG8_STAGE(PG8_SB(0, 0), b2, voffB); PG8_STAGE(PG8_SB(0, 1), b2 + hstep, voffB); PG8_STAGE(PG8_SA(0, 0), a2, vC[0]);
            PG8_WAIT_V(8); PG8_WAIT_L(0); PG8_BAR; PG8_MMA(1, 0, At, B0); PG8_MMA(1, 1, At, B1); PG8_BAR; PG8_SCHED;
            PG8_LDB(B0, 1, 0); PG8_LDB(B1, 1, 1); PG8_SCHED; PG8_LDA(At, 1, 0); PG8_STAGE(PG8_SA(0, 1), a2, vC[1]);
            PG8_WAIT_V(8); PG8_WAIT_L(0); PG8_BAR; PG8_MMA(0, 0, At, B0); PG8_MMA(0, 1, At, B1); PG8_BAR; PG8_SCHED;
            PG8_LDA(At, 1, 1); PG8_STAGE(PG8_SB(1, 0), b3, voffB); PG8_STAGE(PG8_SB(1, 1), b3 + hstep, voffB); PG8_STAGE(PG8_SA(1, 0), a3, vC[0]);
            PG8_WAIT_V(8); PG8_WAIT_L(0); PG8_BAR; PG8_MMA(1, 0, At, B0); PG8_MMA(1, 1, At, B1); PG8_BAR; PG8_SCHED;
        }
        if (wr == 0) PG8_BAR;
        E(acc, cur, wr, wc, fr, fq);
        if (!has_next) break;
#pragma unroll
        for (int a = 0; a < 2; ++a)
#pragma unroll
            for (int b = 0; b < 2; ++b)
#pragma unroll
                for (int m = 0; m < 4; ++m)
#pragma unroll
                    for (int n = 0; n < 2; ++n) acc[a][b][m][n] = (f32x4){0.f, 0.f, 0.f, 0.f};
        cur = nxt; cB = nB; ++ui;
        if (wr == 1) PG8_BAR;
    }
    PG8_WAIT_V(0);
    PG8_BAR;
#undef PG8_SA
#undef PG8_SB
#undef PG8_STAGE
#undef PG8_LDA
#undef PG8_LDB
#undef PG8_MMA
#undef PG8_WAIT_V
#undef PG8_WAIT_L
#undef PG8_BAR
#undef PG8_SCHED
}
}

template <class CM>
__device__ __forceinline__ void transpose_item(const float* W, int ldw, int K, bf16* WT, LAS float* scr, int k0, int n0, int lane, const CM& cmap) {
    const int kb = lane >> 3, ng = lane & 7;
    const float* src = W + cmap(n0 + 4 * ng) + (size_t)(k0 + 8 * kb) * ldw;
    f32x4 v[8];
#pragma unroll
    for (int i = 0; i < 8; ++i) v[i] = *(const f32x4*)(src + (size_t)i * ldw);
#pragma unroll
    for (int q = 0; q < 4; ++q) {
        uint4 o; o.x = f2bf(v[0][q]) | (f2bf(v[1][q]) << 16); o.y = f2bf(v[2][q]) | (f2bf(v[3][q]) << 16); o.z = f2bf(v[4][q]) | (f2bf(v[5][q]) << 16); o.w = f2bf(v[6][q]) | (f2bf(v[7][q]) << 16);
        *(uint4*)(WT + (size_t)(n0 + 4 * ng + q) * K + k0 + 8 * kb) = o;
    }
}
__device__ void ph_wprep(int wv, const Params& p, LAS float* lds, int bid, int nb) {
    const int tid = opaque_tid(), lane = tid & 63, wave = tid >> 6;
    LAS float* scr = lds + wave * 4096;
    bf16* WINT = (bf16*)(p.ws + WS_WINT); bf16* WOUTT = (bf16*)(p.ws + WS_WOUTT);
    constexpr int I_IN = (D_ / 64) * (PJ / 32), I_OUT = (D_ / 64) * (D_ / 32);
    for (int it = bid * 8 + wave; it < I_IN + I_OUT; it += nb * 8) {
        if (it < I_IN) { const int kb = it / (PJ / 32), nbk = it % (PJ / 32); transpose_item(p.in[6], INC, D_, WINT, scr, 64 * kb, 32 * nbk, lane, [](int n) { return n < 2048 ? n : n + 8; }); }
        else { const int r = it - I_IN, kb = r / (D_ / 32), nbk = r % (D_ / 32); transpose_item(p.in[16], D_, D_, WOUTT, scr, 64 * kb, 32 * nbk, lane, [](int n) { return n; }); }
    }
    float* W8T = (float*)(p.ws + WS_W8T); bf16* WRTH = (bf16*)(p.ws + WS_WRTH); bf16* WRTL = (bf16*)(p.ws + WS_WRTL);
    for (int i = bid * NTHR + tid; i < 8 * 1024 + 80 * 1024; i += nb * NTHR) {
        if (i < 8192) { const int j = i >> 10, c = i & 1023; W8T[i] = p.in[6][(size_t)c * INC + 2048 + j]; }
        else { const int q = i - 8192, n = q >> 10, c = q & 1023;
            const float w = n < 8 ? p.in[19][(size_t)c * 8 + n] : (n < 16 ? 0.f : p.in[21][(size_t)c * NE + (n - 16)]);
            const unsigned hi = f2bf(w); WRTH[q] = (bf16)hi; WRTL[q] = (bf16)f2bf(w - bf2f(hi)); }
    }
}
template <class CM>
__device__ __forceinline__ void transpose_item4(const float* W, int ldw, int K, bf16* WT, int k0, int n0, int lane, const CM& cmap) {
    const int kb = lane >> 3, ng = lane & 7;
    f32x4 v[4][8];
#pragma unroll
    for (int t = 0; t < 4; ++t) { const float* src = W + cmap(n0 + 32 * t + 4 * ng) + (size_t)(k0 + 8 * kb) * ldw;
#pragma unroll
        for (int i = 0; i < 8; ++i) v[t][i] = *(const f32x4*)(src + (size_t)i * ldw); }
#pragma unroll
    for (int t = 0; t < 4; ++t)
#pragma unroll
        for (int q = 0; q < 4; ++q) {
            uint4 o; o.x = f2bf(v[t][0][q]) | (f2bf(v[t][1][q]) << 16); o.y = f2bf(v[t][2][q]) | (f2bf(v[t][3][q]) << 16); o.z = f2bf(v[t][4][q]) | (f2bf(v[t][5][q]) << 16); o.w = f2bf(v[t][6][q]) | (f2bf(v[t][7][q]) << 16);
            *(uint4*)(WT + (size_t)(n0 + 32 * t + 4 * ng + q) * K + k0 + 8 * kb) = o;
        }
}
__device__ void ph_wprep_experts(int wv, const Params& p, int bid, int nb, int lo, int hi) {
    const int tid = opaque_tid(), lane = tid & 63, wave = tid >> 6;
    bf16* WGUT = (bf16*)(p.ws + WS_WGUT); bf16* WDNT = (bf16*)(p.ws + WS_WDNT);
    constexpr int I_GU = (D_ / 64) * (2 * DE / 128), I_DN = (DE / 64) * (D_ / 128);
    for (int it = lo + bid * 8 + wave; it < hi; it += nb * 8) {
        int r = it; const int e = r / (I_GU + I_DN); r -= e * (I_GU + I_DN);
        if (r < I_GU) { const int kb = r / (2 * DE / 128), nbk = r % (2 * DE / 128);
            const float* wg = p.in[23] + (size_t)e * D_ * DE; const long up_off = (long)(p.in[24] - p.in[23]);
            transpose_item4(wg, DE, D_, WGUT + (size_t)e * 2 * DE * D_, 64 * kb, 128 * nbk, lane, [up_off](int n) -> long { const int g = n >> 5, w = n & 31; return w < 16 ? (long)(16 * g + w) : up_off + (long)(16 * g + w - 16); }); }
        else { r -= I_GU; const int kb = r / (D_ / 128), nbk = r % (D_ / 128);
            transpose_item4(p.in[25] + (size_t)e * DE * D_, D_, DE, WDNT + (size_t)e * D_ * DE, 64 * kb, 128 * nbk, lane, [](int n) { return n; }); }
    }
}

__device__ void ph_mod(int wv, const Params& p, LAS float* lds, int bid, int nb) {
    const int tid = opaque_tid();
    const float* c = p.in[1]; const float* w_ada = p.in[2]; const float* b_ada = p.in[3];
    float* mod = (float*)(p.ws + WS_MOD);
    LAS float* cact = lds;
    LAS float* part = lds + 8192;
    for (int i = tid; i < 8192; i += NTHR) cact[i] = siluf_(c[i]);
    __syncthreads();
    for (int cg = bid; cg < 256; cg += nb) {
        const int n0 = cg * 24;
        const int kq = tid / 6, cq = tid % 6;
        float acc[8][4];
#pragma unroll
        for (int b = 0; b < 8; ++b) { acc[b][0] = acc[b][1] = acc[b][2] = acc[b][3] = 0.f; }
        if (kq < 85) {
            for (int k = kq; k < 1024; k += 85) {
                const float4 w = *(const float4*)(w_ada + (size_t)k * 6144 + n0 + 4 * cq);
#pragma unroll
                for (int b = 0; b < 8; ++b) { const float a = cact[b * 1024 + k]; acc[b][0] += a * w.x; acc[b][1] += a * w.y; acc[b][2] += a * w.z; acc[b][3] += a * w.w; }
            }
#pragma unroll
            for (int b = 0; b < 8; ++b)
#pragma unroll
                for (int j = 0; j < 4; ++j) part[(kq * 8 + b) * 24 + 4 * cq + j] = acc[b][j];
        }
        __syncthreads();
        if (tid < 192) {
            const int b = tid / 24, j = tid % 24; float s = 0.f;
            for (int q = 0; q < 85; ++q) s += part[(q * 8 + b) * 24 + j];
            mod[b * 6144 + n0 + j] = s + b_ada[n0 + j];
        }
        __syncthreads();
    }
}

__device__ void ph_h(int wv, const Params& p, LAS float* lds, int bid, int nb) {
    const int tid = opaque_tid(), lane = tid & 63, wave = tid >> 6;
    const float* x = p.in[0]; const float* npm = p.in[4];
    const float* mod = (const float*)(p.ws + WS_MOD); const float* W8T = (const float*)(p.ws + WS_W8T);
    bf16* H = (bf16*)(p.ws + WS_H); float* SM = (float*)(p.ws + WS_SMALL);
    for (int i = tid; i < 2048; i += NTHR) *(LAS f32x4*)(lds + 4 * i) = *(const f32x4*)(W8T + 4 * i);
    __syncthreads();
    for (int t = bid * 8 + wave; t < T_; t += nb * 8) {
        const int b = t / NS_;
        const float* xr = x + (size_t)t * D_;
        f32x4 v[4]; float ss = 0.f;
#pragma unroll
        for (int j = 0; j < 4; ++j) { v[j] = *(const f32x4*)(xr + 4 * lane + 256 * j); ss += v[j][0] * v[j][0] + v[j][1] * v[j][1] + v[j][2] * v[j][2] + v[j][3] * v[j][3]; }
        ss = wave_sum(ss);
        const float rstd = rsqrtf(ss * (1.f / D_) + EPS);
        float sm[8];
#pragma unroll
        for (int j = 0; j < 8; ++j) sm[j] = 0.f;
#pragma unroll
        for (int j = 0; j < 4; ++j) {
            const int c0 = 4 * lane + 256 * j;
            const f32x4 nw = *(const f32x4*)(npm + c0);
            const f32x4 sh = *(const f32x4*)(mod + b * 6144 + c0);
            const f32x4 sc = *(const f32x4*)(mod + b * 6144 + 1024 + c0);
            const f32x4 h = v[j] * rstd * nw * (sc + 1.f) + sh;
            uint2 o; o.x = f2bf(h[0]) | (f2bf(h[1]) << 16); o.y = f2bf(h[2]) | (f2bf(h[3]) << 16);
            *(uint2*)(H + (size_t)t * D_ + c0) = o;
#pragma unroll
            for (int q = 0; q < 8; ++q) { const f32x4 w = *(const LAS f32x4*)(lds + q * 1024 + c0); sm[q] += h[0] * w[0] + h[1] * w[1] + h[2] * w[2] + h[3] * w[3]; }
        }
#pragma unroll
        for (int j = 0; j < 8; ++j) sm[j] = wave_sum(sm[j]);
        if (lane == 0) { *(float4*)(SM + (size_t)t * 8) = make_float4(sm[0], sm[1], sm[2], sm[3]); *(float4*)(SM + (size_t)t * 8 + 4) = make_float4(sm[4], sm[5], sm[6], sm[7]); }
    }
}

__device__ __forceinline__ void ph_proj(int wv, const Params& p, LAS unsigned char* lds, int bid, int nb) {
    pg8::DenseSched S; S.init(p.ws + WS_H, p.ws + WS_WINT, T_, PJ, D_, nb, bid);
    pg8::EpiBf16 E{(bf16*)(p.ws + WS_PROJ), PJ};
    pg8::gemm_phase(wv, lds, S, E);
}

typedef short bf16x8_t __attribute__((ext_vector_type(8)));
typedef unsigned u32x4_t __attribute__((ext_vector_type(4)));
typedef unsigned u32x2_t __attribute__((ext_vector_type(2)));
__device__ __forceinline__ int lds_off16(int row, int ch) { return row * 256 + ((ch ^ (row & 15)) << 4); }
__device__ __forceinline__ int lds_off8(int row, int ch) { return row * 128 + ((ch ^ ((row >> 1) & 7)) << 4); }
__device__ __forceinline__ unsigned pk2bf(float lo, float hi) { return f2bf(lo) | (f2bf(hi) << 16); }
__device__ __forceinline__ bf16x8_t ldfrag(const LAS unsigned char* p) { return *(const LAS bf16x8_t*)p; }

__device__ void ph_dnprep(int wv, const Params& p, LAS unsigned char* lds, int bid, int nb) {
    const int tid = opaque_tid(), lane = tid & 63, wave = tid >> 6, fr = lane & 15, fq = lane >> 4;
    const bf16* PROJ = (const bf16*)(p.ws + WS_PROJ); const float* cw = p.in[7]; const float* a_log = p.in[8]; const float* dt_bias = p.in[9];
    const float* SM = (const float*)(p.ws + WS_SMALL);
    bf16* DW = (bf16*)(p.ws + WS_DW); bf16* DQG = (bf16*)(p.ws + WS_DQG); bf16* DKDT = (bf16*)(p.ws + WS_DKDT); bf16* DATT = (bf16*)(p.ws + WS_DATT);
    float* DU = (float*)(p.ws + WS_DU); float* DEGL = (float*)(p.ws + WS_DEGL);
    constexpr int O_KN = 0, O_QS = 16384, O_KD = 32768, O_AM = 50176, O_RHS = 66560, O_GC = 132096;
    LAS float* AM = (LAS float*)(lds + O_AM); LAS float* RHS = (LAS float*)(lds + O_RHS); LAS float* GC = (LAS float*)(lds + O_GC);
    LAS unsigned short* KD = (LAS unsigned short*)(lds + O_KD);
    const float qscale = 0.08838834764831845f;
    for (int item = bid; item < 1024; item += nb) {
        const int b = item >> 7, h = (item >> 5) & 3, n = item & 31, t0 = b * NS_ + n * 64, tl0 = n * 64;
        if (wave == 0) {
            const int t = t0 + lane;
            const float bl = SM[(size_t)t * 8 + h], al = SM[(size_t)t * 8 + 4 + h];
            const float beta = sigmoidf_(bl);
            const float xx = al + dt_bias[h];
            const float sp = xx > 20.f ? xx : log1pf(expf(xx));
            float gc = -expf(a_log[h]) * sp;
#pragma unroll
            for (int o = 1; o < 64; o <<= 1) { const float y = __shfl_up(gc, o); if (lane >= o) gc += y; }
            const float glast = __shfl(gc, 63);
            GC[lane] = gc; GC[64 + lane] = beta; GC[128 + lane] = expf(gc); GC[192 + lane] = expf(glast - gc);
            if (lane == 63) DEGL[item] = expf(gc);
        }
        __syncthreads();
        {
            const int r = tid >> 3, seg = tid & 7;
            const float beta = GC[64 + r], egc = GC[128 + r], edec = GC[192 + r];
            float v3[3][16];
#pragma unroll
            for (int part = 0; part < 3; ++part) {
                const int ch = part * 512 + h * 128 + seg * 16;
#pragma unroll
                for (int i = 0; i < 16; ++i) v3[part][i] = 0.f;
#pragma unroll
                for (int j = 0; j < 4; ++j) {
                    const bool ok = tl0 + r - 3 + j >= 0;
                    const size_t srow = (size_t)(ok ? t0 + r - 3 + j : t0);
                    const u32x4_t x0 = *(const u32x4_t*)(PROJ + srow * PJ + ch), x1 = *(const u32x4_t*)(PROJ + srow * PJ + ch + 8);
                    const unsigned xs[8] = {x0.x, x0.y, x0.z, x0.w, x1.x, x1.y, x1.z, x1.w};
#pragma unroll
                    for (int i = 0; i < 8; ++i) { float2 w = *(const float2*)(cw + j * 1536 + ch + 2 * i); if (!ok) { w.x = 0.f; w.y = 0.f; } v3[part][2 * i] += w.x * bf2f(xs[i] & 0xffffu); v3[part][2 * i + 1] += w.y * bf2f(xs[i] >> 16); }
                }
                asm volatile("" ::: "memory");
                float ss = 0.f;
#pragma unroll
                for (int i = 0; i < 16; ++i) { v3[part][i] = siluf_(v3[part][i]); ss += v3[part][i] * v3[part][i]; }
                if (part < 2) {
                    ss += __shfl_xor(ss, 1); ss += __shfl_xor(ss, 2); ss += __shfl_xor(ss, 4);
                    const float rn = rsqrtf(ss + EPS);
#pragma unroll
                    for (int i = 0; i < 16; ++i) v3[part][i] *= rn;
                }
            }
            {
                u32x4_t a0, a1, g0, g1; const float* q = v3[0]; const float s = qscale, sg = qscale * egc;
                a0.x = pk2bf(q[0] * s, q[1] * s); a0.y = pk2bf(q[2] * s, q[3] * s); a0.z = pk2bf(q[4] * s, q[5] * s); a0.w = pk2bf(q[6] * s, q[7] * s);
                a1.x = pk2bf(q[8] * s, q[9] * s); a1.y = pk2bf(q[10] * s, q[11] * s); a1.z = pk2bf(q[12] * s, q[13] * s); a1.w = pk2bf(q[14] * s, q[15] * s);
                g0.x = pk2bf(q[0] * sg, q[1] * sg); g0.y = pk2bf(q[2] * sg, q[3] * sg); g0.z = pk2bf(q[4] * sg, q[5] * sg); g0.w = pk2bf(q[6] * sg, q[7] * sg);
                g1.x = pk2bf(q[8] * sg, q[9] * sg); g1.y = pk2bf(q[10] * sg, q[11] * sg); g1.z = pk2bf(q[12] * sg, q[13] * sg); g1.w = pk2bf(q[14] * sg, q[15] * sg);
                *(LAS u32x4_t*)(lds + O_QS + lds_off16(r, 2 * seg)) = a0; *(LAS u32x4_t*)(lds + O_QS + lds_off16(r, 2 * seg + 1)) = a1;
                bf16* dst = DQG + (size_t)item * 8192 + r * 128 + seg * 16; *(u32x4_t*)dst = g0; *(u32x4_t*)(dst + 8) = g1;
            }
            {
                u32x4_t a0, a1; const float* k = v3[1];
                a0.x = pk2bf(k[0], k[1]); a0.y = pk2bf(k[2], k[3]); a0.z = pk2bf(k[4], k[5]); a0.w = pk2bf(k[6], k[7]);
                a1.x = pk2bf(k[8], k[9]); a1.y = pk2bf(k[10], k[11]); a1.z = pk2bf(k[12], k[13]); a1.w = pk2bf(k[14], k[15]);
                *(LAS u32x4_t*)(lds + O_KN + lds_off16(r, 2 * seg)) = a0; *(LAS u32x4_t*)(lds + O_KN + lds_off16(r, 2 * seg + 1)) = a1;
                u32x4_t d0, d1;
                d0.x = pk2bf(k[0] * edec, k[1] * edec); d0.y = pk2bf(k[2] * edec, k[3] * edec); d0.z = pk2bf(k[4] * edec, k[5] * edec); d0.w = pk2bf(k[6] * edec, k[7] * edec);
                d1.x = pk2bf(k[8] * edec, k[9] * edec); d1.y = pk2bf(k[10] * edec, k[11] * edec); d1.z = pk2bf(k[12] * edec, k[13] * edec); d1.w = pk2bf(k[14] * edec, k[15] * edec);
                *(LAS u32x4_t*)(KD + r * 136 + seg * 16) = d0; *(LAS u32x4_t*)(KD + r * 136 + seg * 16 + 8) = d1;
                const float bw = beta * egc;
#pragma unroll
                for (int i = 0; i < 4; ++i) *(LAS f32x4*)(RHS + r * 256 + 128 + seg * 16 + 4 * i) = (f32x4){k[4 * i] * bw, k[4 * i + 1] * bw, k[4 * i + 2] * bw, k[4 * i + 3] * bw};
            }
            {
                const float* v = v3[2];
#pragma unroll
                for (int i = 0; i < 4; ++i) *(LAS f32x4*)(RHS + r * 256 + seg * 16 + 4 * i) = (f32x4){v[4 * i] * beta, v[4 * i + 1] * beta, v[4 * i + 2] * beta, v[4 * i + 3] * beta};
            }
        }
        __syncthreads();
        {
            const int rb = wave & 3;
            bf16x8_t xf[4];
#pragma unroll
            for (int s4 = 0; s4 < 4; ++s4) xf[s4] = ldfrag(lds + O_KN + lds_off16(16 * rb + fr, 4 * s4 + fq));
#pragma unroll
            for (int cb = 0; cb < 4; ++cb) {
                f32x4 acc = {0.f, 0.f, 0.f, 0.f};
                const int yoff = (wave < 4) ? O_KN : O_QS;
#pragma unroll
                for (int s4 = 0; s4 < 4; ++s4) { const bf16x8_t yf = ldfrag(lds + yoff + lds_off16(16 * cb + fr, 4 * s4 + fq)); acc = __builtin_amdgcn_mfma_f32_16x16x32_bf16(xf[s4], yf, acc, 0, 0, 0); }
                const int xr0 = 16 * rb + 4 * fq, yr = 16 * cb + fr;
                const f32x4 gx = *(const LAS f32x4*)(GC + xr0); const float gy = GC[yr];
                if (wave < 4) {
                    const f32x4 bx = *(const LAS f32x4*)(GC + 64 + xr0);
                    f32x4 o;
#pragma unroll
                    for (int r = 0; r < 4; ++r) { const bool m = xr0 + r > yr; const float dec = __expf(m ? gx[r] - gy : 0.f); o[r] = m ? bx[r] * acc[r] * dec : 0.f; }
                    *(LAS f32x4*)(AM + ((xr0 >> 2) * 64 + yr) * 4) = o;
                } else {
                    float o[4];
#pragma unroll
                    for (int r = 0; r < 4; ++r) { const bool m = yr >= xr0 + r; const float dec = __expf(m ? gy - gx[r] : 0.f); o[r] = m ? acc[r] * dec : 0.f; }
                    u32x2_t w; w.x = pk2bf(o[0], o[1]); w.y = pk2bf(o[2], o[3]);
                    *(u32x2_t*)(DATT + (size_t)item * 4096 + yr * 64 + xr0) = w;
                }
            }
        }
        __syncthreads();
        if (tid < 256) {
            const int c = tid;
            float x[64];
#pragma unroll
            for (int blk = 0; blk < 16; ++blk) {
                float s0 = RHS[(4 * blk + 0) * 256 + c], s1 = RHS[(4 * blk + 1) * 256 + c], s2 = RHS[(4 * blk + 2) * 256 + c], s3 = RHS[(4 * blk + 3) * 256 + c];
#pragma unroll
                for (int j0 = 0; j0 < 4 * blk; j0 += 16) {
                    f32x4 a[16];
#pragma unroll
                    for (int q = 0; q < 16; ++q) if (j0 + q < 4 * blk) a[q] = *(const LAS f32x4*)(AM + (blk * 64 + j0 + q) * 4);
#pragma unroll
                    for (int q = 0; q < 16; ++q) if (j0 + q < 4 * blk) { const float xv = x[j0 + q]; s0 -= a[q][0] * xv; s1 -= a[q][1] * xv; s2 -= a[q][2] * xv; s3 -= a[q][3] * xv; }
                }
                const f32x4 t0 = *(const LAS f32x4*)(AM + (blk * 64 + 4 * blk) * 4), t1 = *(const LAS f32x4*)(AM + (blk * 64 + 4 * blk + 1) * 4), t2 = *(const LAS f32x4*)(AM + (blk * 64 + 4 * blk + 2) * 4);
                x[4 * blk] = s0;
                s1 -= t0[1] * s0; s2 -= t0[2] * s0; s3 -= t0[3] * s0;
                x[4 * blk + 1] = s1;
                s2 -= t1[2] * s1; s3 -= t1[3] * s1;
                x[4 * blk + 2] = s2;
                s3 -= t2[3] * s2;
                x[4 * blk + 3] = s3;
            }
            if (c < 128) {
#pragma unroll
                for (int i = 0; i < 64; ++i) DU[(size_t)item * 8192 + i * 128 + c] = x[i];
            } else {
#pragma unroll
                for (int i = 0; i < 64; ++i) DW[(size_t)item * 8192 + i * 128 + (c - 128)] = (bf16)f2bf(x[i]);
            }
        } else {
            const int tt = tid - 256, d = tt >> 1, c0 = (tt & 1) * 32;
            unsigned w[16];
#pragma unroll
            for (int i = 0; i < 16; ++i) w[i] = (unsigned)KD[(c0 + 2 * i) * 136 + d] | ((unsigned)KD[(c0 + 2 * i + 1) * 136 + d] << 16);
            bf16* dst = DKDT + (size_t)item * 8192 + d * 64 + c0;
#pragma unroll
            for (int i = 0; i < 4; ++i) *(u32x4_t*)(dst + 8 * i) = (u32x4_t){w[4 * i], w[4 * i + 1], w[4 * i + 2], w[4 * i + 3]};
        }
        __syncthreads();
    }
}

__device__ void ph_dnscan(int wv, const Params& p, LAS unsigned char* lds, int sbid, int nsb) {
    const int tid = opaque_tid(), lane = tid & 63, wave = wv, fr = lane & 15, fq = lane >> 4;
    const bf16* DW = (const bf16*)(p.ws + WS_DW); const bf16* DQG = (const bf16*)(p.ws + WS_DQG); const bf16* DKDT = (const bf16*)(p.ws + WS_DKDT); const bf16* DATT = (const bf16*)(p.ws + WS_DATT);
    const float* DU = (const float*)(p.ws + WS_DU); const float* DEGL = (const float*)(p.ws + WS_DEGL);
    float* ORAW = (float*)(p.ws + WS_ORAW);
    constexpr int BUF = 57344, O_W = 0, O_QG = 16384, O_KDT = 32768, O_ATT = 49152, O_SB = 114688, O_VNT = 131072;
    const int cb = wave >> 1, eb = wave & 1;
    for (int it = sbid; it < 128; it += nsb) {
        const int bh = (it & 7) * 4 + (it >> 5), es = (it >> 3) & 3, b = bh >> 2, h = bh & 3, e0 = es * 32, item0 = bh * 32;
        f32x4 st[2] = {{0.f, 0.f, 0.f, 0.f}, {0.f, 0.f, 0.f, 0.f}};
        *(LAS u32x4_t*)(lds + O_SB + tid * 16) = (u32x4_t){0u, 0u, 0u, 0u};
        u32x4_t rg[7]; float un[4]; float egl_n;
#define DN_LOAD(itm) do { const size_t _o = (size_t)(itm) * 8192; \
            rg[0] = *(const u32x4_t*)(DW + _o + (size_t)tid * 8); rg[1] = *(const u32x4_t*)(DW + _o + (size_t)(tid + 512) * 8); \
            rg[2] = *(const u32x4_t*)(DQG + _o + (size_t)tid * 8); rg[3] = *(const u32x4_t*)(DQG + _o + (size_t)(tid + 512) * 8); \
            rg[4] = *(const u32x4_t*)(DKDT + _o + (size_t)tid * 8); rg[5] = *(const u32x4_t*)(DKDT + _o + (size_t)(tid + 512) * 8); \
            rg[6] = *(const u32x4_t*)(DATT + (size_t)(itm) * 4096 + (size_t)tid * 8); \
            _Pragma("unroll") for (int _r = 0; _r < 4; ++_r) un[_r] = DU[_o + (size_t)(16 * cb + 4 * fq + _r) * 128 + e0 + 16 * eb + fr]; \
            egl_n = DEGL[(itm)]; } while (0)
#define DN_STORE(bufo) do { LAS unsigned char* _b = lds + (bufo); \
            *(LAS u32x4_t*)(_b + O_W + lds_off16(tid >> 4, tid & 15)) = rg[0]; *(LAS u32x4_t*)(_b + O_W + lds_off16((tid + 512) >> 4, tid & 15)) = rg[1]; \
            *(LAS u32x4_t*)(_b + O_QG + lds_off16(tid >> 4, tid & 15)) = rg[2]; *(LAS u32x4_t*)(_b + O_QG + lds_off16((tid + 512) >> 4, tid & 15)) = rg[3]; \
            *(LAS u32x4_t*)(_b + O_KDT + lds_off8(tid >> 3, tid & 7)) = rg[4]; *(LAS u32x4_t*)(_b + O_KDT + lds_off8((tid + 512) >> 3, tid & 7)) = rg[5]; \
            *(LAS u32x4_t*)(_b + O_ATT + lds_off8(tid >> 3, tid & 7)) = rg[6]; } while (0)
        DN_LOAD(item0);
        DN_STORE(0);
        float u[4] = {un[0], un[1], un[2], un[3]}; float egl = egl_n;
        __syncthreads();
        for (int n = 0; n < 32; ++n) {
            const int bufo = (n & 1) * BUF, sbo = O_SB + (n & 1) * 8192, sbn = O_SB + ((n + 1) & 1) * 8192;
            if (n < 31) DN_LOAD(item0 + n + 1);
            f32x4 acc = {0.f, 0.f, 0.f, 0.f};
            bf16x8_t sf[4];
#pragma unroll
            for (int s4 = 0; s4 < 4; ++s4) sf[s4] = ldfrag(lds + sbo + lds_off16(16 * eb + fr, 4 * s4 + fq));
#pragma unroll
            for (int s4 = 0; s4 < 4; ++s4) acc = __builtin_amdgcn_mfma_f32_16x16x32_bf16(ldfrag(lds + bufo + O_W + lds_off16(16 * cb + fr, 4 * s4 + fq)), sf[s4], acc, 0, 0, 0);
            {
                const float v0 = u[0] - acc[0], v1 = u[1] - acc[1], v2 = u[2] - acc[2], v3 = u[3] - acc[3];
                u32x2_t w; w.x = pk2bf(v0, v1); w.y = pk2bf(v2, v3);
                *(LAS u32x2_t*)(lds + O_VNT + lds_off8(16 * eb + fr, 2 * cb + (fq >> 1)) + 8 * (fq & 1)) = w;
            }
            __syncthreads();
            f32x4 oacc = {0.f, 0.f, 0.f, 0.f};
#pragma unroll
            for (int s4 = 0; s4 < 4; ++s4) oacc = __builtin_amdgcn_mfma_f32_16x16x32_bf16(ldfrag(lds + bufo + O_QG + lds_off16(16 * cb + fr, 4 * s4 + fq)), sf[s4], oacc, 0, 0, 0);
            bf16x8_t vf[2][2];
#pragma unroll
            for (int e2 = 0; e2 < 2; ++e2)
#pragma unroll
                for (int s2 = 0; s2 < 2; ++s2) vf[e2][s2] = ldfrag(lds + O_VNT + lds_off8(16 * e2 + fr, 4 * s2 + fq));
#pragma unroll
            for (int s2 = 0; s2 < 2; ++s2) oacc = __builtin_amdgcn_mfma_f32_16x16x32_bf16(ldfrag(lds + bufo + O_ATT + lds_off8(16 * cb + fr, 4 * s2 + fq)), ldfrag(lds + O_VNT + lds_off8(16 * eb + fr, 4 * s2 + fq)), oacc, 0, 0, 0);
            {
                const size_t t0 = (size_t)b * NS_ + n * 64;
#pragma unroll
                for (int r = 0; r < 4; ++r) ORAW[(t0 + 16 * cb + 4 * fq + r) * 512 + h * 128 + e0 + 16 * eb + fr] = oacc[r];
            }
#pragma unroll
            for (int e2 = 0; e2 < 2; ++e2) {
                st[e2] = st[e2] * egl;
#pragma unroll
                for (int s2 = 0; s2 < 2; ++s2) st[e2] = __builtin_amdgcn_mfma_f32_16x16x32_bf16(ldfrag(lds + bufo + O_KDT + lds_off8(16 * wave + fr, 4 * s2 + fq)), vf[e2][s2], st[e2], 0, 0, 0);
                u32x2_t w; w.x = pk2bf(st[e2][0], st[e2][1]); w.y = pk2bf(st[e2][2], st[e2][3]);
                *(LAS u32x2_t*)(lds + sbn + lds_off16(16 * e2 + fr, 2 * wave + (fq >> 1)) + 8 * (fq & 1)) = w;
            }
            if (n < 31) { DN_STORE(((n + 1) & 1) * BUF); u[0] = un[0]; u[1] = un[1]; u[2] = un[2]; u[3] = un[3]; egl = egl_n; }
            __syncthreads();
        }
#undef DN_LOAD
#undef DN_STORE
        {
            unsigned* flag = (unsigned*)(p.ws + WS_CTL) + CW_DNF + 64 * bh;
            asm volatile("s_waitcnt vmcnt(0)" ::: "memory");
            __syncthreads();
            if (tid == 0) {
                __builtin_amdgcn_fence(__ATOMIC_RELEASE, "agent");
                asm volatile("s_waitcnt vmcnt(0)" ::: "memory");
                __hip_atomic_fetch_add(flag, 1u, __ATOMIC_RELAXED, __HIP_MEMORY_SCOPE_AGENT);
                unsigned sp = 0;
                while (__hip_atomic_load(flag, __ATOMIC_RELAXED, __HIP_MEMORY_SCOPE_AGENT) < 4u) { __builtin_amdgcn_s_sleep(2); if (++sp > (1u << 22)) break; }
                __builtin_amdgcn_fence(__ATOMIC_ACQUIRE, "agent");
                asm volatile("s_waitcnt vmcnt(0)" ::: "memory");
            }
            __syncthreads();
            const bf16* PROJ = (const bf16*)(p.ws + WS_PROJ); bf16* MIXED = (bf16*)(p.ws + WS_MIXED);
            const float2 nw = *(const float2*)(p.in[10] + 2 * lane);
            const int tq0 = b * NS_ + es * 512 + (tid >> 6) * 64;
#pragma unroll 1
            for (int i0 = 0; i0 < 64; i0 += 8) {
                float2 o[8]; unsigned zz[8];
#pragma unroll
                for (int q = 0; q < 8; ++q) { const size_t t = (size_t)(tq0 + i0 + q); o[q] = *(const float2*)(ORAW + t * 512 + h * 128 + 2 * lane); zz[q] = *(const unsigned*)(PROJ + t * PJ + 1536 + h * 128 + 2 * lane); }
#pragma unroll
                for (int q = 0; q < 8; ++q) {
                    const float ss = wave_sum(o[q].x * o[q].x + o[q].y * o[q].y);
                    const float r = rsqrtf(ss * (1.f / 128.f) + EPS);
                    const float m0 = o[q].x * r * nw.x * siluf_(bf2f(zz[q] & 0xffffu)), m1 = o[q].y * r * nw.y * siluf_(bf2f(zz[q] >> 16));
                    *(unsigned*)(MIXED + (size_t)(tq0 + i0 + q) * D_ + h * 128 + 2 * lane) = f2bf(m0) | (f2bf(m1) << 16);
                }
            }
        }
    }
}

__device__ void ph_cf(int wv, const Params& p, LAS float* lds, int bid, int nb) {
    const int tid = opaque_tid(), lane = tid & 63, wave = tid >> 6;
    const bf16* PROJ = (const bf16*)(p.ws + WS_PROJ);
    const float* pwb = p.in[11]; const float* dww = p.in[12]; const float* dwb = p.in[13]; const float* lnw = p.in[14]; const float* lnb = p.in[15];
    bf16* MIXED = (bf16*)(p.ws + WS_MIXED);
    constexpr int TT = 32;
    const int c = tid;
    float w[CFK];
#pragma unroll
    for (int j = 0; j < CFK; ++j) w[j] = dww[j * CFW + c];
    const float ba = pwb[c], bg = pwb[512 + c], cb = dwb[c];
    for (int it = bid; it < T_ / TT; it += nb) {
        const int t0 = it * TT, tl0 = t0 % NS_;
        float xg[TT + CFK - 1];
#pragma unroll
        for (int i0 = 0; i0 < TT + CFK - 1; i0 += 16) {
            unsigned ra[16], rg[16];
#pragma unroll
            for (int q = 0; q < 16; ++q) if (i0 + q < TT + CFK - 1) {
                const int tl = tl0 - (CFK - 1) + i0 + q;
                const size_t row = (size_t)(t0 - (CFK - 1) + i0 + q + (tl < 0 ? -tl : 0));
                ra[q] = PROJ[row * PJ + 2048 + c]; rg[q] = PROJ[row * PJ + 2560 + c];
            } else { ra[q] = 0; rg[q] = 0; }
            asm volatile("" : "+v"(ra[0]), "+v"(ra[1]), "+v"(ra[2]), "+v"(ra[3]), "+v"(ra[4]), "+v"(ra[5]), "+v"(ra[6]), "+v"(ra[7]), "+v"(ra[8]), "+v"(ra[9]), "+v"(ra[10]), "+v"(ra[11]), "+v"(ra[12]), "+v"(ra[13]), "+v"(ra[14]), "+v"(ra[15]));
            asm volatile("" : "+v"(rg[0]), "+v"(rg[1]), "+v"(rg[2]), "+v"(rg[3]), "+v"(rg[4]), "+v"(rg[5]), "+v"(rg[6]), "+v"(rg[7]), "+v"(rg[8]), "+v"(rg[9]), "+v"(rg[10]), "+v"(rg[11]), "+v"(rg[12]), "+v"(rg[13]), "+v"(rg[14]), "+v"(rg[15]));
#pragma unroll
            for (int q = 0; q < 16; ++q) if (i0 + q < TT + CFK - 1) {
                const int tl = tl0 - (CFK - 1) + i0 + q;
                const float a = bf2f(ra[q]) + ba, gt = bf2f(rg[q]) + bg;
                xg[i0 + q] = tl >= 0 ? a * sigmoidf_(gt) : 0.f;
            }
        }
        __syncthreads();
#pragma unroll
        for (int r = 0; r < TT; ++r) {
            float s = cb;
#pragma unroll
            for (int j = 0; j < CFK; ++j) s += w[j] * xg[r + j];
            lds[r * 512 + c] = s;
        }
        __syncthreads();
#pragma unroll
        for (int rr = 0; rr < 4; ++rr) {
            const int r = wave * 4 + rr;
            float v[8]; float s = 0.f;
#pragma unroll
            for (int j = 0; j < 8; ++j) { v[j] = lds[r * 512 + lane + 64 * j]; s += v[j]; }
            const float mu = wave_sum(s) * (1.f / 512.f);
            float q = 0.f;
#pragma unroll
            for (int j = 0; j < 8; ++j) { v[j] -= mu; q += v[j] * v[j]; }
            const float rstd = rsqrtf(wave_sum(q) * (1.f / 512.f) + EPS);
#pragma unroll
            for (int j = 0; j < 8; ++j) { const int cc = lane + 64 * j; const float y = v[j] * rstd * lnw[cc] + lnb[cc]; MIXED[(size_t)(t0 + r) * D_ + 512 + cc] = (bf16)f2bf(siluf_(y)); }
        }
    }
}

__device__ __forceinline__ void ph_outproj(int wv, const Params& p, LAS unsigned char* lds, int bid, int nb) {
    pg8::DenseSched S; S.init(p.ws + WS_MIXED, p.ws + WS_WOUTT, T_, D_, D_, nb, bid);
    pg8::EpiBf16 E{(bf16*)(p.ws + WS_HMIX), D_};
    pg8::gemm_phase(wv, lds, S, E);
}

struct Row2Par { f32x4 g1n[4], a2[4], b2[4]; };
__device__ __forceinline__ void row2_front(const Params& p, LAS unsigned char* lds, int t, int lr, int lane, const f32x4 (&hm)[4], const f32x4 (&xv)[4], const Row2Par& P) {
    bf16* H2 = (bf16*)(p.ws + WS_H);
    float ss = 0.f;
#pragma unroll
    for (int j = 0; j < 4; ++j) ss += hm[j][0] * hm[j][0] + hm[j][1] * hm[j][1] + hm[j][2] * hm[j][2] + hm[j][3] * hm[j][3];
    ss = wave_sum(ss);
    const float r1 = rsqrtf(ss * (1.f / D_) + EPS);
    f32x4 x1[4]; float s2 = 0.f;
#pragma unroll
    for (int j = 0; j < 4; ++j) {
        const int c0 = 4 * lane + 256 * j;
        x1[j] = xv[j] + P.g1n[j] * (hm[j] * r1);
        s2 += x1[j][0] * x1[j][0] + x1[j][1] * x1[j][1] + x1[j][2] * x1[j][2] + x1[j][3] * x1[j][3];
        *(f32x4*)(p.out + (size_t)t * D_ + c0) = x1[j];
    }
    s2 = wave_sum(s2);
    const float r2 = rsqrtf(s2 * (1.f / D_) + EPS);
#pragma unroll
    for (int j = 0; j < 4; ++j) {
        const int c0 = 4 * lane + 256 * j;
        const f32x4 h = x1[j] * r2 * P.a2[j] + P.b2[j];
        unsigned hi[4]; float lo[4];
#pragma unroll
        for (int i = 0; i < 4; ++i) { hi[i] = f2bf(h[i]); lo[i] = h[i] - bf2f(hi[i]); }
        u32x2_t wh; wh.x = hi[0] | (hi[1] << 16); wh.y = hi[2] | (hi[3] << 16);
        u32x2_t wl; wl.x = pk2bf(lo[0], lo[1]); wl.y = pk2bf(lo[2], lo[3]);
        *(u32x2_t*)(H2 + (size_t)t * D_ + c0) = wh;
        const int ch = c0 >> 3, off = lr * 2048 + ((ch ^ (lr & 15)) << 4) + (c0 & 7) * 2;
        *(LAS u32x2_t*)(lds + off) = wh; *(LAS u32x2_t*)(lds + 65536 + off) = wl;
    }
}
__device__ void ph_row2(int wv, const Params& p, LAS unsigned char* lds, int bid, int nb) {
    const int tid = opaque_tid(), lane = tid & 63, wave = __builtin_amdgcn_readfirstlane(tid >> 6), fr = lane & 15, fq = lane >> 4;
    const float* x = p.in[0]; const float* brg = p.in[20]; const float* bre = p.in[22];
    const bf16* HMIX = (const bf16*)(p.ws + WS_HMIX);
    const bf16* WRTH = (const bf16*)(p.ws + WS_WRTH); const bf16* WRTL = (const bf16*)(p.ws + WS_WRTL);
    int* ROUTE = (int*)(p.ws + WS_ROUTE); int* POS = (int*)(p.ws + WS_POS); int* TOKL = (int*)(p.ws + WS_TOKL); float* WL = (float*)(p.ws + WS_WL);
    unsigned* cnt = (unsigned*)(p.ws + WS_CTL) + CW_CNT;
    LAS float* PART = (LAS float*)lds;
    LAS float* LOG = (LAS float*)(lds + 131072);
    LAS int* rte = (LAS int*)(lds + 131072 + 10240); LAS int* rtr = rte + 128; LAS float* rtw = (LAS float*)(rtr + 128); LAS int* lcnt = (LAS int*)(rtw + 128); LAS int* lbase = lcnt + 64;
    if (tid < 64) lcnt[tid] = 0;
    __syncthreads();
    for (int chunk = bid; chunk < T_ / 64; chunk += nb) {
#pragma unroll 1
        for (int pass = 0; pass < 2; ++pass) {
            Row2Par P;
            { int lo_ = lane; asm volatile("" : "+v"(lo_));
              const float* mod = (const float*)(p.ws + WS_MOD) + ((chunk * 64) / NS_) * 6144;
#pragma unroll
              for (int j = 0; j < 4; ++j) { const int c0 = 4 * lo_ + 256 * j;
                  P.g1n[j] = *(const f32x4*)(mod + 2048 + c0) * *(const f32x4*)(p.in[5] + c0);
                  P.a2[j] = *(const f32x4*)(p.in[17] + c0) * (*(const f32x4*)(mod + 4096 + c0) + 1.f);
                  P.b2[j] = *(const f32x4*)(mod + 3072 + c0); } }
            const int tb = chunk * 64 + pass * 32 + wave * 4;
            f32x4 hmA[4], xvA[4], hmB[4], xvB[4];
#define R2_LOAD(hm, xv, t) do { _Pragma("unroll") for (int j = 0; j < 4; ++j) { const u32x2_t _h = *(const u32x2_t*)(HMIX + (size_t)(t) * D_ + 4 * lane + 256 * j); hm[j] = (f32x4){bf2f(_h.x & 0xffffu), bf2f(_h.x >> 16), bf2f(_h.y & 0xffffu), bf2f(_h.y >> 16)}; xv[j] = *(const f32x4*)(x + (size_t)(t) * D_ + 4 * lane + 256 * j); } } while (0)
            R2_LOAD(hmA, xvA, tb); R2_LOAD(hmB, xvB, tb + 1);
            row2_front(p, lds, tb, wave * 4, lane, hmA, xvA, P);
            R2_LOAD(hmA, xvA, tb + 2);
            row2_front(p, lds, tb + 1, wave * 4 + 1, lane, hmB, xvB, P);
            R2_LOAD(hmB, xvB, tb + 3);
            row2_front(p, lds, tb + 2, wave * 4 + 2, lane, hmA, xvA, P);
            row2_front(p, lds, tb + 3, wave * 4 + 3, lane, hmB, xvB, P);
#undef R2_LOAD
            __syncthreads();
            f32x4 acc[2][5];
#pragma unroll
            for (int mb = 0; mb < 2; ++mb)
#pragma unroll
                for (int n5 = 0; n5 < 5; ++n5) acc[mb][n5] = (f32x4){0.f, 0.f, 0.f, 0.f};
            bf16x8_t bh[1][5], bl[1][5];
#define R2_BLOAD(buf, s4) do { const int _ks = wave * 4 + (s4); _Pragma("unroll") for (int n5 = 0; n5 < 5; ++n5) { \
                bh[buf][n5] = *(const bf16x8_t*)(WRTH + (size_t)(16 * n5 + fr) * 1024 + _ks * 32 + fq * 8); bl[buf][n5] = *(const bf16x8_t*)(WRTL + (size_t)(16 * n5 + fr) * 1024 + _ks * 32 + fq * 8); } } while (0)
#define R2_BFORCE(buf) do { asm volatile("" : "+v"(bh[buf][0]), "+v"(bh[buf][1]), "+v"(bh[buf][2]), "+v"(bh[buf][3]), "+v"(bh[buf][4]), "+v"(bl[buf][0]), "+v"(bl[buf][1]), "+v"(bl[buf][2]), "+v"(bl[buf][3]), "+v"(bl[buf][4])); } while (0)
#pragma unroll
            for (int s4 = 0; s4 < 4; ++s4) {
                const int ks = wave * 4 + s4;
                R2_BLOAD(0, s4);
                bf16x8_t ah[2], al[2];
#pragma unroll
                for (int mb = 0; mb < 2; ++mb) { const int r = 16 * mb + fr, off = r * 2048 + (((4 * ks + fq) ^ (r & 15)) << 4); ah[mb] = ldfrag(lds + off); al[mb] = ldfrag(lds + 65536 + off); }
                R2_BFORCE(0);
#pragma unroll
                for (int n5 = 0; n5 < 5; ++n5) {
#pragma unroll
                    for (int mb = 0; mb < 2; ++mb) {
                        acc[mb][n5] = __builtin_amdgcn_mfma_f32_16x16x32_bf16(ah[mb], bh[0][n5], acc[mb][n5], 0, 0, 0);
                        acc[mb][n5] = __builtin_amdgcn_mfma_f32_16x16x32_bf16(al[mb], bh[0][n5], acc[mb][n5], 0, 0, 0);
                        acc[mb][n5] = __builtin_amdgcn_mfma_f32_16x16x32_bf16(ah[mb], bl[0][n5], acc[mb][n5], 0, 0, 0);
                    }
                }
            }
#undef R2_BLOAD
#undef R2_BFORCE
            __syncthreads();
            { const int l2 = lane_id_v(), fq2 = l2 >> 4, fr2 = l2 & 15;
#pragma unroll
            for (int mb = 0; mb < 2; ++mb)
#pragma unroll
                for (int n5 = 0; n5 < 5; ++n5)
#pragma unroll
                    for (int r = 0; r < 4; ++r) PART[(wave * 32 + 16 * mb + 4 * fq2 + r) * 80 + 16 * n5 + fr2] = acc[mb][n5][r]; }
            __syncthreads();
            const int tid3 = opaque_tid();
            for (int i = tid3; i < 2560; i += NTHR) { float a = 0.f;
#pragma unroll
                for (int w = 0; w < 8; ++w) a += PART[w * 2560 + i];
                LOG[i] = a; }
            __syncthreads();
            if (tid3 < 32) {
                const LAS float* lg = LOG + tid3 * 80;
                float gmax = -3.0e38f; int gi = 0; float gl[8];
#pragma unroll
                for (int o = 0; o < 8; ++o) { gl[o] = lg[o] + brg[o]; if (gl[o] > gmax) { gmax = gl[o]; gi = o; } }
                float gden = 0.f;
#pragma unroll
                for (int o = 0; o < 8; ++o) gden += __expf(gl[o] - gmax);
                const float gp = 1.f / gden;
                float m1 = -3.0e38f, m2 = -3.0e38f; int i1 = 0, i2 = 0; float el[8];
#pragma unroll
                for (int o = 0; o < 8; ++o) el[o] = lg[16 + gi * 8 + o] + bre[gi * 8 + o];
#pragma unroll
                for (int o = 0; o < 8; ++o) { if (el[o] > m1) { m1 = el[o]; i1 = o; } }
#pragma unroll
                for (int o = 0; o < 8; ++o) { if (o != i1 && el[o] > m2) { m2 = el[o]; i2 = o; } }
                const float e2 = __expf(m2 - m1);
                const int lr = pass * 32 + tid3, ea = gi * 8 + i1, eb = gi * 8 + i2;
                rte[2 * lr] = ea; rte[2 * lr + 1] = eb;
                rtw[2 * lr] = gp * (1.f / (1.f + e2)); rtw[2 * lr + 1] = gp * (e2 / (1.f + e2));
                rtr[2 * lr] = __hip_atomic_fetch_add(lcnt + ea, 1, __ATOMIC_RELAXED, __HIP_MEMORY_SCOPE_WORKGROUP); rtr[2 * lr + 1] = __hip_atomic_fetch_add(lcnt + eb, 1, __ATOMIC_RELAXED, __HIP_MEMORY_SCOPE_WORKGROUP);
            }
            __syncthreads();
        }
        const int tq = opaque_tid();
        if (tq < 64) { const int c = lcnt[tq]; lbase[tq] = c > 0 ? (int)atomicAdd(cnt + tq, (unsigned)c) : 0; }
        __syncthreads();
        if (tq < 128) {
            const int e = rte[tq], pos = lbase[e] + rtr[tq], t = chunk * 64 + (tq >> 1);
            ROUTE[(size_t)t * 4 + (tq & 1)] = e; POS[(size_t)t * 2 + (tq & 1)] = pos;
            TOKL[(size_t)e * T_ + pos] = t; WL[(size_t)e * T_ + pos] = rtw[tq];
        }
        __syncthreads();
        if (tq < 64) lcnt[tq] = 0;
        __syncthreads();
    }
}

struct MoeMap { LAS int* tstart; LAS int* cnt; int total_tiles; };
__device__ __forceinline__ MoeMap moe_map(int wv, const Params& p, LAS int* l) {
    const unsigned* cnt = (const unsigned*)(p.ws + WS_CTL) + CW_CNT;
    __syncthreads();
    if (wv == 0) {
        const int e = lane_id_v();
        const int c = (int)__hip_atomic_load(cnt + e, __ATOMIC_RELAXED, __HIP_MEMORY_SCOPE_AGENT);
        const int nt = (c + TM - 1) / TM; int incl = nt;
#pragma unroll
        for (int o = 1; o < 64; o <<= 1) { const int y = __shfl_up(incl, o); if (e >= o) incl += y; }
        l[e] = incl - nt; l[128 + e] = c; if (e == 63) l[NE] = incl;
    }
    __syncthreads();
    MoeMap m; m.tstart = l; m.cnt = l + 128; m.total_tiles = l[NE];
    return m;
}
__device__ __forceinline__ int moe_find(const MoeMap& m, int tile) { int e = 0; while (e < NE - 1 && m.tstart[e + 1] <= tile) ++e; return e; }

__device__ __forceinline__ void ph_moe_gu(int wv, const Params& p, LAS unsigned char* lds, int bid, int nb) {
    MoeMap mm = moe_map(wv, p, (LAS int*)(lds + pg8::STAGE_BYTES));
    pg8::GroupSched S{(const char*)(p.ws + WS_H), (const char*)(p.ws + WS_WGUT), D_, 4, (size_t)2 * DE * D_ * 2, mm.tstart, mm.cnt, mm.total_tiles, nb, bid, (const int*)(p.ws + WS_TOKL)};
    pg8::EpiGU E{(bf16*)(p.ws + WS_HID)};
    pg8::gemm_phase(wv, lds, S, E);
}
__device__ __forceinline__ void ph_moe_down(int wv, const Params& p, LAS unsigned char* lds, int bid, int nb) {
    MoeMap mm = moe_map(wv, p, (LAS int*)(lds + pg8::STAGE_BYTES));
    pg8::GroupSched S{(const char*)(p.ws + WS_HID), (const char*)(p.ws + WS_WDNT), DE, 4, (size_t)D_ * DE * 2, mm.tstart, mm.cnt, mm.total_tiles, nb, bid, nullptr};
    pg8::EpiDown E{(bf16*)(p.ws + WS_Y), (const float*)(p.ws + WS_WL), mm.cnt};
    pg8::gemm_phase(wv, lds, S, E);
}

__device__ void ph_final(int wv, const Params& p, LAS float* lds, int bid, int nb) {
    const int tid = opaque_tid(), lane = tid & 63, wave = tid >> 6;
    const float* npf = p.in[18]; const float* mod = (const float*)(p.ws + WS_MOD);
    const bf16* Y = (const bf16*)(p.ws + WS_Y); const int* ROUTE = (const int*)(p.ws + WS_ROUTE); const int* POS = (const int*)(p.ws + WS_POS);
    MoeMap mm = moe_map(wv, p, (LAS int*)lds);
    for (int t = bid * 8 + wave; t < T_; t += nb * 8) {
        const int b = t / NS_;
        const int ea = ROUTE[(size_t)t * 4], eb = ROUTE[(size_t)t * 4 + 1];
        const size_t ga = (size_t)mm.tstart[ea] * TM + POS[(size_t)t * 2], gb = (size_t)mm.tstart[eb] * TM + POS[(size_t)t * 2 + 1];
        float m[16]; float ss = 0.f;
#pragma unroll
        for (int j = 0; j < 4; ++j) {
            const uint2 a = *(const uint2*)(Y + ga * D_ + 4 * lane + 256 * j), bb = *(const uint2*)(Y + gb * D_ + 4 * lane + 256 * j);
            m[4 * j] = bf2f(a.x & 0xffffu) + bf2f(bb.x & 0xffffu); m[4 * j + 1] = bf2f(a.x >> 16) + bf2f(bb.x >> 16);
            m[4 * j + 2] = bf2f(a.y & 0xffffu) + bf2f(bb.y & 0xffffu); m[4 * j + 3] = bf2f(a.y >> 16) + bf2f(bb.y >> 16);
#pragma unroll
            for (int i = 0; i < 4; ++i) ss += m[4 * j + i] * m[4 * j + i];
        }
        ss = wave_sum(ss);
        const float r = rsqrtf(ss * (1.f / D_) + EPS);
#pragma unroll
        for (int j = 0; j < 4; ++j) {
            const int c0 = 4 * lane + 256 * j;
            float4 o = *(float4*)(p.out + (size_t)t * D_ + c0);
            o.x += mod[b * 6144 + 5120 + c0] * (m[4 * j] * r * npf[c0]);
            o.y += mod[b * 6144 + 5120 + c0 + 1] * (m[4 * j + 1] * r * npf[c0 + 1]);
            o.z += mod[b * 6144 + 5120 + c0 + 2] * (m[4 * j + 2] * r * npf[c0 + 2]);
            o.w += mod[b * 6144 + 5120 + c0 + 3] * (m[4 * j + 3] * r * npf[c0 + 3]);
            *(float4*)(p.out + (size_t)t * D_ + c0) = o;
        }
    }
}

constexpr int LDS_BYTES = 147456;
#define XB_TMO      128
#define XB_XCNT(j)  (256  + 64 * (j))
#define XB_XSUB(j)  (1280 + 64 * (j))
#define XB_XGEN(j)  (2304 + 64 * (j))
#define XB_TOP      3328
#define XB_TOPGEN   3392
#define XCD_BAR_WORDS 3456
#define XB_SPIN_CAP (1u << 22)
__device__ __forceinline__ unsigned xb_ld(unsigned* p)              { return __hip_atomic_load(p, __ATOMIC_RELAXED, __HIP_MEMORY_SCOPE_AGENT); }
__device__ __forceinline__ unsigned xb_add(unsigned* p, unsigned v) { return __hip_atomic_fetch_add(p, v, __ATOMIC_RELAXED, __HIP_MEMORY_SCOPE_AGENT); }
__device__ __forceinline__ unsigned xb_xcc_id() { return (unsigned)__builtin_amdgcn_s_getreg((3 << 11) | 20) & 0xFu; }
#define XB_SPIN(cond, bar) do { unsigned _sp = 0; while (cond) { __builtin_amdgcn_s_sleep(1); \
    if ((++_sp & 255u) == 0u) { if (xb_ld(&(bar)[XB_TMO])) break; if (_sp > XB_SPIN_CAP) { atomicAdd(&(bar)[XB_TMO], 1u); break; } } } } while (0)
struct XcdBarrier { unsigned* bar; unsigned x; volatile LAS unsigned* st; };
__device__ __forceinline__ XcdBarrier xcd_barrier_post(int wv, unsigned* bar, volatile LAS unsigned* st) {
    XcdBarrier b; b.bar = bar; b.x = xb_xcc_id(); b.st = st;
    if (wv == 0 && lane_id_v() == 0) (void)xb_add(&bar[XB_XCNT(b.x)], 1u);
    return b;
}
__device__ __forceinline__ void xcd_barrier_complete(unsigned* bar, unsigned x, unsigned& nloc, unsigned& nx) {
    const unsigned G = gridDim.x * gridDim.y * gridDim.z;
    unsigned sum, cnt, mine, sp = 0u;
    for (;;) {
        sum = 0u; cnt = 0u; mine = 0u;
#pragma unroll
        for (unsigned j = 0; j < 16; ++j) { const unsigned c = xb_ld(&bar[XB_XCNT(j)]); sum += c; cnt += (c > 0u) ? 1u : 0u; mine = (j == x) ? c : mine; }
        if (sum == G) break;
        __builtin_amdgcn_s_sleep(1);
        if ((++sp & 255u) == 0u) { if (xb_ld(&bar[XB_TMO])) break; if (sp > XB_SPIN_CAP) { atomicAdd(&bar[XB_TMO], 1u); break; } }
    }
    nloc = mine > 0u ? mine : 1u; nx = cnt > 0u ? cnt : 1u;
}
__device__ __forceinline__ void xcd_barrier(int wv, unsigned char* ws, volatile LAS unsigned* st) {
    XcdBarrier b; b.bar = (unsigned*)(ws + WS_CTL) + 4096; b.x = xb_xcc_id(); b.st = st;
    asm volatile("s_waitcnt vmcnt(0)" ::: "memory");
    __syncthreads();
    if (wv == 0 && lane_id_v() == 0) {
        unsigned* bar = b.bar;
        __builtin_amdgcn_s_waitcnt(0);
        unsigned nloc = b.st[0], nx = b.st[1];
        if (nloc == 0u) { xcd_barrier_complete(bar, b.x, nloc, nx); b.st[0] = nloc; b.st[1] = nx; }
        const unsigned old = xb_add(&bar[XB_XSUB(b.x)], 1u);
        const unsigned gen = old / nloc;
        if (old + 1u == (gen + 1u) * nloc) {
            __builtin_amdgcn_fence(__ATOMIC_RELEASE, "agent");
            asm volatile("s_waitcnt vmcnt(0)" ::: "memory");
            const unsigned og = xb_add(&bar[XB_TOP], 1u);
            const unsigned tg = og / nx;
            if (og + 1u == (tg + 1u) * nx) xb_add(&bar[XB_TOPGEN], 1u);
            else XB_SPIN(xb_ld(&bar[XB_TOPGEN]) == tg, bar);
            __builtin_amdgcn_fence(__ATOMIC_ACQUIRE, "agent");
            xb_add(&bar[XB_XGEN(b.x)], 1u);
            asm volatile("s_waitcnt vmcnt(0)" ::: "memory");
        } else {
            XB_SPIN(xb_ld(&bar[XB_XGEN(b.x)]) == gen, bar);
            __builtin_amdgcn_fence(__ATOMIC_ACQUIRE, "agent");
            asm volatile("s_waitcnt vmcnt(0)" ::: "memory");
        }
    }
    __syncthreads();
}
constexpr int CW_BAR = 4096;
constexpr int LDS_ST_OFF = LDS_BYTES - 64;

__global__ void __launch_bounds__(NTHR, 2) mk_all(Params p) {
    extern __shared__ __attribute__((aligned(16))) unsigned char lds_raw[];
    LAS float* lds = (LAS float*)lds_raw;
    const int bid = blockIdx.x, nb = gridDim.x;
    volatile LAS unsigned* st = (volatile LAS unsigned*)((LAS unsigned char*)lds_raw + LDS_ST_OFF);
    const int wv = __builtin_amdgcn_readfirstlane(threadIdx.x >> 6);
    if (threadIdx.x < 16) st[threadIdx.x] = 0u;
    __syncthreads();
    (void)xcd_barrier_post(wv, (unsigned*)(p.ws + WS_CTL) + CW_BAR, st);
#ifndef STAMP_SEL
#define STAMP_SEL -1
#endif
    unsigned long long t_prev = 0, dt_sel = 0;
    if (STAMP_SEL >= 0) t_prev = __builtin_amdgcn_s_memrealtime();
#define STAMP(k) do { if (STAMP_SEL >= 0) { const unsigned long long now_ = __builtin_amdgcn_s_memrealtime(); if ((k) == STAMP_SEL && bid == 0) dt_sel = now_ - t_prev; t_prev = now_; } } while (0)
    ph_wprep(wv, p, lds, bid, nb); __syncthreads();
    ph_mod(wv, p, lds, bid, nb);            xcd_barrier(wv, p.ws, st); STAMP(0);
    ph_h(wv, p, lds, bid, nb);              xcd_barrier(wv, p.ws, st); STAMP(1);
    ph_proj(wv, p, (LAS unsigned char*)lds_raw, bid, nb);           xcd_barrier(wv, p.ws, st); STAMP(2);
    ph_dnprep(wv, p, (LAS unsigned char*)lds_raw, bid, nb);    xcd_barrier(wv, p.ws, st); STAMP(3);
    {
        constexpr int CONV_ITEMS = NE * ((D_ / 64) * (2 * DE / 128) + (DE / 64) * (D_ / 128)), CONV_SPLIT = (CONV_ITEMS * 4 / 10) & ~7;
        if (bid < nb / 2) { ph_dnscan(wv, p, (LAS unsigned char*)lds_raw, bid, nb / 2); ph_wprep_experts(wv, p, bid, nb / 2, 0, CONV_SPLIT); }
        else { ph_cf(wv, p, lds, bid - nb / 2, nb - nb / 2); ph_wprep_experts(wv, p, bid - nb / 2, nb - nb / 2, CONV_SPLIT, CONV_ITEMS); }
    }
    if (STAMP_SEL == 40 && bid == 0) { const unsigned long long now_ = __builtin_amdgcn_s_memrealtime(); dt_sel = now_ - t_prev; }
    xcd_barrier(wv, p.ws, st); STAMP(4);
    ph_outproj(wv, p, (LAS unsigned char*)lds_raw, bid, nb);        xcd_barrier(wv, p.ws, st); STAMP(6);
    ph_row2(wv, p, (LAS unsigned char*)lds_raw, bid, nb);           xcd_barrier(wv, p.ws, st); STAMP(7);
    ph_moe_gu(wv, p, (LAS unsigned char*)lds_raw, bid, nb);      xcd_barrier(wv, p.ws, st); STAMP(8);
    ph_moe_down(wv, p, (LAS unsigned char*)lds_raw, bid, nb);    xcd_barrier(wv, p.ws, st); STAMP(9);
    ph_final(wv, p, lds, bid, nb);
    if (STAMP_SEL >= 0) {
        __syncthreads(); STAMP(10);
        { const unsigned long long t0 = __builtin_amdgcn_s_memrealtime(); while (__builtin_amdgcn_s_memrealtime() - t0 < 8ull * dt_sel) __builtin_amdgcn_s_sleep(8); }
    }
}

extern "C" void kernel_launch(void* const* d_in, const int* in_sizes, int n_in, void* d_out, int out_size, void* d_ws, size_t ws_size, hipStream_t stream) {
    static int inited = 0;
    if (!inited) {
        if (n_in != 26 || out_size != T_ * D_ || ws_size < WS_END) { fprintf(stderr, "kernel_launch: unexpected shapes n_in %d out %d ws %zu\n", n_in, out_size, ws_size); inited = -1; return; }
        if (hipFuncSetAttribute((const void*)mk_all, hipFuncAttributeMaxDynamicSharedMemorySize, LDS_BYTES) != hipSuccess) { fprintf(stderr, "hipFuncSetAttribute failed\n"); inited = -1; return; }
        inited = 1;
    }
    if (inited < 0) return;
    (void)hipMemsetAsync((char*)d_ws + WS_CTL, 0, 1 * MiB, stream);
    Params p{};
    for (int i = 0; i < 26; ++i) p.in[i] = (const float*)d_in[i];
    p.out = (float*)d_out; p.ws = (unsigned char*)d_ws;
    hipLaunchKernelGGL(mk_all, dim3(256), dim3(NTHR), LDS_BYTES, stream, p);
}
```

```cpp
#include <hip/hip_runtime.h>
#include <cstdio>
#include <cstdint>

#define LAS __attribute__((address_space(3)))
typedef unsigned short bf16;
typedef float f32x4 __attribute__((ext_vector_type(4)));

constexpr int NB_ = 8, NS_ = 2048, D_ = 1024, T_ = NB_ * NS_;
constexpr int DNW = 512, NH = 4, HD = 128;
constexpr int CFW = 512, CFK = 31;
constexpr int INC = 3080;
constexpr int PJ = 3072;
constexpr int NE = 64, DE = 512;
constexpr int NTHR = 512;
constexpr float EPS = 1e-6f;
constexpr int TM = 256;
constexpr int MAXROWS = 2 * T_ + NE * TM;

constexpr size_t MiB = 1u << 20;
constexpr size_t WS_CTL = 0;
constexpr size_t WS_MOD = 1 * MiB;
constexpr size_t WS_SMALL = 1 * MiB + 512 * 1024;
constexpr size_t WS_ROUTE = 2 * MiB;
constexpr size_t WS_POS = 2 * MiB + 512 * 1024;
constexpr size_t WS_TOKL = 3 * MiB;
constexpr size_t WS_WL = 7 * MiB;
constexpr size_t WS_W8T = 11 * MiB;
constexpr size_t WS_WRTH = 12 * MiB;
constexpr size_t WS_WRTL = 12 * MiB + 256 * 1024;
constexpr size_t WS_WINT = 16 * MiB;
constexpr size_t WS_WOUTT = 22 * MiB;
constexpr size_t WS_WGUT = 24 * MiB;
constexpr size_t WS_WDNT = 152 * MiB;
constexpr size_t WS_H = 216 * MiB;
constexpr size_t WS_PROJ = 248 * MiB;
constexpr size_t WS_HMIX = 248 * MiB;
constexpr size_t WS_HID = 248 * MiB;
constexpr size_t WS_DW = 344 * MiB;
constexpr size_t WS_DQG = 360 * MiB;
constexpr size_t WS_DKDT = 376 * MiB;
constexpr size_t WS_DATT = 392 * MiB;
constexpr size_t WS_DU = 400 * MiB;
constexpr size_t WS_DEGL = 432 * MiB;
constexpr size_t WS_Y = 344 * MiB;
constexpr size_t WS_ORAW = 440 * MiB;
constexpr size_t WS_MIXED = 472 * MiB;
constexpr size_t WS_END = 504 * MiB;
constexpr int CW_CNT = 1024;
constexpr int CW_DNF = 2048;
constexpr int CW_HF = 8192;
constexpr int CW_OF = 12288;

__device__ __forceinline__ unsigned f2bf(float f) { unsigned u = __builtin_bit_cast(unsigned, f); return (u + 0x7fffu + ((u >> 16) & 1u)) >> 16; }
__device__ __forceinline__ float bf2f(unsigned b) { return __builtin_bit_cast(float, b << 16); }
template <int CTRL, int ROWMASK> __device__ __forceinline__ float dpp_f(float v) {
    return __builtin_bit_cast(float, __builtin_amdgcn_update_dpp(0, __builtin_bit_cast(int, v), CTRL, ROWMASK, 0xF, true));
}
__device__ __forceinline__ float wave_sum(float v) {
    v += dpp_f<0xB1, 0xF>(v);
    v += dpp_f<0x4E, 0xF>(v);
    v += dpp_f<0x141, 0xF>(v);
    v += dpp_f<0x140, 0xF>(v);
    v += dpp_f<0x142, 0xA>(v);
    v += dpp_f<0x143, 0xC>(v);
    return __builtin_bit_cast(float, __builtin_amdgcn_readlane(__builtin_bit_cast(int, v), 63));
}
__device__ __forceinline__ float sigmoidf_(float x) { return 1.f / (1.f + __expf(-x)); }
__device__ __forceinline__ float siluf_(float x) { return x / (1.f + __expf(-x)); }

__device__ __forceinline__ int lane_id_v() { int l; asm volatile("v_mbcnt_lo_u32_b32 %0, -1, 0\n\tv_mbcnt_hi_u32_b32 %0, -1, %0" : "=v"(l)); return l; }
__device__ __forceinline__ int opaque_tid_w(int wv) { return (wv << 6) | lane_id_v(); }
#define opaque_tid() opaque_tid_w(wv)

__device__ __forceinline__ void group_sync(int wv, unsigned* flag, unsigned target) {
    asm volatile("s_waitcnt vmcnt(0)" ::: "memory");
    __syncthreads();
    if (wv == 0 && lane_id_v() == 0) {
        __builtin_amdgcn_fence(__ATOMIC_RELEASE, "agent");
        asm volatile("s_waitcnt vmcnt(0)" ::: "memory");
        __hip_atomic_fetch_add(flag, 1u, __ATOMIC_RELAXED, __HIP_MEMORY_SCOPE_AGENT);
        unsigned sp = 0;
        while (__hip_atomic_load(flag, __ATOMIC_RELAXED, __HIP_MEMORY_SCOPE_AGENT) < target) { __builtin_amdgcn_s_sleep(2); if (++sp > (1u << 22)) break; }
        __builtin_amdgcn_fence(__ATOMIC_ACQUIRE, "agent");
        asm volatile("s_waitcnt vmcnt(0)" ::: "memory");
    }
    __syncthreads();
}

struct Params {
    const float* in[26];
    float* out;
    unsigned char* ws;
};


namespace pg8 {
#define PG8_LAS __attribute__((address_space(3)))
typedef unsigned short bf16_t;
typedef short bf16x8 __attribute__((ext_vector_type(8)));
typedef float f32x4 __attribute__((ext_vector_type(4)));
typedef unsigned u32x4 __attribute__((ext_vector_type(4)));
typedef unsigned u32x2 __attribute__((ext_vector_type(2)));
constexpr int BM = 256, BK = 64, HALF = 128, HTB = HALF * BK * 2, STAGE_BYTES = 8 * HTB, NXCD = 8, WGM = 8;
__host__ __device__ __forceinline__ int lds_byte(int r, int c) { const int st = (r >> 4) * 2 + (c >> 5), rr = r & 15, cc = c & 31, ob = rr * 64 + cc * 2; return st * 1024 + (ob ^ (((ob >> 9) & 1) << 5)); }
__host__ __device__ __forceinline__ void stage_rc(int b, int& R, int& C) { const int st = b / 1024, sb = b % 1024, swz = sb ^ (((sb >> 9) & 1) << 5); R = (st >> 1) * 16 + swz / 64; C = (st & 1) * 32 + (swz % 64) / 2; }
__host__ __device__ __forceinline__ int perm32(int rho) { const int n = rho >> 4, i = rho & 15; return 8 * (i >> 2) + 4 * n + (i & 3); }
struct Unit { int pm, pn, e, r0; };
__device__ __forceinline__ void st_wt16(void* p, u32x4 v) { asm volatile("global_store_dwordx4 %0, %1, off sc1\n\ts_nop 1" :: "v"(p), "v"(v) : "memory"); }
__device__ __forceinline__ unsigned cvt_pk_bf16(float lo, float hi) { unsigned r; asm volatile("v_cvt_pk_bf16_f32 %0, %1, %2" : "=v"(r) : "v"(lo), "v"(hi)); return r; }

struct DenseSched {
    const char* A; const char* Bt; int K; int nM, nN, nwg, G, c;
    __device__ void init(const void* A_, const void* Bt_, int M, int N, int K_, int G_, int c_) { A = (const char*)A_; Bt = (const char*)Bt_; K = K_; nM = M / BM; nN = N / BM; nwg = nM * nN; G = G_; c = c_; }
    __device__ bool next(int i, Unit& u) const {
        const long L = (long)i * G + c; if (L >= nwg) return false;
        int wgid = (int)L; { const int q = nwg / NXCD, r = nwg % NXCD, xcd = wgid % NXCD, off = wgid / NXCD; wgid = (xcd < r ? xcd * (q + 1) : r * (q + 1) + (xcd - r) * q) + off; }
        const int nig = WGM * nN, gid = wgid / nig, fm = gid * WGM, gsz = (nM - fm) < WGM ? (nM - fm) : WGM;
        u.pm = fm + ((wgid % nig) % gsz); u.pn = (wgid % nig) / gsz; u.e = 0; u.r0 = 0; return true;
    }
    __device__ __forceinline__ const char* a_base() const { return A; }
    __device__ __forceinline__ const char* b_ptr(const Unit& u) const { return Bt + (size_t)u.pn * BM * K * 2; }
    __device__ __forceinline__ void a_off(const Unit& u, const int (&R)[2], const int (&C)[2], unsigned (&v)[2][2]) const {
#pragma unroll
        for (int h = 0; h < 2; ++h)
#pragma unroll
            for (int i = 0; i < 2; ++i) v[h][i] = (unsigned)(((u.pm * BM + h * HALF + R[i]) * K + C[i]) * 2);
    }
};

struct EpiBf16 {
    static constexpr bool PERM = true;
    bf16_t* O; int ldc;
    __device__ __forceinline__ void operator()(const f32x4 (&acc)[2][2][4][2], const Unit& u, int wr, int wc, int fr, int fq) const {
        const int row0 = u.pm * BM + wr * 64 + fr, col0 = u.pn * BM + wc * 32 + 8 * fq;
#pragma unroll
        for (int ai = 0; ai < 2; ++ai)
#pragma unroll
            for (int m = 0; m < 4; ++m) { bf16_t* rowp = O + (size_t)(row0 + ai * HALF + m * 16) * ldc + col0;
#pragma unroll
                for (int bj = 0; bj < 2; ++bj) { const f32x4 v0 = acc[ai][bj][m][0], v1 = acc[ai][bj][m][1];
                    u32x4 w; w.x = cvt_pk_bf16(v0[0], v0[1]); w.y = cvt_pk_bf16(v0[2], v0[3]); w.z = cvt_pk_bf16(v1[0], v1[1]); w.w = cvt_pk_bf16(v1[2], v1[3]);
                    st_wt16(rowp + bj * HALF, w); } }
    }
};
struct EpiF32 {
    static constexpr bool PERM = false;
    float* C; int ldc;
    __device__ __forceinline__ void operator()(const f32x4 (&acc)[2][2][4][2], const Unit& u, int wr, int wc, int fr, int fq) const {
        const int row0 = u.pm * BM + wr * 64 + fr, col0 = u.pn * BM + wc * 32 + 4 * fq;
#pragma unroll
        for (int ai = 0; ai < 2; ++ai)
#pragma unroll
            for (int m = 0; m < 4; ++m) { float* rowp = C + (size_t)(row0 + ai * HALF + m * 16) * ldc + col0;
#pragma unroll
                for (int bj = 0; bj < 2; ++bj)
#pragma unroll
                    for (int n = 0; n < 2; ++n) *(f32x4*)(rowp + bj * HALF + n * 16) = acc[ai][bj][m][n]; }
    }
};

struct GroupSched {
    const char* A; const char* Bt; int K; int nN; size_t bstride; LAS int* tstart; LAS int* cnt; int total; int G, c; const int* tokl;
    __device__ __forceinline__ bool next(int i, Unit& u) const {
        const int L = i * G + c; if (L >= total * nN) return false;
        const int tile = L / nN; u.pn = L % nN; int e = 0; while (e < NE - 1 && tstart[e + 1] <= tile) ++e;
        u.e = e; u.pm = tile; u.r0 = (tile - tstart[e]) * BM; return true;
    }
    __device__ __forceinline__ const char* a_base() const { return A; }
    __device__ __forceinline__ const char* b_ptr(const Unit& u) const { return Bt + (size_t)u.e * bstride + (size_t)u.pn * BM * K * 2; }
    __device__ __forceinline__ void a_off(const Unit& u, const int (&R)[2], const int (&C)[2], unsigned (&v)[2][2]) const {
        const int ce = cnt[u.e];
#pragma unroll
        for (int h = 0; h < 2; ++h)
#pragma unroll
            for (int i = 0; i < 2; ++i) {
                const int r = u.r0 + h * HALF + R[i];
                int grow = u.pm * BM + h * HALF + R[i];
                if (tokl) grow = (r < ce) ? tokl[(size_t)u.e * T_ + r] : 0;
                v[h][i] = (unsigned)((grow * K + C[i]) * 2);
            }
    }
};
struct EpiGU {
    static constexpr bool PERM = false;
    bf16_t* HID;
    __device__ __forceinline__ void operator()(const f32x4 (&acc)[2][2][4][2], const Unit& u, int wr, int wc, int fr, int fq) const {
        const int row0 = u.pm * BM + wr * 64 + fr;
#pragma unroll
        for (int ai = 0; ai < 2; ++ai)
#pragma unroll
            for (int m = 0; m < 4; ++m) { bf16_t* rowp = HID + (size_t)(row0 + ai * HALF + m * 16) * DE;
#pragma unroll
                for (int bj = 0; bj < 2; ++bj) { const f32x4 g = acc[ai][bj][m][0], up = acc[ai][bj][m][1];
                    float h[4];
#pragma unroll
                    for (int i = 0; i < 4; ++i) h[i] = g[i] / (1.f + __expf(-g[i])) * up[i];
                    u32x2 w; w.x = cvt_pk_bf16(h[0], h[1]); w.y = cvt_pk_bf16(h[2], h[3]);
                    *(u32x2*)(rowp + 16 * (u.pn * 8 + 4 * bj + wc) + 4 * fq) = w; } }
    }
};
struct EpiDown {
    static constexpr bool PERM = true;
    bf16_t* Y; const float* wl; LAS int* cnt;
    __device__ __forceinline__ void operator()(const f32x4 (&acc)[2][2][4][2], const Unit& u, int wr, int wc, int fr, int fq) const {
        const int rloc = wr * 64 + fr, col0 = u.pn * BM + wc * 32 + 8 * fq, ce = cnt[u.e];
#pragma unroll
        for (int ai = 0; ai < 2; ++ai) {
            float w4[4];
#pragma unroll
            for (int m = 0; m < 4; ++m) { const int r = u.r0 + rloc + ai * HALF + m * 16; w4[m] = wl[(size_t)u.e * T_ + (r < ce ? r : 0)]; }
            asm volatile("" : "+v"(w4[0]), "+v"(w4[1]), "+v"(w4[2]), "+v"(w4[3]));
#pragma unroll
            for (int m = 0; m < 4; ++m) { const int r = u.r0 + rloc + ai * HALF + m * 16;
                if (r < ce) {
                    const float w = w4[m];
                    bf16_t* rowp = Y + (size_t)(u.pm * BM + rloc + ai * HALF + m * 16) * D_ + col0;
#pragma unroll
                    for (int bj = 0; bj < 2; ++bj) { const f32x4 v0 = acc[ai][bj][m][0] * w, v1 = acc[ai][bj][m][1] * w;
                        u32x4 o; o.x = cvt_pk_bf16(v0[0], v0[1]); o.y = cvt_pk_bf16(v0[2], v0[3]); o.z = cvt_pk_bf16(v1[0], v1[1]); o.w = cvt_pk_bf16(v1[2], v1[3]);
                        *(u32x4*)(rowp + bj * HALF) = o; } } }
        }
    }
};

template <class Epi, class Sched>
__device__ __forceinline__ void gemm_phase(int wv, PG8_LAS unsigned char* lds, const Sched& S, const Epi& E) {
    int tid_ = opaque_tid();
    const int tid = tid_, wid = __builtin_amdgcn_readfirstlane(tid >> 6), lane = tid & 63, wr = wid >> 2, wc = wid & 3, fr = lane & 15, fq = lane >> 4;
    const int K = S.K, nt = K / BK;
    int sR[2], sC[2]; unsigned voffB[2];
#pragma unroll
    for (int i = 0; i < 2; ++i) { int R, C; stage_rc(tid * 16 + i * 8192, R, C); sR[i] = R; sC[i] = C; const int Rb = Epi::PERM ? ((R & ~31) + perm32(R & 31)) : R; voffB[i] = (unsigned)(Rb * K + C) * 2u; }
    const size_t kstep = (size_t)(BK * 2);
    const size_t hstep = (size_t)HALF * K * 2;
    const unsigned ldsw = (unsigned)wid * 1024u;
    const int aoff = lds_byte(wr * 64 + fr, fq * 8), boff = lds_byte(wc * 32 + fr, fq * 8);
#define PG8_SA(b, h) (((b) * 2 + (h)) * HTB)
#define PG8_SB(b, h) ((4 + (b) * 2 + (h)) * HTB)
#define PG8_STAGE(bufoff, gbase, voff) do { _Pragma("unroll") for (int _i = 0; _i < 2; ++_i) \
        __builtin_amdgcn_global_load_lds((const unsigned*)((const char*)(gbase) + (voff)[_i]), (PG8_LAS unsigned*)(lds + (bufoff) + ldsw + _i * 8192), 16, 0, 0); } while (0)
#define PG8_LDA(dst, b, h) do { _Pragma("unroll") for (int m = 0; m < 4; ++m) _Pragma("unroll") for (int k = 0; k < 2; ++k) dst[m][k] = *(const PG8_LAS bf16x8*)(lds + PG8_SA(b, h) + aoff + m * 2048 + k * 1024); } while (0)
#define PG8_LDB(dst, b, h) do { _Pragma("unroll") for (int n = 0; n < 2; ++n) _Pragma("unroll") for (int k = 0; k < 2; ++k) dst[n][k] = *(const PG8_LAS bf16x8*)(lds + PG8_SB(b, h) + boff + n * 2048 + k * 1024); } while (0)
#define PG8_MMA(ai, bj, At, Bt) do { __builtin_amdgcn_s_setprio(1); _Pragma("unroll") for (int m = 0; m < 4; ++m) _Pragma("unroll") for (int n = 0; n < 2; ++n) _Pragma("unroll") for (int k = 0; k < 2; ++k) \
        acc[ai][bj][m][n] = __builtin_amdgcn_mfma_f32_16x16x32_bf16(Bt[n][k], At[m][k], acc[ai][bj][m][n], 0, 0, 0); __builtin_amdgcn_s_setprio(0); } while (0)
#define PG8_WAIT_V(n) asm volatile("s_waitcnt vmcnt(" #n ")" ::: "memory")
#define PG8_WAIT_L(n) asm volatile("s_waitcnt lgkmcnt(" #n ")" ::: "memory")
#define PG8_BAR __builtin_amdgcn_s_barrier()
#define PG8_SCHED __builtin_amdgcn_sched_barrier(0)
    Unit cur, nxt; int ui = 0;
    if (!S.next(0, cur)) return;
    f32x4 acc[2][2][4][2];
#pragma unroll
    for (int a = 0; a < 2; ++a)
#pragma unroll
        for (int b = 0; b < 2; ++b)
#pragma unroll
            for (int m = 0; m < 4; ++m)
#pragma unroll
                for (int n = 0; n < 2; ++n) acc[a][b][m][n] = (f32x4){0.f, 0.f, 0.f, 0.f};
    bf16x8 At[4][2], B0[2][2], B1[2][2];
    const char* const gA = S.a_base();
    unsigned vC[2][2];
    S.a_off(cur, sR, sC, vC);
    const char* cB = S.b_ptr(cur);
    PG8_STAGE(PG8_SB(0, 0), cB, voffB); PG8_STAGE(PG8_SB(0, 1), cB + hstep, voffB); PG8_STAGE(PG8_SA(0, 0), gA, vC[0]); PG8_STAGE(PG8_SA(0, 1), gA, vC[1]);
    if (wr == 1) PG8_BAR;
    PG8_WAIT_V(2); PG8_BAR;
    PG8_STAGE(PG8_SB(1, 0), cB + kstep, voffB); PG8_STAGE(PG8_SA(1, 0), gA + kstep, vC[0]); PG8_STAGE(PG8_SB(1, 1), cB + hstep + kstep, voffB);
    PG8_WAIT_V(6); PG8_BAR;
    for (;;) {
        const bool has_next = S.next(ui + 1, nxt);
        const char* nB = has_next ? S.b_ptr(nxt) : cB;
        for (int t = 0; t < nt; t += 2) {
            const bool last = (t == nt - 2);
            const char* a1 = gA + (size_t)(t + 1) * kstep;
            const char* a2 = last ? gA : gA + (size_t)(t + 2) * kstep; const char* b2 = last ? nB : cB + (size_t)(t + 2) * kstep;
            const char* a3 = a2 + kstep; const char* b3 = b2 + kstep;
            PG8_LDB(B0, 0, 0); PG8_LDB(B1, 0, 1); PG8_SCHED; PG8_LDA(At, 0, 0); PG8_STAGE(PG8_SA(1, 1), a1, vC[1]);
            PG8_WAIT_V(8); PG8_WAIT_L(0); PG8_BAR; PG8_MMA(0, 0, At, B0); PG8_MMA(0, 1, At, B1); PG8_BAR; PG8_SCHED;
            if (last && has_next) S.a_off(nxt, sR, sC, vC);
            PG8_LDA(At, 0, 1); PG8_STAGE(PG8_SB(0, 0), b2, voffB); PG8_STAGE(PG8_SB(0, 1), b2 + hstep, voffB); PG8_STAGE(PG8_SA(0, 0), a2, vC[0]);
            PG8_WAIT_V(8); PG8_WAIT_L(0); PG8_BAR; PG8_MMA(1, 0, At, B0); PG8_MMA(1, 1, At, B1); PG8_BAR; PG8_SCHED;
            PG8_LDB(B0, 1, 0); PG8_LDB(B1, 1, 1); PG8_SCHED; PG8_LDA(At, 1, 0); PG8_STAGE(PG8_SA(0, 1), a2, vC[1]);
            PG8_WAIT_V(8); PG8_WAIT_L(0); PG8_BAR; PG8_MMA(0, 0, At, B0); PG8_MMA(0, 1, At, B1); PG8_BAR; PG8_SCHED;
            PG8_LDA(At, 1, 1); PG8_STAGE(PG8_SB(1, 0), b3, voffB); PG8_STAGE(PG8_SB(1, 1), b3 + hstep, voffB); PG8_STAGE(PG8_SA(1, 0), a3, vC[0]);
            PG8_WAIT_V(8); PG8_WAIT_L(0); PG8_BAR; PG8_MMA(1, 0, At, B0); PG8_MMA(1, 1, At, B1); PG8_BAR; PG8_SCHED;
        }
        if (wr == 0) PG8_BAR;
        E(acc, cur, wr, wc, fr, fq);
        if (!has_next) break;
#pragma unroll
        for (int a = 0; a < 2; ++a)
#pragma unroll
            for (int b = 0; b < 2; ++b)
#pragma unroll
                for (int m = 0; m < 4; ++m)
#pragma unroll
                    for (int n = 0; n < 2; ++n) acc[a][b][m][n] = (f32x4){0.f, 0.f, 0.f, 0.f};
        cur = nxt; cB = nB; ++ui;
        if (wr == 1) PG8_BAR;
    }
    PG8_WAIT_V(0);
    PG8_BAR;
#undef PG8_SA
#undef PG8_SB
#undef PG8_STAGE
#undef PG8_LDA
#undef PG8_LDB
#undef PG8_MMA
#undef PG8_WAIT_V
#undef PG8_WAIT_L
#undef PG8_BAR
#undef PG8_SCHED
}
}

template <class CM>
__device__ __forceinline__ void transpose_item(const float* W, int ldw, int K, bf16* WT, LAS float* scr, int k0, int n0, int lane, const CM& cmap) {
    const int kb = lane >> 3, ng = lane & 7;
    const float* src = W + cmap(n0 + 4 * ng) + (size_t)(k0 + 8 * kb) * ldw;
    f32x4 v[8];
#pragma unroll
    for (int i = 0; i < 8; ++i) v[i] = *(const f32x4*)(src + (size_t)i * ldw);
#pragma unroll
    for (int q = 0; q < 4; ++q) {
        uint4 o; o.x = f2bf(v[0][q]) | (f2bf(v[1][q]) << 16); o.y = f2bf(v[2][q]) | (f2bf(v[3][q]) << 16); o.z = f2bf(v[4][q]) | (f2bf(v[5][q]) << 16); o.w = f2bf(v[6][q]) | (f2bf(v[7][q]) << 16);
        *(uint4*)(WT + (size_t)(n0 + 4 * ng + q) * K + k0 + 8 * kb) = o;
    }
}
__device__ void ph_wprep(int wv, const Params& p, LAS float* lds, int bid, int nb) {
    const int tid = opaque_tid(), lane = tid & 63, wave = tid >> 6;
    LAS float* scr = lds + wave * 4096;
    bf16* WINT = (bf16*)(p.ws + WS_WINT); bf16* WOUTT = (bf16*)(p.ws + WS_WOUTT);
    constexpr int I_IN = (D_ / 64) * (PJ / 32), I_OUT = (D_ / 64) * (D_ / 32);
    for (int it = bid * 8 + wave; it < I_IN + I_OUT; it += nb * 8) {
        if (it < I_IN) { const int kb = it / (PJ / 32), nbk = it % (PJ / 32); transpose_item(p.in[6], INC, D_, WINT, scr, 64 * kb, 32 * nbk, lane, [](int n) { return n < 2048 ? n : n + 8; }); }
        else { const int r = it - I_IN, kb = r / (D_ / 32), nbk = r % (D_ / 32); transpose_item(p.in[16], D_, D_, WOUTT, scr, 64 * kb, 32 * nbk, lane, [](int n) { return n; }); }
    }
    float* W8T = (float*)(p.ws + WS_W8T); bf16* WRTH = (bf16*)(p.ws + WS_WRTH); bf16* WRTL = (bf16*)(p.ws + WS_WRTL);
    for (int i = bid * NTHR + tid; i < 8 * 1024 + 80 * 1024; i += nb * NTHR) {
        if (i < 8192) { const int j = i >> 10, c = i & 1023; W8T[i] = p.in[6][(size_t)c * INC + 2048 + j]; }
        else { const int q = i - 8192, n = q >> 10, c = q & 1023;
            const float w = n < 8 ? p.in[19][(size_t)c * 8 + n] : (n < 16 ? 0.f : p.in[21][(size_t)c * NE + (n - 16)]);
            const unsigned hi = f2bf(w); WRTH[q] = (bf16)hi; WRTL[q] = (bf16)f2bf(w - bf2f(hi)); }
    }
}
template <class CM>
__device__ __forceinline__ void transpose_item4(const float* W, int ldw, int K, bf16* WT, int k0, int n0, int lane, const CM& cmap) {
    const int kb = lane >> 3, ng = lane & 7;
    f32x4 v[4][8];
#pragma unroll
    for (int t = 0; t < 4; ++t) { const float* src = W + cmap(n0 + 32 * t + 4 * ng) + (size_t)(k0 + 8 * kb) * ldw;
#pragma unroll
        for (int i = 0; i < 8; ++i) v[t][i] = *(const f32x4*)(src + (size_t)i * ldw); }
#pragma unroll
    for (int t = 0; t < 4; ++t)
#pragma unroll
        for (int q = 0; q < 4; ++q) {
            uint4 o; o.x = f2bf(v[t][0][q]) | (f2bf(v[t][1][q]) << 16); o.y = f2bf(v[t][2][q]) | (f2bf(v[t][3][q]) << 16); o.z = f2bf(v[t][4][q]) | (f2bf(v[t][5][q]) << 16); o.w = f2bf(v[t][6][q]) | (f2bf(v[t][7][q]) << 16);
            *(uint4*)(WT + (size_t)(n0 + 32 * t + 4 * ng + q) * K + k0 + 8 * kb) = o;
        }
}
__device__ void ph_wprep_experts(int wv, const Params& p, int bid, int nb, int lo, int hi) {
    const int tid = opaque_tid(), lane = tid & 63, wave = tid >> 6;
    bf16* WGUT = (bf16*)(p.ws + WS_WGUT); bf16* WDNT = (bf16*)(p.ws + WS_WDNT);
    constexpr int I_GU = (D_ / 64) * (2 * DE / 128), I_DN = (DE / 64) * (D_ / 128);
    for (int it = lo + bid * 8 + wave; it < hi; it += nb * 8) {
        int r = it; const int e = r / (I_GU + I_DN); r -= e * (I_GU + I_DN);
        if (r < I_GU) { const int kb = r / (2 * DE / 128), nbk = r % (2 * DE / 128);
            const float* wg = p.in[23] + (size_t)e * D_ * DE; const long up_off = (long)(p.in[24] - p.in[23]);
            transpose_item4(wg, DE, D_, WGUT + (size_t)e * 2 * DE * D_, 64 * kb, 128 * nbk, lane, [up_off](int n) -> long { const int g = n >> 5, w = n & 31; return w < 16 ? (long)(16 * g + w) : up_off + (long)(16 * g + w - 16); }); }
        else { r -= I_GU; const int kb = r / (D_ / 128), nbk = r % (D_ / 128);
            transpose_item4(p.in[25] + (size_t)e * DE * D_, D_, DE, WDNT + (size_t)e * D_ * DE, 64 * kb, 128 * nbk, lane, [](int n) { return n; }); }
    }
}

__device__ void ph_mod(int wv, const Params& p, LAS float* lds, int bid, int nb) {
    const int tid = opaque_tid();
    const float* c = p.in[1]; const float* w_ada = p.in[2]; const float* b_ada = p.in[3];
    float* mod = (float*)(p.ws + WS_MOD);
    LAS float* cact = lds;
    LAS float* part = lds + 8192;
    for (int i = tid; i < 8192; i += NTHR) cact[i] = siluf_(c[i]);
    __syncthreads();
    for (int cg = bid; cg < 256; cg += nb) {
        const int n0 = cg * 24;
        const int kq = tid / 6, cq = tid % 6;
        float acc[8][4];
#pragma unroll
        for (int b = 0; b < 8; ++b) { acc[b][0] = acc[b][1] = acc[b][2] = acc[b][3] = 0.f; }
        if (kq < 85) {
            f32x4 wv4[13];
#pragma unroll
            for (int i = 0; i < 13; ++i) { const int k = kq + 85 * i; wv4[i] = *(const f32x4*)(w_ada + (size_t)(k < 1024 ? k : 0) * 6144 + n0 + 4 * cq); }
#pragma unroll
            for (int i = 0; i < 13; ++i) { const int k = kq + 85 * i; const bool ok = k < 1024; const int kk = ok ? k : 0;
#pragma unroll
                for (int b = 0; b < 8; ++b) { const float a = ok ? cact[b * 1024 + kk] : 0.f; acc[b][0] += a * wv4[i][0]; acc[b][1] += a * wv4[i][1]; acc[b][2] += a * wv4[i][2]; acc[b][3] += a * wv4[i][3]; } }
#pragma unroll
            for (int b = 0; b < 8; ++b)
#pragma unroll
                for (int j = 0; j < 4; ++j) part[(kq * 8 + b) * 24 + 4 * cq + j] = acc[b][j];
        }
        __syncthreads();
        if (tid < 192) {
            const int b = tid / 24, j = tid % 24; float s = 0.f;
            for (int q = 0; q < 85; ++q) s += part[(q * 8 + b) * 24 + j];
            mod[b * 6144 + n0 + j] = s + b_ada[n0 + j];
        }
        __syncthreads();
    }
}

__device__ void ph_h(int wv, const Params& p, LAS float* lds, int row0) {
    const int tid = opaque_tid(), lane = tid & 63, wave = tid >> 6;
    const float* x = p.in[0]; const float* npm = p.in[4];
    const float* mod = (const float*)(p.ws + WS_MOD); const float* W8T = (const float*)(p.ws + WS_W8T);
    bf16* H = (bf16*)(p.ws + WS_H); float* SM = (float*)(p.ws + WS_SMALL);
    for (int i = tid; i < 2048; i += NTHR) *(LAS f32x4*)(lds + 4 * i) = *(const f32x4*)(W8T + 4 * i);
    __syncthreads();
#pragma unroll 1
    for (int t = row0 + wave * 8; t < row0 + wave * 8 + 8; ++t) {
        const int b = t / NS_;
        const float* xr = x + (size_t)t * D_;
        f32x4 v[4]; float ss = 0.f;
#pragma unroll
        for (int j = 0; j < 4; ++j) { v[j] = *(const f32x4*)(xr + 4 * lane + 256 * j); ss += v[j][0] * v[j][0] + v[j][1] * v[j][1] + v[j][2] * v[j][2] + v[j][3] * v[j][3]; }
        ss = wave_sum(ss);
        const float rstd = rsqrtf(ss * (1.f / D_) + EPS);
        float sm[8];
#pragma unroll
        for (int j = 0; j < 8; ++j) sm[j] = 0.f;
#pragma unroll
        for (int j = 0; j < 4; ++j) {
            const int c0 = 4 * lane + 256 * j;
            const f32x4 nw = *(const f32x4*)(npm + c0);
            const f32x4 sh = *(const f32x4*)(mod + b * 6144 + c0);
            const f32x4 sc = *(const f32x4*)(mod + b * 6144 + 1024 + c0);
            const f32x4 h = v[j] * rstd * nw * (sc + 1.f) + sh;
            uint2 o; o.x = f2bf(h[0]) | (f2bf(h[1]) << 16); o.y = f2bf(h[2]) | (f2bf(h[3]) << 16);
            *(uint2*)(H + (size_t)t * D_ + c0) = o;
#pragma unroll
            for (int q = 0; q < 8; ++q) { const f32x4 w = *(const LAS f32x4*)(lds + q * 1024 + c0); sm[q] += h[0] * w[0] + h[1] * w[1] + h[2] * w[2] + h[3] * w[3]; }
        }
#pragma unroll
        for (int j = 0; j < 8; ++j) sm[j] = wave_sum(sm[j]);
        if (lane == 0) { *(float4*)(SM + (size_t)t * 8) = make_float4(sm[0], sm[1], sm[2], sm[3]); *(float4*)(SM + (size_t)t * 8 + 4) = make_float4(sm[4], sm[5], sm[6], sm[7]); }
    }
}

__device__ __forceinline__ void ph_proj(int wv, const Params& p, LAS unsigned char* lds, int bid, int nb) {
    pg8::DenseSched S; S.init(p.ws + WS_H, p.ws + WS_WINT, T_, PJ, D_, nb, bid);
    pg8::EpiBf16 E{(bf16*)(p.ws + WS_PROJ), PJ};
    pg8::gemm_phase(wv, lds, S, E);
}

typedef short bf16x8_t __attribute__((ext_vector_type(8)));
typedef unsigned u32x4_t __attribute__((ext_vector_type(4)));
typedef unsigned u32x2_t __attribute__((ext_vector_type(2)));
__device__ __forceinline__ int lds_off16(int row, int ch) { return row * 256 + ((ch ^ (row & 15)) << 4); }
__device__ __forceinline__ int lds_off8(int row, int ch) { return row * 128 + ((ch ^ ((row >> 1) & 7)) << 4); }
__device__ __forceinline__ unsigned pk2bf(float lo, float hi) { return f2bf(lo) | (f2bf(hi) << 16); }
__device__ __forceinline__ bf16x8_t ldfrag(const LAS unsigned char* p) { return *(const LAS bf16x8_t*)p; }

__device__ void ph_dnprep(int wv, const Params& p, LAS unsigned char* lds, int bid, int nb) {
    const int tid = opaque_tid(), lane = tid & 63, wave = tid >> 6, fr = lane & 15, fq = lane >> 4;
    const bf16* PROJ = (const bf16*)(p.ws + WS_PROJ); const float* cw = p.in[7]; const float* a_log = p.in[8]; const float* dt_bias = p.in[9];
    const float* SM = (const float*)(p.ws + WS_SMALL);
    bf16* DW = (bf16*)(p.ws + WS_DW); bf16* DQG = (bf16*)(p.ws + WS_DQG); bf16* DKDT = (bf16*)(p.ws + WS_DKDT); bf16* DATT = (bf16*)(p.ws + WS_DATT);
    float* DU = (float*)(p.ws + WS_DU); float* DEGL = (float*)(p.ws + WS_DEGL);
    constexpr int O_KN = 0, O_QS = 16384, O_KD = 32768, O_AM = 50176, O_RHS = 66560, O_GC = 132096;
    LAS float* AM = (LAS float*)(lds + O_AM); LAS float* RHS = (LAS float*)(lds + O_RHS); LAS float* GC = (LAS float*)(lds + O_GC);
    LAS unsigned short* KD = (LAS unsigned short*)(lds + O_KD);
    const float qscale = 0.08838834764831845f;
    for (int item = bid; item < 1024; item += nb) {
        const int b = item >> 7, h = (item >> 5) & 3, n = item & 31, t0 = b * NS_ + n * 64, tl0 = n * 64;
        if (wave == 0) {
            const int t = t0 + lane;
            const float bl = SM[(size_t)t * 8 + h], al = SM[(size_t)t * 8 + 4 + h];
            const float beta = sigmoidf_(bl);
            const float xx = al + dt_bias[h];
            const float sp = xx > 20.f ? xx : log1pf(expf(xx));
            float gc = -expf(a_log[h]) * sp;
#pragma unroll
            for (int o = 1; o < 64; o <<= 1) { const float y = __shfl_up(gc, o); if (lane >= o) gc += y; }
            const float glast = __shfl(gc, 63);
            GC[lane] = gc; GC[64 + lane] = beta; GC[128 + lane] = expf(gc); GC[192 + lane] = expf(glast - gc);
            if (lane == 63) DEGL[item] = expf(gc);
        }
        __syncthreads();
        {
            const int r = tid >> 3, seg = tid & 7;
            const float beta = GC[64 + r], egc = GC[128 + r], edec = GC[192 + r];
            float v3[3][16];
#pragma unroll
            for (int part = 0; part < 3; ++part) {
                const int ch = part * 512 + h * 128 + seg * 16;
#pragma unroll
                for (int i = 0; i < 16; ++i) v3[part][i] = 0.f;
#pragma unroll
                for (int j = 0; j < 4; ++j) {
                    const bool ok = tl0 + r - 3 + j >= 0;
                    const size_t srow = (size_t)(ok ? t0 + r - 3 + j : t0);
                    const u32x4_t x0 = *(const u32x4_t*)(PROJ + srow * PJ + ch), x1 = *(const u32x4_t*)(PROJ + srow * PJ + ch + 8);
                    const unsigned xs[8] = {x0.x, x0.y, x0.z, x0.w, x1.x, x1.y, x1.z, x1.w};
#pragma unroll
                    for (int i = 0; i < 8; ++i) { float2 w = *(const float2*)(cw + j * 1536 + ch + 2 * i); if (!ok) { w.x = 0.f; w.y = 0.f; } v3[part][2 * i] += w.x * bf2f(xs[i] & 0xffffu); v3[part][2 * i + 1] += w.y * bf2f(xs[i] >> 16); }
                }
                asm volatile("" ::: "memory");
                float ss = 0.f;
#pragma unroll
                for (int i = 0; i < 16; ++i) { v3[part][i] = siluf_(v3[part][i]); ss += v3[part][i] * v3[part][i]; }
                if (part < 2) {
                    ss += __shfl_xor(ss, 1); ss += __shfl_xor(ss, 2); ss += __shfl_xor(ss, 4);
                    const float rn = rsqrtf(ss + EPS);
#pragma unroll
                    for (int i = 0; i < 16; ++i) v3[part][i] *= rn;
                }
            }
            {
                u32x4_t a0, a1, g0, g1; const float* q = v3[0]; const float s = qscale, sg = qscale * egc;
                a0.x = pk2bf(q[0] * s, q[1] * s); a0.y = pk2bf(q[2] * s, q[3] * s); a0.z = pk2bf(q[4] * s, q[5] * s); a0.w = pk2bf(q[6] * s, q[7] * s);
                a1.x = pk2bf(q[8] * s, q[9] * s); a1.y = pk2bf(q[10] * s, q[11] * s); a1.z = pk2bf(q[12] * s, q[13] * s); a1.w = pk2bf(q[14] * s, q[15] * s);
                g0.x = pk2bf(q[0] * sg, q[1] * sg); g0.y = pk2bf(q[2] * sg, q[3] * sg); g0.z = pk2bf(q[4] * sg, q[5] * sg); g0.w = pk2bf(q[6] * sg, q[7] * sg);
                g1.x = pk2bf(q[8] * sg, q[9] * sg); g1.y = pk2bf(q[10] * sg, q[11] * sg); g1.z = pk2bf(q[12] * sg, q[13] * sg); g1.w = pk2bf(q[14] * sg, q[15] * sg);
                *(LAS u32x4_t*)(lds + O_QS + lds_off16(r, 2 * seg)) = a0; *(LAS u32x4_t*)(lds + O_QS + lds_off16(r, 2 * seg + 1)) = a1;
                bf16* dst = DQG + (size_t)item * 8192 + r * 128 + seg * 16; *(u32x4_t*)dst = g0; *(u32x4_t*)(dst + 8) = g1;
            }
            {
                u32x4_t a0, a1; const float* k = v3[1];
                a0.x = pk2bf(k[0], k[1]); a0.y = pk2bf(k[2], k[3]); a0.z = pk2bf(k[4], k[5]); a0.w = pk2bf(k[6], k[7]);
                a1.x = pk2bf(k[8], k[9]); a1.y = pk2bf(k[10], k[11]); a1.z = pk2bf(k[12], k[13]); a1.w = pk2bf(k[14], k[15]);
                *(LAS u32x4_t*)(lds + O_KN + lds_off16(r, 2 * seg)) = a0; *(LAS u32x4_t*)(lds + O_KN + lds_off16(r, 2 * seg + 1)) = a1;
                u32x4_t d0, d1;
                d0.x = pk2bf(k[0] * edec, k[1] * edec); d0.y = pk2bf(k[2] * edec, k[3] * edec); d0.z = pk2bf(k[4] * edec, k[5] * edec); d0.w = pk2bf(k[6] * edec, k[7] * edec);
                d1.x = pk2bf(k[8] * edec, k[9] * edec); d1.y = pk2bf(k[10] * edec, k[11] * edec); d1.z = pk2bf(k[12] * edec, k[13] * edec); d1.w = pk2bf(k[14] * edec, k[15] * edec);
                *(LAS u32x4_t*)(KD + r * 136 + seg * 16) = d0; *(LAS u32x4_t*)(KD + r * 136 + seg * 16 + 8) = d1;
                const float bw = beta * egc;
#pragma unroll
                for (int i = 0; i < 4; ++i) *(LAS f32x4*)(RHS + r * 256 + 128 + seg * 16 + 4 * i) = (f32x4){k[4 * i] * bw, k[4 * i + 1] * bw, k[4 * i + 2] * bw, k[4 * i + 3] * bw};
            }
            {
                const float* v = v3[2];
#pragma unroll
                for (int i = 0; i < 4; ++i) *(LAS f32x4*)(RHS + r * 256 + seg * 16 + 4 * i) = (f32x4){v[4 * i] * beta, v[4 * i + 1] * beta, v[4 * i + 2] * beta, v[4 * i + 3] * beta};
            }
        }
        __syncthreads();
        {
            const int rb = wave & 3;
            bf16x8_t xf[4];
#pragma unroll
            for (int s4 = 0; s4 < 4; ++s4) xf[s4] = ldfrag(lds + O_KN + lds_off16(16 * rb + fr, 4 * s4 + fq));
#pragma unroll
            for (int cb = 0; cb < 4; ++cb) {
                f32x4 acc = {0.f, 0.f, 0.f, 0.f};
                const int yoff = (wave < 4) ? O_KN : O_QS;
#pragma unroll
                for (int s4 = 0; s4 < 4; ++s4) { const bf16x8_t yf = ldfrag(lds + yoff + lds_off16(16 * cb + fr, 4 * s4 + fq)); acc = __builtin_amdgcn_mfma_f32_16x16x32_bf16(xf[s4], yf, acc, 0, 0, 0); }
                const int xr0 = 16 * rb + 4 * fq, yr = 16 * cb + fr;
                const f32x4 gx = *(const LAS f32x4*)(GC + xr0); const float gy = GC[yr];
                if (wave < 4) {
                    const f32x4 bx = *(const LAS f32x4*)(GC + 64 + xr0);
                    f32x4 o;
#pragma unroll
                    for (int r = 0; r < 4; ++r) { const bool m = xr0 + r > yr; const float dec = __expf(m ? gx[r] - gy : 0.f); o[r] = m ? bx[r] * acc[r] * dec : 0.f; }
                    *(LAS f32x4*)(AM + ((xr0 >> 2) * 64 + yr) * 4) = o;
                } else {
                    float o[4];
#pragma unroll
                    for (int r = 0; r < 4; ++r) { const bool m = yr >= xr0 + r; const float dec = __expf(m ? gy - gx[r] : 0.f); o[r] = m ? acc[r] * dec : 0.f; }
                    u32x2_t w; w.x = pk2bf(o[0], o[1]); w.y = pk2bf(o[2], o[3]);
                    *(u32x2_t*)(DATT + (size_t)item * 4096 + yr * 64 + xr0) = w;
                }
            }
        }
        __syncthreads();
        if (tid < 256) {
            const int c = tid;
            float x[64];
#pragma unroll
            for (int blk = 0; blk < 16; ++blk) {
                float s0 = RHS[(4 * blk + 0) * 256 + c], s1 = RHS[(4 * blk + 1) * 256 + c], s2 = RHS[(4 * blk + 2) * 256 + c], s3 = RHS[(4 * blk + 3) * 256 + c];
#pragma unroll
                for (int j0 = 0; j0 < 4 * blk; j0 += 16) {
                    f32x4 a[16];
#pragma unroll
                    for (int q = 0; q < 16; ++q) if (j0 + q < 4 * blk) a[q] = *(const LAS f32x4*)(AM + (blk * 64 + j0 + q) * 4);
#pragma unroll
                    for (int q = 0; q < 16; ++q) if (j0 + q < 4 * blk) { const float xv = x[j0 + q]; s0 -= a[q][0] * xv; s1 -= a[q][1] * xv; s2 -= a[q][2] * xv; s3 -= a[q][3] * xv; }
                }
                const f32x4 t0 = *(const LAS f32x4*)(AM + (blk * 64 + 4 * blk) * 4), t1 = *(const LAS f32x4*)(AM + (blk * 64 + 4 * blk + 1) * 4), t2 = *(const LAS f32x4*)(AM + (blk * 64 + 4 * blk + 2) * 4);
                x[4 * blk] = s0;
                s1 -= t0[1] * s0; s2 -= t0[2] * s0; s3 -= t0[3] * s0;
                x[4 * blk + 1] = s1;
                s2 -= t1[2] * s1; s3 -= t1[3] * s1;
                x[4 * blk + 2] = s2;
                s3 -= t2[3] * s2;
                x[4 * blk + 3] = s3;
            }
            if (c < 128) {
#pragma unroll
                for (int i = 0; i < 64; ++i) DU[(size_t)item * 8192 + i * 128 + c] = x[i];
            } else {
#pragma unroll
                for (int i = 0; i < 64; ++i) DW[(size_t)item * 8192 + i * 128 + (c - 128)] = (bf16)f2bf(x[i]);
            }
        } else {
            const int tt = tid - 256, d = tt >> 1, c0 = (tt & 1) * 32;
            unsigned w[16];
#pragma unroll
            for (int i = 0; i < 16; ++i) w[i] = (unsigned)KD[(c0 + 2 * i) * 136 + d] | ((unsigned)KD[(c0 + 2 * i + 1) * 136 + d] << 16);
            bf16* dst = DKDT + (size_t)item * 8192 + d * 64 + c0;
#pragma unroll
            for (int i = 0; i < 4; ++i) *(u32x4_t*)(dst + 8 * i) = (u32x4_t){w[4 * i], w[4 * i + 1], w[4 * i + 2], w[4 * i + 3]};
        }
        __syncthreads();
    }
}

__device__ void ph_dnscan(int wv, const Params& p, LAS unsigned char* lds, int sbid, int nsb) {
    const int tid = opaque_tid(), lane = tid & 63, wave = wv, fr = lane & 15, fq = lane >> 4;
    const bf16* DW = (const bf16*)(p.ws + WS_DW); const bf16* DQG = (const bf16*)(p.ws + WS_DQG); const bf16* DKDT = (const bf16*)(p.ws + WS_DKDT); const bf16* DATT = (const bf16*)(p.ws + WS_DATT);
    const float* DU = (const float*)(p.ws + WS_DU); const float* DEGL = (const float*)(p.ws + WS_DEGL);
    float* ORAW = (float*)(p.ws + WS_ORAW);
    constexpr int BUF = 57344, O_W = 0, O_QG = 16384, O_KDT = 32768, O_ATT = 49152, O_SB = 114688, O_VNT = 131072;
    const int cb = wave >> 1, eb = wave & 1;
    for (int it = sbid; it < 128; it += nsb) {
        const int bh = (it & 7) * 4 + (it >> 5), es = (it >> 3) & 3, b = bh >> 2, h = bh & 3, e0 = es * 32, item0 = bh * 32;
        f32x4 st[2] = {{0.f, 0.f, 0.f, 0.f}, {0.f, 0.f, 0.f, 0.f}};
        *(LAS u32x4_t*)(lds + O_SB + tid * 16) = (u32x4_t){0u, 0u, 0u, 0u};
        u32x4_t rg[7]; float un[4]; float egl_n;
#define DN_LOAD(itm) do { const size_t _o = (size_t)(itm) * 8192; \
            rg[0] = *(const u32x4_t*)(DW + _o + (size_t)tid * 8); rg[1] = *(const u32x4_t*)(DW + _o + (size_t)(tid + 512) * 8); \
            rg[2] = *(const u32x4_t*)(DQG + _o + (size_t)tid * 8); rg[3] = *(const u32x4_t*)(DQG + _o + (size_t)(tid + 512) * 8); \
            rg[4] = *(const u32x4_t*)(DKDT + _o + (size_t)tid * 8); rg[5] = *(const u32x4_t*)(DKDT + _o + (size_t)(tid + 512) * 8); \
            rg[6] = *(const u32x4_t*)(DATT + (size_t)(itm) * 4096 + (size_t)tid * 8); \
            _Pragma("unroll") for (int _r = 0; _r < 4; ++_r) un[_r] = DU[_o + (size_t)(16 * cb + 4 * fq + _r) * 128 + e0 + 16 * eb + fr]; \
            egl_n = DEGL[(itm)]; } while (0)
#define DN_STORE(bufo) do { LAS unsigned char* _b = lds + (bufo); \
            *(LAS u32x4_t*)(_b + O_W + lds_off16(tid >> 4, tid & 15)) = rg[0]; *(LAS u32x4_t*)(_b + O_W + lds_off16((tid + 512) >> 4, tid & 15)) = rg[1]; \
            *(LAS u32x4_t*)(_b + O_QG + lds_off16(tid >> 4, tid & 15)) = rg[2]; *(LAS u32x4_t*)(_b + O_QG + lds_off16((tid + 512) >> 4, tid & 15)) = rg[3]; \
            *(LAS u32x4_t*)(_b + O_KDT + lds_off8(tid >> 3, tid & 7)) = rg[4]; *(LAS u32x4_t*)(_b + O_KDT + lds_off8((tid + 512) >> 3, tid & 7)) = rg[5]; \
            *(LAS u32x4_t*)(_b + O_ATT + lds_off8(tid >> 3, tid & 7)) = rg[6]; } while (0)
        DN_LOAD(item0);
        DN_STORE(0);
        float u[4] = {un[0], un[1], un[2], un[3]}; float egl = egl_n;
        __syncthreads();
        for (int n = 0; n < 32; ++n) {
            const int bufo = (n & 1) * BUF, sbo = O_SB + (n & 1) * 8192, sbn = O_SB + ((n + 1) & 1) * 8192;
            if (n < 31) DN_LOAD(item0 + n + 1);
            f32x4 acc = {0.f, 0.f, 0.f, 0.f};
            bf16x8_t sf[4];
#pragma unroll
            for (int s4 = 0; s4 < 4; ++s4) sf[s4] = ldfrag(lds + sbo + lds_off16(16 * eb + fr, 4 * s4 + fq));
#pragma unroll
            for (int s4 = 0; s4 < 4; ++s4) acc = __builtin_amdgcn_mfma_f32_16x16x32_bf16(ldfrag(lds + bufo + O_W + lds_off16(16 * cb + fr, 4 * s4 + fq)), sf[s4], acc, 0, 0, 0);
            {
                const float v0 = u[0] - acc[0], v1 = u[1] - acc[1], v2 = u[2] - acc[2], v3 = u[3] - acc[3];
                u32x2_t w; w.x = pk2bf(v0, v1); w.y = pk2bf(v2, v3);
                *(LAS u32x2_t*)(lds + O_VNT + lds_off8(16 * eb + fr, 2 * cb + (fq >> 1)) + 8 * (fq & 1)) = w;
            }
            __syncthreads();
            f32x4 oacc = {0.f, 0.f, 0.f, 0.f};
#pragma unroll
            for (int s4 = 0; s4 < 4; ++s4) oacc = __builtin_amdgcn_mfma_f32_16x16x32_bf16(ldfrag(lds + bufo + O_QG + lds_off16(16 * cb + fr, 4 * s4 + fq)), sf[s4], oacc, 0, 0, 0);
            bf16x8_t vf[2][2];
#pragma unroll
            for (int e2 = 0; e2 < 2; ++e2)
#pragma unroll
                for (int s2 = 0; s2 < 2; ++s2) vf[e2][s2] = ldfrag(lds + O_VNT + lds_off8(16 * e2 + fr, 4 * s2 + fq));
#pragma unroll
            for (int s2 = 0; s2 < 2; ++s2) oacc = __builtin_amdgcn_mfma_f32_16x16x32_bf16(ldfrag(lds + bufo + O_ATT + lds_off8(16 * cb + fr, 4 * s2 + fq)), ldfrag(lds + O_VNT + lds_off8(16 * eb + fr, 4 * s2 + fq)), oacc, 0, 0, 0);
            {
                const size_t t0 = (size_t)b * NS_ + n * 64;
#pragma unroll
                for (int r = 0; r < 4; ++r) ORAW[(t0 + 16 * cb + 4 * fq + r) * 512 + h * 128 + e0 + 16 * eb + fr] = oacc[r];
            }
#pragma unroll
            for (int e2 = 0; e2 < 2; ++e2) {
                st[e2] = st[e2] * egl;
#pragma unroll
                for (int s2 = 0; s2 < 2; ++s2) st[e2] = __builtin_amdgcn_mfma_f32_16x16x32_bf16(ldfrag(lds + bufo + O_KDT + lds_off8(16 * wave + fr, 4 * s2 + fq)), vf[e2][s2], st[e2], 0, 0, 0);
                u32x2_t w; w.x = pk2bf(st[e2][0], st[e2][1]); w.y = pk2bf(st[e2][2], st[e2][3]);
                *(LAS u32x2_t*)(lds + sbn + lds_off16(16 * e2 + fr, 2 * wave + (fq >> 1)) + 8 * (fq & 1)) = w;
            }
            if (n < 31) { DN_STORE(((n + 1) & 1) * BUF); u[0] = un[0]; u[1] = un[1]; u[2] = un[2]; u[3] = un[3]; egl = egl_n; }
            __syncthreads();
        }
#undef DN_LOAD
#undef DN_STORE
        {
            unsigned* flag = (unsigned*)(p.ws + WS_CTL) + CW_DNF + 64 * bh;
            asm volatile("s_waitcnt vmcnt(0)" ::: "memory");
            __syncthreads();
            if (tid == 0) {
                __builtin_amdgcn_fence(__ATOMIC_RELEASE, "agent");
                asm volatile("s_waitcnt vmcnt(0)" ::: "memory");
                __hip_atomic_fetch_add(flag, 1u, __ATOMIC_RELAXED, __HIP_MEMORY_SCOPE_AGENT);
                unsigned sp = 0;
                while (__hip_atomic_load(flag, __ATOMIC_RELAXED, __HIP_MEMORY_SCOPE_AGENT) < 4u) { __builtin_amdgcn_s_sleep(2); if (++sp > (1u << 22)) break; }
                __builtin_amdgcn_fence(__ATOMIC_ACQUIRE, "agent");
                asm volatile("s_waitcnt vmcnt(0)" ::: "memory");
            }
            __syncthreads();
            const bf16* PROJ = (const bf16*)(p.ws + WS_PROJ); bf16* MIXED = (bf16*)(p.ws + WS_MIXED);
            const float2 nw = *(const float2*)(p.in[10] + 2 * lane);
            const int tq0 = b * NS_ + es * 512 + (tid >> 6) * 64;
#pragma unroll 1
            for (int i0 = 0; i0 < 64; i0 += 8) {
                float2 o[8]; unsigned zz[8];
#pragma unroll
                for (int q = 0; q < 8; ++q) { const size_t t = (size_t)(tq0 + i0 + q); o[q] = *(const float2*)(ORAW + t * 512 + h * 128 + 2 * lane); zz[q] = *(const unsigned*)(PROJ + t * PJ + 1536 + h * 128 + 2 * lane); }
#pragma unroll
                for (int q = 0; q < 8; ++q) {
                    const float ss = wave_sum(o[q].x * o[q].x + o[q].y * o[q].y);
                    const float r = rsqrtf(ss * (1.f / 128.f) + EPS);
                    const float m0 = o[q].x * r * nw.x * siluf_(bf2f(zz[q] & 0xffffu)), m1 = o[q].y * r * nw.y * siluf_(bf2f(zz[q] >> 16));
                    *(unsigned*)(MIXED + (size_t)(tq0 + i0 + q) * D_ + h * 128 + 2 * lane) = f2bf(m0) | (f2bf(m1) << 16);
                }
            }
        }
    }
}

__device__ void ph_cf(int wv, const Params& p, LAS float* lds, int bid, int nb) {
    const int tid = opaque_tid(), lane = tid & 63, wave = tid >> 6;
    const bf16* PROJ = (const bf16*)(p.ws + WS_PROJ);
    const float* pwb = p.in[11]; const float* dww = p.in[12]; const float* dwb = p.in[13]; const float* lnw = p.in[14]; const float* lnb = p.in[15];
    bf16* MIXED = (bf16*)(p.ws + WS_MIXED);
    constexpr int TT = 32;
    const int c = tid;
    float w[CFK];
#pragma unroll
    for (int j = 0; j < CFK; ++j) w[j] = dww[j * CFW + c];
    const float ba = pwb[c], bg = pwb[512 + c], cb = dwb[c];
    for (int it = bid; it < T_ / TT; it += nb) {
        const int t0 = it * TT, tl0 = t0 % NS_;
        float xg[TT + CFK - 1];
#pragma unroll
        for (int i0 = 0; i0 < TT + CFK - 1; i0 += 16) {
            unsigned ra[16], rg[16];
#pragma unroll
            for (int q = 0; q < 16; ++q) if (i0 + q < TT + CFK - 1) {
                const int tl = tl0 - (CFK - 1) + i0 + q;
                const size_t row = (size_t)(t0 - (CFK - 1) + i0 + q + (tl < 0 ? -tl : 0));
                ra[q] = PROJ[row * PJ + 2048 + c]; rg[q] = PROJ[row * PJ + 2560 + c];
            } else { ra[q] = 0; rg[q] = 0; }
            asm volatile("" : "+v"(ra[0]), "+v"(ra[1]), "+v"(ra[2]), "+v"(ra[3]), "+v"(ra[4]), "+v"(ra[5]), "+v"(ra[6]), "+v"(ra[7]), "+v"(ra[8]), "+v"(ra[9]), "+v"(ra[10]), "+v"(ra[11]), "+v"(ra[12]), "+v"(ra[13]), "+v"(ra[14]), "+v"(ra[15]));
            asm volatile("" : "+v"(rg[0]), "+v"(rg[1]), "+v"(rg[2]), "+v"(rg[3]), "+v"(rg[4]), "+v"(rg[5]), "+v"(rg[6]), "+v"(rg[7]), "+v"(rg[8]), "+v"(rg[9]), "+v"(rg[10]), "+v"(rg[11]), "+v"(rg[12]), "+v"(rg[13]), "+v"(rg[14]), "+v"(rg[15]));
#pragma unroll
            for (int q = 0; q < 16; ++q) if (i0 + q < TT + CFK - 1) {
                const int tl = tl0 - (CFK - 1) + i0 + q;
                const float a = bf2f(ra[q]) + ba, gt = bf2f(rg[q]) + bg;
                xg[i0 + q] = tl >= 0 ? a * sigmoidf_(gt) : 0.f;
            }
        }
        __syncthreads();
#pragma unroll
        for (int r = 0; r < TT; ++r) {
            float s = cb;
#pragma unroll
            for (int j = 0; j < CFK; ++j) s += w[j] * xg[r + j];
            lds[r * 512 + c] = s;
        }
        __syncthreads();
#pragma unroll
        for (int rr = 0; rr < 4; ++rr) {
            const int r = wave * 4 + rr;
            float v[8]; float s = 0.f;
#pragma unroll
            for (int j = 0; j < 8; ++j) { v[j] = lds[r * 512 + lane + 64 * j]; s += v[j]; }
            const float mu = wave_sum(s) * (1.f / 512.f);
            float q = 0.f;
#pragma unroll
            for (int j = 0; j < 8; ++j) { v[j] -= mu; q += v[j] * v[j]; }
            const float rstd = rsqrtf(wave_sum(q) * (1.f / 512.f) + EPS);
#pragma unroll
            for (int j = 0; j < 8; ++j) { const int cc = lane + 64 * j; const float y = v[j] * rstd * lnw[cc] + lnb[cc]; MIXED[(size_t)(t0 + r) * D_ + 512 + cc] = (bf16)f2bf(siluf_(y)); }
        }
    }
}

__device__ __forceinline__ void ph_outproj(int wv, const Params& p, LAS unsigned char* lds, int bid, int nb) {
    pg8::DenseSched S; S.init(p.ws + WS_MIXED, p.ws + WS_WOUTT, T_, D_, D_, nb, bid);
    pg8::EpiBf16 E{(bf16*)(p.ws + WS_HMIX), D_};
    pg8::gemm_phase(wv, lds, S, E);
}

struct Row2Par { f32x4 g1n[4], a2[4], b2[4]; };
__device__ __forceinline__ void row2_front(const Params& p, LAS unsigned char* lds, int t, int lr, int lane, const f32x4 (&hm)[4], const f32x4 (&xv)[4], const Row2Par& P) {
    bf16* H2 = (bf16*)(p.ws + WS_H);
    float ss = 0.f;
#pragma unroll
    for (int j = 0; j < 4; ++j) ss += hm[j][0] * hm[j][0] + hm[j][1] * hm[j][1] + hm[j][2] * hm[j][2] + hm[j][3] * hm[j][3];
    ss = wave_sum(ss);
    const float r1 = rsqrtf(ss * (1.f / D_) + EPS);
    f32x4 x1[4]; float s2 = 0.f;
#pragma unroll
    for (int j = 0; j < 4; ++j) {
        const int c0 = 4 * lane + 256 * j;
        x1[j] = xv[j] + P.g1n[j] * (hm[j] * r1);
        s2 += x1[j][0] * x1[j][0] + x1[j][1] * x1[j][1] + x1[j][2] * x1[j][2] + x1[j][3] * x1[j][3];
        *(f32x4*)(p.out + (size_t)t * D_ + c0) = x1[j];
    }
    s2 = wave_sum(s2);
    const float r2 = rsqrtf(s2 * (1.f / D_) + EPS);
#pragma unroll
    for (int j = 0; j < 4; ++j) {
        const int c0 = 4 * lane + 256 * j;
        const f32x4 h = x1[j] * r2 * P.a2[j] + P.b2[j];
        unsigned hi[4]; float lo[4];
#pragma unroll
        for (int i = 0; i < 4; ++i) { hi[i] = f2bf(h[i]); lo[i] = h[i] - bf2f(hi[i]); }
        u32x2_t wh; wh.x = hi[0] | (hi[1] << 16); wh.y = hi[2] | (hi[3] << 16);
        u32x2_t wl; wl.x = pk2bf(lo[0], lo[1]); wl.y = pk2bf(lo[2], lo[3]);
        *(u32x2_t*)(H2 + (size_t)t * D_ + c0) = wh;
        const int ch = c0 >> 3, off = lr * 2048 + ((ch ^ (lr & 15)) << 4) + (c0 & 7) * 2;
        *(LAS u32x2_t*)(lds + off) = wh; *(LAS u32x2_t*)(lds + 65536 + off) = wl;
    }
}
__device__ void ph_row2(int wv, const Params& p, LAS unsigned char* lds, int chunk0) {
    const int tid = opaque_tid(), lane = tid & 63, wave = __builtin_amdgcn_readfirstlane(tid >> 6), fr = lane & 15, fq = lane >> 4;
    const float* x = p.in[0]; const float* brg = p.in[20]; const float* bre = p.in[22];
    const bf16* HMIX = (const bf16*)(p.ws + WS_HMIX);
    const bf16* WRTH = (const bf16*)(p.ws + WS_WRTH); const bf16* WRTL = (const bf16*)(p.ws + WS_WRTL);
    int* ROUTE = (int*)(p.ws + WS_ROUTE); int* POS = (int*)(p.ws + WS_POS); int* TOKL = (int*)(p.ws + WS_TOKL); float* WL = (float*)(p.ws + WS_WL);
    unsigned* cnt = (unsigned*)(p.ws + WS_CTL) + CW_CNT;
    LAS float* PART = (LAS float*)lds;
    LAS float* LOG = (LAS float*)(lds + 131072);
    LAS int* rte = (LAS int*)(lds + 131072 + 10240); LAS int* rtr = rte + 128; LAS float* rtw = (LAS float*)(rtr + 128); LAS int* lcnt = (LAS int*)(rtw + 128); LAS int* lbase = lcnt + 64;
    if (tid < 64) lcnt[tid] = 0;
    __syncthreads();
    for (int chunk = chunk0; chunk < chunk0 + 1; ++chunk) {
#pragma unroll 1
        for (int pass = 0; pass < 2; ++pass) {
            Row2Par P;
            { int lo_ = lane; asm volatile("" : "+v"(lo_));
              const float* mod = (const float*)(p.ws + WS_MOD) + ((chunk * 64) / NS_) * 6144;
#pragma unroll
              for (int j = 0; j < 4; ++j) { const int c0 = 4 * lo_ + 256 * j;
                  P.g1n[j] = *(const f32x4*)(mod + 2048 + c0) * *(const f32x4*)(p.in[5] + c0);
                  P.a2[j] = *(const f32x4*)(p.in[17] + c0) * (*(const f32x4*)(mod + 4096 + c0) + 1.f);
                  P.b2[j] = *(const f32x4*)(mod + 3072 + c0); } }
            const int tb = chunk * 64 + pass * 32 + wave * 4;
            f32x4 hmA[4], xvA[4], hmB[4], xvB[4];
#define R2_LOAD(hm, xv, t) do { _Pragma("unroll") for (int j = 0; j < 4; ++j) { const u32x2_t _h = *(const u32x2_t*)(HMIX + (size_t)(t) * D_ + 4 * lane + 256 * j); hm[j] = (f32x4){bf2f(_h.x & 0xffffu), bf2f(_h.x >> 16), bf2f(_h.y & 0xffffu), bf2f(_h.y >> 16)}; xv[j] = *(const f32x4*)(x + (size_t)(t) * D_ + 4 * lane + 256 * j); } } while (0)
            R2_LOAD(hmA, xvA, tb); R2_LOAD(hmB, xvB, tb + 1);
            row2_front(p, lds, tb, wave * 4, lane, hmA, xvA, P);
            R2_LOAD(hmA, xvA, tb + 2);
            row2_front(p, lds, tb + 1, wave * 4 + 1, lane, hmB, xvB, P);
            R2_LOAD(hmB, xvB, tb + 3);
            row2_front(p, lds, tb + 2, wave * 4 + 2, lane, hmA, xvA, P);
            row2_front(p, lds, tb + 3, wave * 4 + 3, lane, hmB, xvB, P);
#undef R2_LOAD
            __syncthreads();
            f32x4 acc[2][5];
#pragma unroll
            for (int mb = 0; mb < 2; ++mb)
#pragma unroll
                for (int n5 = 0; n5 < 5; ++n5) acc[mb][n5] = (f32x4){0.f, 0.f, 0.f, 0.f};
            bf16x8_t bh[1][5], bl[1][5];
#define R2_BLOAD(buf, s4) do { const int _ks = wave * 4 + (s4); _Pragma("unroll") for (int n5 = 0; n5 < 5; ++n5) { \
                bh[buf][n5] = *(const bf16x8_t*)(WRTH + (size_t)(16 * n5 + fr) * 1024 + _ks * 32 + fq * 8); bl[buf][n5] = *(const bf16x8_t*)(WRTL + (size_t)(16 * n5 + fr) * 1024 + _ks * 32 + fq * 8); } } while (0)
#define R2_BFORCE(buf) do { asm volatile("" : "+v"(bh[buf][0]), "+v"(bh[buf][1]), "+v"(bh[buf][2]), "+v"(bh[buf][3]), "+v"(bh[buf][4]), "+v"(bl[buf][0]), "+v"(bl[buf][1]), "+v"(bl[buf][2]), "+v"(bl[buf][3]), "+v"(bl[buf][4])); } while (0)
#pragma unroll
            for (int s4 = 0; s4 < 4; ++s4) {
                const int ks = wave * 4 + s4;
                R2_BLOAD(0, s4);
                bf16x8_t ah[2], al[2];
#pragma unroll
                for (int mb = 0; mb < 2; ++mb) { const int r = 16 * mb + fr, off = r * 2048 + (((4 * ks + fq) ^ (r & 15)) << 4); ah[mb] = ldfrag(lds + off); al[mb] = ldfrag(lds + 65536 + off); }
                R2_BFORCE(0);
#pragma unroll
                for (int n5 = 0; n5 < 5; ++n5) {
#pragma unroll
                    for (int mb = 0; mb < 2; ++mb) {
                        acc[mb][n5] = __builtin_amdgcn_mfma_f32_16x16x32_bf16(ah[mb], bh[0][n5], acc[mb][n5], 0, 0, 0);
                        acc[mb][n5] = __builtin_amdgcn_mfma_f32_16x16x32_bf16(al[mb], bh[0][n5], acc[mb][n5], 0, 0, 0);
                        acc[mb][n5] = __builtin_amdgcn_mfma_f32_16x16x32_bf16(ah[mb], bl[0][n5], acc[mb][n5], 0, 0, 0);
                    }
                }
            }
#undef R2_BLOAD
#undef R2_BFORCE
            __syncthreads();
            { const int l2 = lane_id_v(), fq2 = l2 >> 4, fr2 = l2 & 15;
#pragma unroll
            for (int mb = 0; mb < 2; ++mb)
#pragma unroll
                for (int n5 = 0; n5 < 5; ++n5)
#pragma unroll
                    for (int r = 0; r < 4; ++r) PART[(wave * 32 + 16 * mb + 4 * fq2 + r) * 80 + 16 * n5 + fr2] = acc[mb][n5][r]; }
            __syncthreads();
            const int tid3 = opaque_tid();
            for (int i = tid3; i < 2560; i += NTHR) { float a = 0.f;
#pragma unroll
                for (int w = 0; w < 8; ++w) a += PART[w * 2560 + i];
                LOG[i] = a; }
            __syncthreads();
            if (tid3 < 32) {
                const LAS float* lg = LOG + tid3 * 80;
                float gmax = -3.0e38f; int gi = 0; float gl[8];
#pragma unroll
                for (int o = 0; o < 8; ++o) { gl[o] = lg[o] + brg[o]; if (gl[o] > gmax) { gmax = gl[o]; gi = o; } }
                float gden = 0.f;
#pragma unroll
                for (int o = 0; o < 8; ++o) gden += __expf(gl[o] - gmax);
                const float gp = 1.f / gden;
                float m1 = -3.0e38f, m2 = -3.0e38f; int i1 = 0, i2 = 0; float el[8];
#pragma unroll
                for (int o = 0; o < 8; ++o) el[o] = lg[16 + gi * 8 + o] + bre[gi * 8 + o];
#pragma unroll
                for (int o = 0; o < 8; ++o) { if (el[o] > m1) { m1 = el[o]; i1 = o; } }
#pragma unroll
                for (int o = 0; o < 8; ++o) { if (o != i1 && el[o] > m2) { m2 = el[o]; i2 = o; } }
                const float e2 = __expf(m2 - m1);
                const int lr = pass * 32 + tid3, ea = gi * 8 + i1, eb = gi * 8 + i2;
                rte[2 * lr] = ea; rte[2 * lr + 1] = eb;
                rtw[2 * lr] = gp * (1.f / (1.f + e2)); rtw[2 * lr + 1] = gp * (e2 / (1.f + e2));
                rtr[2 * lr] = __hip_atomic_fetch_add(lcnt + ea, 1, __ATOMIC_RELAXED, __HIP_MEMORY_SCOPE_WORKGROUP); rtr[2 * lr + 1] = __hip_atomic_fetch_add(lcnt + eb, 1, __ATOMIC_RELAXED, __HIP_MEMORY_SCOPE_WORKGROUP);
            }
            __syncthreads();
        }
        const int tq = opaque_tid();
        if (tq < 64) { const int c = lcnt[tq]; lbase[tq] = c > 0 ? (int)atomicAdd(cnt + tq, (unsigned)c) : 0; }
        __syncthreads();
        if (tq < 128) {
            const int e = rte[tq], pos = lbase[e] + rtr[tq], t = chunk * 64 + (tq >> 1);
            ROUTE[(size_t)t * 4 + (tq & 1)] = e; POS[(size_t)t * 2 + (tq & 1)] = pos;
            TOKL[(size_t)e * T_ + pos] = t; WL[(size_t)e * T_ + pos] = rtw[tq];
        }
        __syncthreads();
        if (tq < 64) lcnt[tq] = 0;
        __syncthreads();
    }
}

struct MoeMap { LAS int* tstart; LAS int* cnt; int total_tiles; };
__device__ __forceinline__ MoeMap moe_map(int wv, const Params& p, LAS int* l) {
    const unsigned* cnt = (const unsigned*)(p.ws + WS_CTL) + CW_CNT;
    __syncthreads();
    if (wv == 0) {
        const int e = lane_id_v();
        const int c = (int)__hip_atomic_load(cnt + e, __ATOMIC_RELAXED, __HIP_MEMORY_SCOPE_AGENT);
        const int nt = (c + TM - 1) / TM; int incl = nt;
#pragma unroll
        for (int o = 1; o < 64; o <<= 1) { const int y = __shfl_up(incl, o); if (e >= o) incl += y; }
        l[e] = incl - nt; l[128 + e] = c; if (e == 63) l[NE] = incl;
    }
    __syncthreads();
    MoeMap m; m.tstart = l; m.cnt = l + 128; m.total_tiles = l[NE];
    return m;
}
__device__ __forceinline__ int moe_find(const MoeMap& m, int tile) { int e = 0; while (e < NE - 1 && m.tstart[e + 1] <= tile) ++e; return e; }

__device__ __forceinline__ void ph_moe_gu(int wv, const Params& p, LAS unsigned char* lds, int bid, int nb) {
    MoeMap mm = moe_map(wv, p, (LAS int*)(lds + pg8::STAGE_BYTES));
    pg8::GroupSched S{(const char*)(p.ws + WS_H), (const char*)(p.ws + WS_WGUT), D_, 4, (size_t)2 * DE * D_ * 2, mm.tstart, mm.cnt, mm.total_tiles, nb, bid, (const int*)(p.ws + WS_TOKL)};
    pg8::EpiGU E{(bf16*)(p.ws + WS_HID)};
    pg8::gemm_phase(wv, lds, S, E);
}
__device__ __forceinline__ void ph_moe_down(int wv, const Params& p, LAS unsigned char* lds, int bid, int nb) {
    MoeMap mm = moe_map(wv, p, (LAS int*)(lds + pg8::STAGE_BYTES));
    pg8::GroupSched S{(const char*)(p.ws + WS_HID), (const char*)(p.ws + WS_WDNT), DE, 4, (size_t)D_ * DE * 2, mm.tstart, mm.cnt, mm.total_tiles, nb, bid, nullptr};
    pg8::EpiDown E{(bf16*)(p.ws + WS_Y), (const float*)(p.ws + WS_WL), mm.cnt};
    pg8::gemm_phase(wv, lds, S, E);
}

__device__ void ph_final(int wv, const Params& p, LAS float* lds, int bid, int nb) {
    const int tid = opaque_tid(), lane = tid & 63, wave = tid >> 6;
    const float* npf = p.in[18]; const float* mod = (const float*)(p.ws + WS_MOD);
    const bf16* Y = (const bf16*)(p.ws + WS_Y); const int* ROUTE = (const int*)(p.ws + WS_ROUTE); const int* POS = (const int*)(p.ws + WS_POS);
    MoeMap mm = moe_map(wv, p, (LAS int*)lds);
    for (int t = bid * 8 + wave; t < T_; t += nb * 8) {
        const int b = t / NS_;
        const int ea = ROUTE[(size_t)t * 4], eb = ROUTE[(size_t)t * 4 + 1];
        const size_t ga = (size_t)mm.tstart[ea] * TM + POS[(size_t)t * 2], gb = (size_t)mm.tstart[eb] * TM + POS[(size_t)t * 2 + 1];
        float m[16]; float ss = 0.f;
#pragma unroll
        for (int j = 0; j < 4; ++j) {
            const uint2 a = *(const uint2*)(Y + ga * D_ + 4 * lane + 256 * j), bb = *(const uint2*)(Y + gb * D_ + 4 * lane + 256 * j);
            m[4 * j] = bf2f(a.x & 0xffffu) + bf2f(bb.x & 0xffffu); m[4 * j + 1] = bf2f(a.x >> 16) + bf2f(bb.x >> 16);
            m[4 * j + 2] = bf2f(a.y & 0xffffu) + bf2f(bb.y & 0xffffu); m[4 * j + 3] = bf2f(a.y >> 16) + bf2f(bb.y >> 16);
#pragma unroll
            for (int i = 0; i < 4; ++i) ss += m[4 * j + i] * m[4 * j + i];
        }
        ss = wave_sum(ss);
        const float r = rsqrtf(ss * (1.f / D_) + EPS);
#pragma unroll
        for (int j = 0; j < 4; ++j) {
            const int c0 = 4 * lane + 256 * j;
            float4 o = *(float4*)(p.out + (size_t)t * D_ + c0);
            o.x += mod[b * 6144 + 5120 + c0] * (m[4 * j] * r * npf[c0]);
            o.y += mod[b * 6144 + 5120 + c0 + 1] * (m[4 * j + 1] * r * npf[c0 + 1]);
            o.z += mod[b * 6144 + 5120 + c0 + 2] * (m[4 * j + 2] * r * npf[c0 + 2]);
            o.w += mod[b * 6144 + 5120 + c0 + 3] * (m[4 * j + 3] * r * npf[c0 + 3]);
            *(float4*)(p.out + (size_t)t * D_ + c0) = o;
        }
    }
}

constexpr int LDS_BYTES = 147456;
#define XB_TMO      128
#define XB_XCNT(j)  (256  + 64 * (j))
#define XB_XSUB(j)  (1280 + 64 * (j))
#define XB_XGEN(j)  (2304 + 64 * (j))
#define XB_TOP      3328
#define XB_TOPGEN   3392
#define XCD_BAR_WORDS 3456
#define XB_SPIN_CAP (1u << 22)
__device__ __forceinline__ unsigned xb_ld(unsigned* p)              { return __hip_atomic_load(p, __ATOMIC_RELAXED, __HIP_MEMORY_SCOPE_AGENT); }
__device__ __forceinline__ unsigned xb_add(unsigned* p, unsigned v) { return __hip_atomic_fetch_add(p, v, __ATOMIC_RELAXED, __HIP_MEMORY_SCOPE_AGENT); }
__device__ __forceinline__ unsigned xb_xcc_id() { return (unsigned)__builtin_amdgcn_s_getreg((3 << 11) | 20) & 0xFu; }
#define XB_SPIN(cond, bar) do { unsigned _sp = 0; while (cond) { __builtin_amdgcn_s_sleep(1); \
    if ((++_sp & 255u) == 0u) { if (xb_ld(&(bar)[XB_TMO])) break; if (_sp > XB_SPIN_CAP) { atomicAdd(&(bar)[XB_TMO], 1u); break; } } } } while (0)
struct XcdBarrier { unsigned* bar; unsigned x; volatile LAS unsigned* st; };
__device__ __forceinline__ XcdBarrier xcd_barrier_post(int wv, unsigned* bar, volatile LAS unsigned* st) {
    XcdBarrier b; b.bar = bar; b.x = xb_xcc_id(); b.st = st;
    if (wv == 0 && lane_id_v() == 0) (void)xb_add(&bar[XB_XCNT(b.x)], 1u);
    return b;
}
__device__ __forceinline__ void xcd_barrier_complete(unsigned* bar, unsigned x, unsigned& nloc, unsigned& nx) {
    const unsigned G = gridDim.x * gridDim.y * gridDim.z;
    unsigned sum, cnt, mine, sp = 0u;
    for (;;) {
        sum = 0u; cnt = 0u; mine = 0u;
#pragma unroll
        for (unsigned j = 0; j < 16; ++j) { const unsigned c = xb_ld(&bar[XB_XCNT(j)]); sum += c; cnt += (c > 0u) ? 1u : 0u; mine = (j == x) ? c : mine; }
        if (sum == G) break;
        __builtin_amdgcn_s_sleep(1);
        if ((++sp & 255u) == 0u) { if (xb_ld(&bar[XB_TMO])) break; if (sp > XB_SPIN_CAP) { atomicAdd(&bar[XB_TMO], 1u); break; } }
    }
    nloc = mine > 0u ? mine : 1u; nx = cnt > 0u ? cnt : 1u;
}
__device__ __forceinline__ void xcd_barrier(int wv, unsigned char* ws, volatile LAS unsigned* st) {
    XcdBarrier b; b.bar = (unsigned*)(ws + WS_CTL) + 4096; b.x = xb_xcc_id(); b.st = st;
    asm volatile("s_waitcnt vmcnt(0)" ::: "memory");
    __syncthreads();
    if (wv == 0 && lane_id_v() == 0) {
        unsigned* bar = b.bar;
        __builtin_amdgcn_s_waitcnt(0);
        unsigned nloc = b.st[0], nx = b.st[1];
        if (nloc == 0u) { xcd_barrier_complete(bar, b.x, nloc, nx); b.st[0] = nloc; b.st[1] = nx; }
        const unsigned old = xb_add(&bar[XB_XSUB(b.x)], 1u);
        const unsigned gen = old / nloc;
        if (old + 1u == (gen + 1u) * nloc) {
            __builtin_amdgcn_fence(__ATOMIC_RELEASE, "agent");
            asm volatile("s_waitcnt vmcnt(0)" ::: "memory");
            const unsigned og = xb_add(&bar[XB_TOP], 1u);
            const unsigned tg = og / nx;
            if (og + 1u == (tg + 1u) * nx) xb_add(&bar[XB_TOPGEN], 1u);
            else XB_SPIN(xb_ld(&bar[XB_TOPGEN]) == tg, bar);
            __builtin_amdgcn_fence(__ATOMIC_ACQUIRE, "agent");
            xb_add(&bar[XB_XGEN(b.x)], 1u);
            asm volatile("s_waitcnt vmcnt(0)" ::: "memory");
        } else {
            XB_SPIN(xb_ld(&bar[XB_XGEN(b.x)]) == gen, bar);
            __builtin_amdgcn_fence(__ATOMIC_ACQUIRE, "agent");
            asm volatile("s_waitcnt vmcnt(0)" ::: "memory");
        }
    }
    __syncthreads();
}
constexpr int CW_BAR = 4096;
constexpr int LDS_ST_OFF = LDS_BYTES - 64;

__global__ void __launch_bounds__(NTHR, 2) mk_all(Params p) {
    extern __shared__ __attribute__((aligned(16))) unsigned char lds_raw[];
    LAS float* lds = (LAS float*)lds_raw;
    const int bid = blockIdx.x, nb = gridDim.x;
    volatile LAS unsigned* st = (volatile LAS unsigned*)((LAS unsigned char*)lds_raw + LDS_ST_OFF);
    const int wv = __builtin_amdgcn_readfirstlane(threadIdx.x >> 6);
    if (threadIdx.x < 16) st[threadIdx.x] = 0u;
    __syncthreads();
    (void)xcd_barrier_post(wv, (unsigned*)(p.ws + WS_CTL) + CW_BAR, st);
#ifndef STAMP_SEL
#define STAMP_SEL -1
#endif
    unsigned long long t_prev = 0, dt_sel = 0;
    if (STAMP_SEL >= 0) t_prev = __builtin_amdgcn_s_memrealtime();
#define STAMP(k) do { if (STAMP_SEL >= 0) { const unsigned long long now_ = __builtin_amdgcn_s_memrealtime(); if ((k) == STAMP_SEL && bid == 0) dt_sel = now_ - t_prev; t_prev = now_; } } while (0)
    ph_wprep(wv, p, lds, bid, nb); __syncthreads();
    ph_mod(wv, p, lds, bid, nb);            xcd_barrier(wv, p.ws, st); STAMP(0);
    int pan, qua; { pg8::DenseSched S0; S0.init(nullptr, nullptr, T_, D_, D_, nb, bid); pg8::Unit u0; S0.next(0, u0); pan = u0.pm; qua = u0.pn; }
    ph_h(wv, p, lds, pan * 256 + qua * 64);
    group_sync(wv, (unsigned*)(p.ws + WS_CTL) + CW_HF + 64 * pan, 4u); STAMP(1);
    ph_proj(wv, p, (LAS unsigned char*)lds_raw, bid, nb);           xcd_barrier(wv, p.ws, st); STAMP(2);
    ph_dnprep(wv, p, (LAS unsigned char*)lds_raw, bid, nb);    xcd_barrier(wv, p.ws, st); STAMP(3);
    {
        constexpr int CONV_ITEMS = NE * ((D_ / 64) * (2 * DE / 128) + (DE / 64) * (D_ / 128)), CONV_SPLIT = (CONV_ITEMS * 4 / 10) & ~7;
        if (bid < nb / 2) { ph_dnscan(wv, p, (LAS unsigned char*)lds_raw, bid, nb / 2); ph_wprep_experts(wv, p, bid, nb / 2, 0, CONV_SPLIT); }
        else { ph_cf(wv, p, lds, bid - nb / 2, nb - nb / 2); ph_wprep_experts(wv, p, bid - nb / 2, nb - nb / 2, CONV_SPLIT, CONV_ITEMS); }
    }
    if (STAMP_SEL == 40 && bid == 0) { const unsigned long long now_ = __builtin_amdgcn_s_memrealtime(); dt_sel = now_ - t_prev; }
    xcd_barrier(wv, p.ws, st); STAMP(4);
    ph_outproj(wv, p, (LAS unsigned char*)lds_raw, bid, nb);
    group_sync(wv, (unsigned*)(p.ws + WS_CTL) + CW_OF + 64 * pan, 4u); STAMP(6);
    ph_row2(wv, p, (LAS unsigned char*)lds_raw, pan * 4 + qua);           xcd_barrier(wv, p.ws, st); STAMP(7);
    ph_moe_gu(wv, p, (LAS unsigned char*)lds_raw, bid, nb);      xcd_barrier(wv, p.ws, st); STAMP(8);
    ph_moe_down(wv, p, (LAS unsigned char*)lds_raw, bid, nb);    xcd_barrier(wv, p.ws, st); STAMP(9);
    ph_final(wv, p, lds, bid, nb);
    if (STAMP_SEL >= 0) {
        __syncthreads(); STAMP(10);
        { const unsigned long long t0 = __builtin_amdgcn_s_memrealtime(); while (__builtin_amdgcn_s_memrealtime() - t0 < 8ull * dt_sel) __builtin_amdgcn_s_sleep(8); }
    }
}

extern "C" void kernel_launch(void* const* d_in, const int* in_sizes, int n_in, void* d_out, int out_size, void* d_ws, size_t ws_size, hipStream_t stream) {
    static int inited = 0;
    if (!inited) {
        if (n_in != 26 || out_size != T_ * D_ || ws_size < WS_END) { fprintf(stderr, "kernel_launch: unexpected shapes n_in %d out %d ws %zu\n", n_in, out_size, ws_size); inited = -1; return; }
        if (hipFuncSetAttribute((const void*)mk_all, hipFuncAttributeMaxDynamicSharedMemorySize, LDS_BYTES) != hipSuccess) { fprintf(stderr, "hipFuncSetAttribute failed\n"); inited = -1; return; }
        inited = 1;
    }
    if (inited < 0) return;
    (void)hipMemsetAsync((char*)d_ws + WS_CTL, 0, 1 * MiB, stream);
    Params p{};
    for (int i = 0; i < 26; ++i) p.in[i] = (const float*)d_in[i];
    p.out = (float*)d_out; p.ws = (unsigned char*)d_ws;
    hipLaunchKernelGGL(mk_all, dim3(256), dim3(NTHR), LDS_BYTES, stream, p);
}
```

```cpp
#include <hip/hip_runtime.h>
#include <cstdio>
#include <cstdint>

#define LAS __attribute__((address_space(3)))
typedef unsigned short bf16;
typedef float f32x4 __attribute__((ext_vector_type(4)));

constexpr int NB_ = 8, NS_ = 2048, D_ = 1024, T_ = NB_ * NS_;
constexpr int DNW = 512, NH = 4, HD = 128;
constexpr int CFW = 512, CFK = 31;
constexpr int INC = 3080;
constexpr int PJ = 3072;
constexpr int NE = 64, DE = 512;
constexpr int NTHR = 512;
constexpr float EPS = 1e-6f;
constexpr int TM = 256;
constexpr int MAXROWS = 2 * T_ + NE * TM;

constexpr size_t MiB = 1u << 20;
constexpr size_t WS_CTL = 0;
constexpr size_t WS_MOD = 1 * MiB;
constexpr size_t WS_SMALL = 1 * MiB + 512 * 1024;
constexpr size_t WS_ROUTE = 2 * MiB;
constexpr size_t WS_POS = 2 * MiB + 512 * 1024;
constexpr size_t WS_TOKL = 3 * MiB;
constexpr size_t WS_WL = 7 * MiB;
constexpr size_t WS_W8T = 11 * MiB;
constexpr size_t WS_WRTH = 12 * MiB;
constexpr size_t WS_WRTL = 12 * MiB + 256 * 1024;
constexpr size_t WS_WINT = 16 * MiB;
constexpr size_t WS_WOUTT = 22 * MiB;
constexpr size_t WS_WGUT = 24 * MiB;
constexpr size_t WS_WDNT = 152 * MiB;
constexpr size_t WS_H = 216 * MiB;
constexpr size_t WS_PROJ = 248 * MiB;
constexpr size_t WS_HMIX = 248 * MiB;
constexpr size_t WS_HID = 248 * MiB;
constexpr size_t WS_DW = 344 * MiB;
constexpr size_t WS_DQG = 360 * MiB;
constexpr size_t WS_DKDT = 376 * MiB;
constexpr size_t WS_DATT = 392 * MiB;
constexpr size_t WS_DU = 400 * MiB;
constexpr size_t WS_DEGL = 432 * MiB;
constexpr size_t WS_Y = 344 * MiB;
constexpr size_t WS_ORAW = 440 * MiB;
constexpr size_t WS_MIXED = 472 * MiB;
constexpr size_t WS_END = 504 * MiB;
constexpr int CW_CNT = 1024;
constexpr int CW_DNF = 2048;
constexpr int CW_HF = 8192;
constexpr int CW_OF = 12288;

__device__ __forceinline__ unsigned f2bf(float f) { unsigned u = __builtin_bit_cast(unsigned, f); return (u + 0x7fffu + ((u >> 16) & 1u)) >> 16; }
__device__ __forceinline__ float bf2f(unsigned b) { return __builtin_bit_cast(float, b << 16); }
template <int CTRL, int ROWMASK> __device__ __forceinline__ float dpp_f(float v) {
    return __builtin_bit_cast(float, __builtin_amdgcn_update_dpp(0, __builtin_bit_cast(int, v), CTRL, ROWMASK, 0xF, true));
}
__device__ __forceinline__ float wave_sum(float v) {
    v += dpp_f<0xB1, 0xF>(v);
    v += dpp_f<0x4E, 0xF>(v);
    v += dpp_f<0x141, 0xF>(v);
    v += dpp_f<0x140, 0xF>(v);
    v += dpp_f<0x142, 0xA>(v);
    v += dpp_f<0x143, 0xC>(v);
    return __builtin_bit_cast(float, __builtin_amdgcn_readlane(__builtin_bit_cast(int, v), 63));
}
__device__ __forceinline__ float sigmoidf_(float x) { return 1.f / (1.f + __expf(-x)); }
__device__ __forceinline__ float siluf_(float x) { return x / (1.f + __expf(-x)); }

__device__ __forceinline__ int lane_id_v() { int l; asm volatile("v_mbcnt_lo_u32_b32 %0, -1, 0\n\tv_mbcnt_hi_u32_b32 %0, -1, %0" : "=v"(l)); return l; }
__device__ __forceinline__ int opaque_tid_w(int wv) { return (wv << 6) | lane_id_v(); }
#define opaque_tid() opaque_tid_w(wv)

__device__ __forceinline__ void group_sync(int wv, unsigned* flag, unsigned target) {
    asm volatile("s_waitcnt vmcnt(0)" ::: "memory");
    __syncthreads();
    if (wv == 0 && lane_id_v() == 0) {
        __builtin_amdgcn_fence(__ATOMIC_RELEASE, "agent");
        asm volatile("s_waitcnt vmcnt(0)" ::: "memory");
        __hip_atomic_fetch_add(flag, 1u, __ATOMIC_RELAXED, __HIP_MEMORY_SCOPE_AGENT);
        unsigned sp = 0;
        while (__hip_atomic_load(flag, __ATOMIC_RELAXED, __HIP_MEMORY_SCOPE_AGENT) < target) { __builtin_amdgcn_s_sleep(2); if (++sp > (1u << 22)) break; }
        __builtin_amdgcn_fence(__ATOMIC_ACQUIRE, "agent");
        asm volatile("s_waitcnt vmcnt(0)" ::: "memory");
    }
    __syncthreads();
}

struct Params {
    const float* in[26];
    float* out;
    unsigned char* ws;
};


namespace pg8 {
#define PG8_LAS __attribute__((address_space(3)))
typedef unsigned short bf16_t;
typedef short bf16x8 __attribute__((ext_vector_type(8)));
typedef float f32x4 __attribute__((ext_vector_type(4)));
typedef unsigned u32x4 __attribute__((ext_vector_type(4)));
typedef unsigned u32x2 __attribute__((ext_vector_type(2)));
constexpr int BM = 256, BK = 64, HALF = 128, HTB = HALF * BK * 2, STAGE_BYTES = 8 * HTB, NXCD = 8, WGM = 8;
__host__ __device__ __forceinline__ int lds_byte(int r, int c) { const int st = (r >> 4) * 2 + (c >> 5), rr = r & 15, cc = c & 31, ob = rr * 64 + cc * 2; return st * 1024 + (ob ^ (((ob >> 9) & 1) << 5)); }
__host__ __device__ __forceinline__ void stage_rc(int b, int& R, int& C) { const int st = b / 1024, sb = b % 1024, swz = sb ^ (((sb >> 9) & 1) << 5); R = (st >> 1) * 16 + swz / 64; C = (st & 1) * 32 + (swz % 64) / 2; }
__host__ __device__ __forceinline__ int perm32(int rho) { const int n = rho >> 4, i = rho & 15; return 8 * (i >> 2) + 4 * n + (i & 3); }
struct Unit { int pm, pn, e, r0; };
__device__ __forceinline__ void st_wt16(void* p, u32x4 v) { asm volatile("global_store_dwordx4 %0, %1, off sc1\n\ts_nop 1" :: "v"(p), "v"(v) : "memory"); }
__device__ __forceinline__ unsigned cvt_pk_bf16(float lo, float hi) { unsigned r; asm volatile("v_cvt_pk_bf16_f32 %0, %1, %2" : "=v"(r) : "v"(lo), "v"(hi)); return r; }

struct DenseSched {
    const char* A; const char* Bt; int K; int nM, nN, nwg, G, c;
    __device__ void init(const void* A_, const void* Bt_, int M, int N, int K_, int G_, int c_) { A = (const char*)A_; Bt = (const char*)Bt_; K = K_; nM = M / BM; nN = N / BM; nwg = nM * nN; G = G_; c = c_; }
    __device__ bool next(int i, Unit& u) const {
        const long L = (long)i * G + c; if (L >= nwg) return false;
        int wgid = (int)L; { const int q = nwg / NXCD, r = nwg % NXCD, xcd = wgid % NXCD, off = wgid / NXCD; wgid = (xcd < r ? xcd * (q + 1) : r * (q + 1) + (xcd - r) * q) + off; }
        const int nig = WGM * nN, gid = wgid / nig, fm = gid * WGM, gsz = (nM - fm) < WGM ? (nM - fm) : WGM;
        u.pm = fm + ((wgid % nig) % gsz); u.pn = (wgid % nig) / gsz; u.e = 0; u.r0 = 0; return true;
    }
    __device__ __forceinline__ const char* a_base() const { return A; }
    __device__ __forceinline__ const char* b_ptr(const Unit& u) const { return Bt + (size_t)u.pn * BM * K * 2; }
    __device__ __forceinline__ void a_off(const Unit& u, const int (&R)[2], const int (&C)[2], unsigned (&v)[2][2]) const {
#pragma unroll
        for (int h = 0; h < 2; ++h)
#pragma unroll
            for (int i = 0; i < 2; ++i) v[h][i] = (unsigned)(((u.pm * BM + h * HALF + R[i]) * K + C[i]) * 2);
    }
};

struct EpiBf16 {
    static constexpr bool PERM = true;
    bf16_t* O; int ldc;
    __device__ __forceinline__ void operator()(const f32x4 (&acc)[2][2][4][2], const Unit& u, int wr, int wc, int fr, int fq) const {
        const int row0 = u.pm * BM + wr * 64 + fr, col0 = u.pn * BM + wc * 32 + 8 * fq;
#pragma unroll
        for (int ai = 0; ai < 2; ++ai)
#pragma unroll
            for (int m = 0; m < 4; ++m) { bf16_t* rowp = O + (size_t)(row0 + ai * HALF + m * 16) * ldc + col0;
#pragma unroll
                for (int bj = 0; bj < 2; ++bj) { const f32x4 v0 = acc[ai][bj][m][0], v1 = acc[ai][bj][m][1];
                    u32x4 w; w.x = cvt_pk_bf16(v0[0], v0[1]); w.y = cvt_pk_bf16(v0[2], v0[3]); w.z = cvt_pk_bf16(v1[0], v1[1]); w.w = cvt_pk_bf16(v1[2], v1[3]);
                    st_wt16(rowp + bj * HALF, w); } }
    }
};
struct EpiF32 {
    static constexpr bool PERM = false;
    float* C; int ldc;
    __device__ __forceinline__ void operator()(const f32x4 (&acc)[2][2][4][2], const Unit& u, int wr, int wc, int fr, int fq) const {
        const int row0 = u.pm * BM + wr * 64 + fr, col0 = u.pn * BM + wc * 32 + 4 * fq;
#pragma unroll
        for (int ai = 0; ai < 2; ++ai)
#pragma unroll
            for (int m = 0; m < 4; ++m) { float* rowp = C + (size_t)(row0 + ai * HALF + m * 16) * ldc + col0;
#pragma unroll
                for (int bj = 0; bj < 2; ++bj)
#pragma unroll
                    for (int n = 0; n < 2; ++n) *(f32x4*)(rowp + bj * HALF + n * 16) = acc[ai][bj][m][n]; }
    }
};

struct GroupSched {
    const char* A; const char* Bt; int K; int nN; size_t bstride; LAS int* tstart; LAS int* cnt; int total; int G, c; const int* tokl;
    __device__ __forceinline__ bool next(int i, Unit& u) const {
        const int L = i * G + c; if (L >= total * nN) return false;
        const int tile = L / nN; u.pn = L % nN; int e = 0; while (e < NE - 1 && tstart[e + 1] <= tile) ++e;
        u.e = e; u.pm = tile; u.r0 = (tile - tstart[e]) * BM; return true;
    }
    __device__ __forceinline__ const char* a_base() const { return A; }
    __device__ __forceinline__ const char* b_ptr(const Unit& u) const { return Bt + (size_t)u.e * bstride + (size_t)u.pn * BM * K * 2; }
    __device__ __forceinline__ void a_off(const Unit& u, const int (&R)[2], const int (&C)[2], unsigned (&v)[2][2]) const {
        const int ce = cnt[u.e];
#pragma unroll
        for (int h = 0; h < 2; ++h)
#pragma unroll
            for (int i = 0; i < 2; ++i) {
                const int r = u.r0 + h * HALF + R[i];
                int grow = u.pm * BM + h * HALF + R[i];
                if (tokl) grow = (r < ce) ? tokl[(size_t)u.e * T_ + r] : 0;
                v[h][i] = (unsigned)((grow * K + C[i]) * 2);
            }
    }
};
struct EpiGU {
    static constexpr bool PERM = false;
    bf16_t* HID;
    __device__ __forceinline__ void operator()(const f32x4 (&acc)[2][2][4][2], const Unit& u, int wr, int wc, int fr, int fq) const {
        const int row0 = u.pm * BM + wr * 64 + fr;
#pragma unroll
        for (int ai = 0; ai < 2; ++ai)
#pragma unroll
            for (int m = 0; m < 4; ++m) { bf16_t* rowp = HID + (size_t)(row0 + ai * HALF + m * 16) * DE;
#pragma unroll
                for (int bj = 0; bj < 2; ++bj) { const f32x4 g = acc[ai][bj][m][0], up = acc[ai][bj][m][1];
                    float h[4];
#pragma unroll
                    for (int i = 0; i < 4; ++i) h[i] = g[i] / (1.f + __expf(-g[i])) * up[i];
                    u32x2 w; w.x = cvt_pk_bf16(h[0], h[1]); w.y = cvt_pk_bf16(h[2], h[3]);
                    *(u32x2*)(rowp + 16 * (u.pn * 8 + 4 * bj + wc) + 4 * fq) = w; } }
    }
};
struct EpiDown {
    static constexpr bool PERM = true;
    bf16_t* Y; const float* wl; LAS int* cnt;
    __device__ __forceinline__ void operator()(const f32x4 (&acc)[2][2][4][2], const Unit& u, int wr, int wc, int fr, int fq) const {
        const int rloc = wr * 64 + fr, col0 = u.pn * BM + wc * 32 + 8 * fq, ce = cnt[u.e];
#pragma unroll
        for (int ai = 0; ai < 2; ++ai) {
            float w4[4];
#pragma unroll
            for (int m = 0; m < 4; ++m) { const int r = u.r0 + rloc + ai * HALF + m * 16; w4[m] = wl[(size_t)u.e * T_ + (r < ce ? r : 0)]; }
            asm volatile("" : "+v"(w4[0]), "+v"(w4[1]), "+v"(w4[2]), "+v"(w4[3]));
#pragma unroll
            for (int m = 0; m < 4; ++m) { const int r = u.r0 + rloc + ai * HALF + m * 16;
                if (r < ce) {
                    const float w = w4[m];
                    bf16_t* rowp = Y + (size_t)(u.pm * BM + rloc + ai * HALF + m * 16) * D_ + col0;
#pragma unroll
                    for (int bj = 0; bj < 2; ++bj) { const f32x4 v0 = acc[ai][bj][m][0] * w, v1 = acc[ai][bj][m][1] * w;
                        u32x4 o; o.x = cvt_pk_bf16(v0[0], v0[1]); o.y = cvt_pk_bf16(v0[2], v0[3]); o.z = cvt_pk_bf16(v1[0], v1[1]); o.w = cvt_pk_bf16(v1[2], v1[3]);
                        *(u32x4*)(rowp + bj * HALF) = o; } } }
        }
    }
};

template <class Epi, class Sched>
__device__ __forceinline__ void gemm_phase(int wv, PG8_LAS unsigned char* lds, const Sched& S, const Epi& E) {
    int tid_ = opaque_tid();
    const int tid = tid_, wid = __builtin_amdgcn_readfirstlane(tid >> 6), lane = tid & 63, wr = wid >> 2, wc = wid & 3, fr = lane & 15, fq = lane >> 4;
    const int K = S.K, nt = K / BK;
    int sR[2], sC[2]; unsigned voffB[2];
#pragma unroll
    for (int i = 0; i < 2; ++i) { int R, C; stage_rc(tid * 16 + i * 8192, R, C); sR[i] = R; sC[i] = C; const int Rb = Epi::PERM ? ((R & ~31) + perm32(R & 31)) : R; voffB[i] = (unsigned)(Rb * K + C) * 2u; }
    const size_t kstep = (size_t)(BK * 2);
    const size_t hstep = (size_t)HALF * K * 2;
    const unsigned ldsw = (unsigned)wid * 1024u;
    const int aoff = lds_byte(wr * 64 + fr, fq * 8), boff = lds_byte(wc * 32 + fr, fq * 8);
#define PG8_SA(b, h) (((b) * 2 + (h)) * HTB)
#define PG8_SB(b, h) ((4 + (b) * 2 + (h)) * HTB)
#define PG8_STAGE(bufoff, gbase, voff) do { _Pragma("unroll") for (int _i = 0; _i < 2; ++_i) \
        __builtin_amdgcn_global_load_lds((const unsigned*)((const char*)(gbase) + (voff)[_i]), (PG8_LAS unsigned*)(lds + (bufoff) + ldsw + _i * 8192), 16, 0, 0); } while (0)
#define PG8_LDA(dst, b, h) do { _Pragma("unroll") for (int m = 0; m < 4; ++m) _Pragma("unroll") for (int k = 0; k < 2; ++k) dst[m][k] = *(const PG8_LAS bf16x8*)(lds + PG8_SA(b, h) + aoff + m * 2048 + k * 1024); } while (0)
#define PG8_LDB(dst, b, h) do { _Pragma("unroll") for (int n = 0; n < 2; ++n) _Pragma("unroll") for (int k = 0; k < 2; ++k) dst[n][k] = *(const PG8_LAS bf16x8*)(lds + PG8_SB(b, h) + boff + n * 2048 + k * 1024); } while (0)
#define PG8_MMA(ai, bj, At, Bt) do { __builtin_amdgcn_s_setprio(1); _Pragma("unroll") for (int m = 0; m < 4; ++m) _Pragma("unroll") for (int n = 0; n < 2; ++n) _Pragma("unroll") for (int k = 0; k < 2; ++k) \
        acc[ai][bj][m][n] = __builtin_amdgcn_mfma_f32_16x16x32_bf16(Bt[n][k], At[m][k], acc[ai][bj][m][n], 0, 0, 0); __builtin_amdgcn_s_setprio(0); } while (0)
#define PG8_WAIT_V(n) asm volatile("s_waitcnt vmcnt(" #n ")" ::: "memory")
#define PG8_WAIT_L(n) asm volatile("s_waitcnt lgkmcnt(" #n ")" ::: "memory")
#define PG8_BAR __builtin_amdgcn_s_barrier()
#define PG8_SCHED __builtin_amdgcn_sched_barrier(0)
    Unit cur, nxt; int ui = 0;
    if (!S.next(0, cur)) return;
    f32x4 acc[2][2][4][2];
#pragma unroll
    for (int a = 0; a < 2; ++a)
#pragma unroll
        for (int b = 0; b < 2; ++b)
#pragma unroll
            for (int m = 0; m < 4; ++m)
#pragma unroll
                for (int n = 0; n < 2; ++n) acc[a][b][m][n] = (f32x4){0.f, 0.f, 0.f, 0.f};
    bf16x8 At[4][2], B0[2][2], B1[2][2];
    const char* const gA = S.a_base();
    unsigned vC[2][2];
    S.a_off(cur, sR, sC, vC);
    const char* cB = S.b_ptr(cur);
    PG8_STAGE(PG8_SB(0, 0), cB, voffB); PG8_STAGE(PG8_SB(0, 1), cB + hstep, voffB); PG8_STAGE(PG8_SA(0, 0), gA, vC[0]); PG8_STAGE(PG8_SA(0, 1), gA, vC[1]);
    if (wr == 1) PG8_BAR;
    PG8_WAIT_V(2); PG8_BAR;
    PG8_STAGE(PG8_SB(1, 0), cB + kstep, voffB); PG8_STAGE(PG8_SA(1, 0), gA + kstep, vC[0]); PG8_STAGE(PG8_SB(1, 1), cB + hstep + kstep, voffB);
    PG8_WAIT_V(6); PG8_BAR;
    for (;;) {
        const bool has_next = S.next(ui + 1, nxt);
        const char* nB = has_next ? S.b_ptr(nxt) : cB;
        for (int t = 0; t < nt; t += 2) {
            const bool last = (t == nt - 2);
            const char* a1 = gA + (size_t)(t + 1) * kstep;
            const char* a2 = last ? gA : gA + (size_t)(t + 2) * kstep; const char* b2 = last ? nB : cB + (size_t)(t + 2) * kstep;
            const char* a3 = a2 + kstep; const char* b3 = b2 + kstep;
            PG8_LDB(B0, 0, 0); PG8_LDB(B1, 0, 1); PG8_SCHED; PG8_LDA(At, 0, 0); PG8_STAGE(PG8_SA(1, 1), a1, vC[1]);
            PG8_WAIT_V(8); PG8_WAIT_L(0); PG8_BAR; PG8_MMA(0, 0, At, B0); PG8_MMA(0, 1, At, B1); PG8_BAR; PG8_SCHED;
            if (last && has_next) S.a_off(nxt, sR, sC, vC);
            PG8_LDA(At, 0, 1); PG8_STAGE(PG8_SB(0, 0), b2, voffB); PG8_STAGE(PG8_SB(0, 1), b2 + hstep, voffB); PG8_STAGE(PG8_SA(0, 0), a2, vC[0]);
            PG8_WAIT_V(8); PG8_WAIT_L(0); PG8_BAR; PG8_MMA(1, 0, At, B0); PG8_MMA(1, 1, At, B1); PG8_BAR; PG8_SCHED;
            PG8_LDB(B0, 1, 0); PG8_LDB(B1, 1, 1); PG8_SCHED; PG8_LDA(At, 1, 0); PG8_STAGE(PG8_SA(0, 1), a2, vC[1]);
            PG8_WAIT_V(8); PG8_WAIT_L(0); PG8_BAR; PG8_MMA(0, 0, At, B0); PG8_MMA(0, 1, At, B1); PG8_BAR; PG8_SCHED;
            PG8_LDA(At, 1, 1); PG8_STAGE(PG8_SB(1, 0), b3, voffB); PG8_STAGE(PG8_SB(1, 1), b3 + hstep, voffB); PG8_STAGE(PG8_SA(1, 0), a3, vC[0]);
            PG8_WAIT_V(8); PG8_WAIT_L(0); PG8_BAR; PG8_MMA(1, 0, At, B0); PG8_MMA(1, 1, At, B1); PG8_BAR; PG8_SCHED;
        }
        if (wr == 0) PG8_BAR;
        E(acc, cur, wr, wc, fr, fq);
        if (!has_next) break;
#pragma unroll
        for (int a = 0; a < 2; ++a)
#pragma unroll
            for (int b = 0; b < 2; ++b)
#pragma unroll
                for (int m = 0; m < 4; ++m)
#pragma unroll
                    for (int n = 0; n < 2; ++n) acc[a][b][m][n] = (f32x4){0.f, 0.f, 0.f, 0.f};
        cur = nxt; cB = nB; ++ui;
        if (wr == 1) PG8_BAR;
    }
    PG8_WAIT_V(0);
    PG8_BAR;
#undef PG8_SA
#undef PG8_SB
#undef PG8_STAGE
#undef PG8_LDA
#undef PG8_LDB
#undef PG8_MMA
#undef PG8_WAIT_V
#undef PG8_WAIT_L
#undef PG8_BAR
#undef PG8_SCHED
}
}

template <class CM>
__device__ __forceinline__ void transpose_item(const float* W, int ldw, int K, bf16* WT, LAS float* scr, int k0, int n0, int lane, const CM& cmap) {
    const int kb = lane >> 3, ng = lane & 7;
    const float* src = W + cmap(n0 + 4 * ng) + (size_t)(k0 + 8 * kb) * ldw;
    f32x4 v[8];
#pragma unroll
    for (int i = 0; i < 8; ++i) v[i] = *(const f32x4*)(src + (size_t)i * ldw);
#pragma unroll
    for (int q = 0; q < 4; ++q) {
        uint4 o; o.x = f2bf(v[0][q]) | (f2bf(v[1][q]) << 16); o.y = f2bf(v[2][q]) | (f2bf(v[3][q]) << 16); o.z = f2bf(v[4][q]) | (f2bf(v[5][q]) << 16); o.w = f2bf(v[6][q]) | (f2bf(v[7][q]) << 16);
        *(uint4*)(WT + (size_t)(n0 + 4 * ng + q) * K + k0 + 8 * kb) = o;
    }
}
__device__ void ph_wprep(int wv, const Params& p, LAS float* lds, int bid, int nb) {
    const int tid = opaque_tid(), lane = tid & 63, wave = tid >> 6;
    LAS float* scr = lds + wave * 4096;
    bf16* WINT = (bf16*)(p.ws + WS_WINT); bf16* WOUTT = (bf16*)(p.ws + WS_WOUTT);
    constexpr int I_IN = (D_ / 64) * (PJ / 32), I_OUT = (D_ / 64) * (D_ / 32);
    for (int it = bid * 8 + wave; it < I_IN + I_OUT; it += nb * 8) {
        if (it < I_IN) { const int kb = it / (PJ / 32), nbk = it % (PJ / 32); transpose_item(p.in[6], INC, D_, WINT, scr, 64 * kb, 32 * nbk, lane, [](int n) { return n < 2048 ? n : n + 8; }); }
        else { const int r = it - I_IN, kb = r / (D_ / 32), nbk = r % (D_ / 32); transpose_item(p.in[16], D_, D_, WOUTT, scr, 64 * kb, 32 * nbk, lane, [](int n) { return n; }); }
    }
    float* W8T = (float*)(p.ws + WS_W8T); bf16* WRTH = (bf16*)(p.ws + WS_WRTH); bf16* WRTL = (bf16*)(p.ws + WS_WRTL);
    for (int i = bid * NTHR + tid; i < 8 * 1024 + 80 * 1024; i += nb * NTHR) {
        if (i < 8192) { const int j = i >> 10, c = i & 1023; W8T[i] = p.in[6][(size_t)c * INC + 2048 + j]; }
        else { const int q = i - 8192, n = q >> 10, c = q & 1023;
            const float w = n < 8 ? p.in[19][(size_t)c * 8 + n] : (n < 16 ? 0.f : p.in[21][(size_t)c * NE + (n - 16)]);
            const unsigned hi = f2bf(w); WRTH[q] = (bf16)hi; WRTL[q] = (bf16)f2bf(w - bf2f(hi)); }
    }
}
template <class CM>
__device__ __forceinline__ void transpose_item4(const float* W, int ldw, int K, bf16* WT, int k0, int n0, int lane, const CM& cmap) {
    const int kb = lane >> 3, ng = lane & 7;
    f32x4 v[4][8];
#pragma unroll
    for (int t = 0; t < 4; ++t) { const float* src = W + cmap(n0 + 32 * t + 4 * ng) + (size_t)(k0 + 8 * kb) * ldw;
#pragma unroll
        for (int i = 0; i < 8; ++i) v[t][i] = *(const f32x4*)(src + (size_t)i * ldw); }
#pragma unroll
    for (int t = 0; t < 4; ++t)
#pragma unroll
        for (int q = 0; q < 4; ++q) {
            uint4 o; o.x = f2bf(v[t][0][q]) | (f2bf(v[t][1][q]) << 16); o.y = f2bf(v[t][2][q]) | (f2bf(v[t][3][q]) << 16); o.z = f2bf(v[t][4][q]) | (f2bf(v[t][5][q]) << 16); o.w = f2bf(v[t][6][q]) | (f2bf(v[t][7][q]) << 16);
            *(uint4*)(WT + (size_t)(n0 + 32 * t + 4 * ng + q) * K + k0 + 8 * kb) = o;
        }
}
__device__ void ph_wprep_experts(int wv, const Params& p, int bid, int nb, int lo, int hi) {
    const int tid = opaque_tid(), lane = tid & 63, wave = tid >> 6;
    bf16* WGUT = (bf16*)(p.ws + WS_WGUT); bf16* WDNT = (bf16*)(p.ws + WS_WDNT);
    constexpr int I_GU = (D_ / 64) * (2 * DE / 128), I_DN = (DE / 64) * (D_ / 128);
    for (int it = lo + bid * 8 + wave; it < hi; it += nb * 8) {
        int r = it; const int e = r / (I_GU + I_DN); r -= e * (I_GU + I_DN);
        if (r < I_GU) { const int kb = r / (2 * DE / 128), nbk = r % (2 * DE / 128);
            const float* wg = p.in[23] + (size_t)e * D_ * DE; const long up_off = (long)(p.in[24] - p.in[23]);
            transpose_item4(wg, DE, D_, WGUT + (size_t)e * 2 * DE * D_, 64 * kb, 128 * nbk, lane, [up_off](int n) -> long { const int g = n >> 5, w = n & 31; return w < 16 ? (long)(16 * g + w) : up_off + (long)(16 * g + w - 16); }); }
        else { r -= I_GU; const int kb = r / (D_ / 128), nbk = r % (D_ / 128);
            transpose_item4(p.in[25] + (size_t)e * DE * D_, D_, DE, WDNT + (size_t)e * D_ * DE, 64 * kb, 128 * nbk, lane, [](int n) { return n; }); }
    }
}

__device__ void ph_mod(int wv, const Params& p, LAS float* lds, int bid, int nb) {
    const int tid = opaque_tid();
    const float* c = p.in[1]; const float* w_ada = p.in[2]; const float* b_ada = p.in[3];
    float* mod = (float*)(p.ws + WS_MOD);
    LAS float* cact = lds;
    LAS float* part = lds + 8192;
    for (int i = tid; i < 8192; i += NTHR) cact[i] = siluf_(c[i]);
    __syncthreads();
    for (int cg = bid; cg < 256; cg += nb) {
        const int n0 = cg * 24;
        const int kq = tid / 6, cq = tid % 6;
        float acc[8][4];
#pragma unroll
        for (int b = 0; b < 8; ++b) { acc[b][0] = acc[b][1] = acc[b][2] = acc[b][3] = 0.f; }
        if (kq < 85) {
            f32x4 wv4[13];
#pragma unroll
            for (int i = 0; i < 13; ++i) { const int k = kq + 85 * i; wv4[i] = *(const f32x4*)(w_ada + (size_t)(k < 1024 ? k : 0) * 6144 + n0 + 4 * cq); }
#pragma unroll
            for (int i = 0; i < 13; ++i) { const int k = kq + 85 * i; const bool ok = k < 1024; const int kk = ok ? k : 0;
#pragma unroll
                for (int b = 0; b < 8; ++b) { const float a = ok ? cact[b * 1024 + kk] : 0.f; acc[b][0] += a * wv4[i][0]; acc[b][1] += a * wv4[i][1]; acc[b][2] += a * wv4[i][2]; acc[b][3] += a * wv4[i][3]; } }
#pragma unroll
            for (int b = 0; b < 8; ++b)
#pragma unroll
                for (int j = 0; j < 4; ++j) part[(kq * 8 + b) * 24 + 4 * cq + j] = acc[b][j];
        }
        __syncthreads();
        if (tid < 192) {
            const int b = tid / 24, j = tid % 24; float s = 0.f;
            for (int q = 0; q < 85; ++q) s += part[(q * 8 + b) * 24 + j];
            mod[b * 6144 + n0 + j] = s + b_ada[n0 + j];
        }
        __syncthreads();
    }
}

__device__ void ph_h(int wv, const Params& p, LAS float* lds, int row0) {
    const int tid = opaque_tid(), lane = tid & 63, wave = tid >> 6;
    const float* x = p.in[0]; const float* npm = p.in[4];
    const float* mod = (const float*)(p.ws + WS_MOD); const float* W8T = (const float*)(p.ws + WS_W8T);
    bf16* H = (bf16*)(p.ws + WS_H); float* SM = (float*)(p.ws + WS_SMALL);
    for (int i = tid; i < 2048; i += NTHR) *(LAS f32x4*)(lds + 4 * i) = *(const f32x4*)(W8T + 4 * i);
    __syncthreads();
#pragma unroll 1
    for (int t = row0 + wave * 8; t < row0 + wave * 8 + 8; ++t) {
        const int b = t / NS_;
        const float* xr = x + (size_t)t * D_;
        f32x4 v[4]; float ss = 0.f;
#pragma unroll
        for (int j = 0; j < 4; ++j) { v[j] = *(const f32x4*)(xr + 4 * lane + 256 * j); ss += v[j][0] * v[j][0] + v[j][1] * v[j][1] + v[j][2] * v[j][2] + v[j][3] * v[j][3]; }
        ss = wave_sum(ss);
        const float rstd = rsqrtf(ss * (1.f / D_) + EPS);
        float sm[8];
#pragma unroll
        for (int j = 0; j < 8; ++j) sm[j] = 0.f;
#pragma unroll
        for (int j = 0; j < 4; ++j) {
            const int c0 = 4 * lane + 256 * j;
            const f32x4 nw = *(const f32x4*)(npm + c0);
            const f32x4 sh = *(const f32x4*)(mod + b * 6144 + c0);
            const f32x4 sc = *(const f32x4*)(mod + b * 6144 + 1024 + c0);
            const f32x4 h = v[j] * rstd * nw * (sc + 1.f) + sh;
            uint2 o; o.x = f2bf(h[0]) | (f2bf(h[1]) << 16); o.y = f2bf(h[2]) | (f2bf(h[3]) << 16);
            *(uint2*)(H + (size_t)t * D_ + c0) = o;
#pragma unroll
            for (int q = 0; q < 8; ++q) { const f32x4 w = *(const LAS f32x4*)(lds + q * 1024 + c0); sm[q] += h[0] * w[0] + h[1] * w[1] + h[2] * w[2] + h[3] * w[3]; }
        }
#pragma unroll
        for (int j = 0; j < 8; ++j) sm[j] = wave_sum(sm[j]);
        if (lane == 0) { *(float4*)(SM + (size_t)t * 8) = make_float4(sm[0], sm[1], sm[2], sm[3]); *(float4*)(SM + (size_t)t * 8 + 4) = make_float4(sm[4], sm[5], sm[6], sm[7]); }
    }
}

__device__ __forceinline__ void ph_proj(int wv, const Params& p, LAS unsigned char* lds, int bid, int nb) {
    pg8::DenseSched S; S.init(p.ws + WS_H, p.ws + WS_WINT, T_, PJ, D_, nb, bid);
    pg8::EpiBf16 E{(bf16*)(p.ws + WS_PROJ), PJ};
    pg8::gemm_phase(wv, lds, S, E);
}

typedef short bf16x8_t __attribute__((ext_vector_type(8)));
typedef unsigned u32x4_t __attribute__((ext_vector_type(4)));
typedef unsigned u32x2_t __attribute__((ext_vector_type(2)));
__device__ __forceinline__ int lds_off16(int row, int ch) { return row * 256 + ((ch ^ (row & 15)) << 4); }
__device__ __forceinline__ int lds_off8(int row, int ch) { return row * 128 + ((ch ^ ((row >> 1) & 7)) << 4); }
__device__ __forceinline__ unsigned pk2bf(float lo, float hi) { return f2bf(lo) | (f2bf(hi) << 16); }
__device__ __forceinline__ bf16x8_t ldfrag(const LAS unsigned char* p) { return *(const LAS bf16x8_t*)p; }

__device__ void ph_dnprep(int wv, const Params& p, LAS unsigned char* lds, int bid, int nb) {
    const int tid = opaque_tid(), lane = tid & 63, wave = tid >> 6, fr = lane & 15, fq = lane >> 4;
    const bf16* PROJ = (const bf16*)(p.ws + WS_PROJ); const float* cw = p.in[7]; const float* a_log = p.in[8]; const float* dt_bias = p.in[9];
    const float* SM = (const float*)(p.ws + WS_SMALL);
    bf16* DW = (bf16*)(p.ws + WS_DW); bf16* DQG = (bf16*)(p.ws + WS_DQG); bf16* DKDT = (bf16*)(p.ws + WS_DKDT); bf16* DATT = (bf16*)(p.ws + WS_DATT);
    float* DU = (float*)(p.ws + WS_DU); float* DEGL = (float*)(p.ws + WS_DEGL);
    constexpr int O_KN = 0, O_QS = 16384, O_KD = 32768, O_AM = 50176, O_RHS = 66560, O_GC = 132096;
    LAS float* AM = (LAS float*)(lds + O_AM); LAS float* RHS = (LAS float*)(lds + O_RHS); LAS float* GC = (LAS float*)(lds + O_GC);
    LAS unsigned short* KD = (LAS unsigned short*)(lds + O_KD);
    const float qscale = 0.08838834764831845f;
    for (int item = bid; item < 1024; item += nb) {
        const int b = item >> 7, h = (item >> 5) & 3, n = item & 31, t0 = b * NS_ + n * 64, tl0 = n * 64;
        if (wave == 0) {
            const int t = t0 + lane;
            const float bl = SM[(size_t)t * 8 + h], al = SM[(size_t)t * 8 + 4 + h];
            const float beta = sigmoidf_(bl);
            const float xx = al + dt_bias[h];
            const float sp = xx > 20.f ? xx : log1pf(expf(xx));
            float gc = -expf(a_log[h]) * sp;
#pragma unroll
            for (int o = 1; o < 64; o <<= 1) { const float y = __shfl_up(gc, o); if (lane >= o) gc += y; }
            const float glast = __shfl(gc, 63);
            GC[lane] = gc; GC[64 + lane] = beta; GC[128 + lane] = expf(gc); GC[192 + lane] = expf(glast - gc);
            if (lane == 63) DEGL[item] = expf(gc);
        }
        __syncthreads();
        {
            const int r = tid >> 3, seg = tid & 7;
            const float beta = GC[64 + r], egc = GC[128 + r], edec = GC[192 + r];
            float v3[3][16];
#pragma unroll
            for (int part = 0; part < 3; ++part) {
                const int ch = part * 512 + h * 128 + seg * 16;
#pragma unroll
                for (int i = 0; i < 16; ++i) v3[part][i] = 0.f;
#pragma unroll
                for (int j = 0; j < 4; ++j) {
                    const bool ok = tl0 + r - 3 + j >= 0;
                    const size_t srow = (size_t)(ok ? t0 + r - 3 + j : t0);
                    const u32x4_t x0 = *(const u32x4_t*)(PROJ + srow * PJ + ch), x1 = *(const u32x4_t*)(PROJ + srow * PJ + ch + 8);
                    const unsigned xs[8] = {x0.x, x0.y, x0.z, x0.w, x1.x, x1.y, x1.z, x1.w};
#pragma unroll
                    for (int i = 0; i < 8; ++i) { float2 w = *(const float2*)(cw + j * 1536 + ch + 2 * i); if (!ok) { w.x = 0.f; w.y = 0.f; } v3[part][2 * i] += w.x * bf2f(xs[i] & 0xffffu); v3[part][2 * i + 1] += w.y * bf2f(xs[i] >> 16); }
                }
                asm volatile("" ::: "memory");
                float ss = 0.f;
#pragma unroll
                for (int i = 0; i < 16; ++i) { v3[part][i] = siluf_(v3[part][i]); ss += v3[part][i] * v3[part][i]; }
                if (part < 2) {
                    ss += __shfl_xor(ss, 1); ss += __shfl_xor(ss, 2); ss += __shfl_xor(ss, 4);
                    const float rn = rsqrtf(ss + EPS);
#pragma unroll
                    for (int i = 0; i < 16; ++i) v3[part][i] *= rn;
                }
            }
            {
                u32x4_t a0, a1, g0, g1; const float* q = v3[0]; const float s = qscale, sg = qscale * egc;
                a0.x = pk2bf(q[0] * s, q[1] * s); a0.y = pk2bf(q[2] * s, q[3] * s); a0.z = pk2bf(q[4] * s, q[5] * s); a0.w = pk2bf(q[6] * s, q[7] * s);
                a1.x = pk2bf(q[8] * s, q[9] * s); a1.y = pk2bf(q[10] * s, q[11] * s); a1.z = pk2bf(q[12] * s, q[13] * s); a1.w = pk2bf(q[14] * s, q[15] * s);
                g0.x = pk2bf(q[0] * sg, q[1] * sg); g0.y = pk2bf(q[2] * sg, q[3] * sg); g0.z = pk2bf(q[4] * sg, q[5] * sg); g0.w = pk2bf(q[6] * sg, q[7] * sg);
                g1.x = pk2bf(q[8] * sg, q[9] * sg); g1.y = pk2bf(q[10] * sg, q[11] * sg); g1.z = pk2bf(q[12] * sg, q[13] * sg); g1.w = pk2bf(q[14] * sg, q[15] * sg);
                *(LAS u32x4_t*)(lds + O_QS + lds_off16(r, 2 * seg)) = a0; *(LAS u32x4_t*)(lds + O_QS + lds_off16(r, 2 * seg + 1)) = a1;
                bf16* dst = DQG + (size_t)item * 8192 + r * 128 + seg * 16; *(u32x4_t*)dst = g0; *(u32x4_t*)(dst + 8) = g1;
            }
            {
                u32x4_t a0, a1; const float* k = v3[1];
                a0.x = pk2bf(k[0], k[1]); a0.y = pk2bf(k[2], k[3]); a0.z = pk2bf(k[4], k[5]); a0.w = pk2bf(k[6], k[7]);
                a1.x = pk2bf(k[8], k[9]); a1.y = pk2bf(k[10], k[11]); a1.z = pk2bf(k[12], k[13]); a1.w = pk2bf(k[14], k[15]);
                *(LAS u32x4_t*)(lds + O_KN + lds_off16(r, 2 * seg)) = a0; *(LAS u32x4_t*)(lds + O_KN + lds_off16(r, 2 * seg + 1)) = a1;
                u32x4_t d0, d1;
                d0.x = pk2bf(k[0] * edec, k[1] * edec); d0.y = pk2bf(k[2] * edec, k[3] * edec); d0.z = pk2bf(k[4] * edec, k[5] * edec); d0.w = pk2bf(k[6] * edec, k[7] * edec);
                d1.x = pk2bf(k[8] * edec, k[9] * edec); d1.y = pk2bf(k[10] * edec, k[11] * edec); d1.z = pk2bf(k[12] * edec, k[13] * edec); d1.w = pk2bf(k[14] * edec, k[15] * edec);
                *(LAS u32x4_t*)(KD + r * 136 + seg * 16) = d0; *(LAS u32x4_t*)(KD + r * 136 + seg * 16 + 8) = d1;
                const float bw = beta * egc;
#pragma unroll
                for (int i = 0; i < 4; ++i) *(LAS f32x4*)(RHS + r * 256 + 128 + seg * 16 + 4 * i) = (f32x4){k[4 * i] * bw, k[4 * i + 1] * bw, k[4 * i + 2] * bw, k[4 * i + 3] * bw};
            }
            {
                const float* v = v3[2];
#pragma unroll
                for (int i = 0; i < 4; ++i) *(LAS f32x4*)(RHS + r * 256 + seg * 16 + 4 * i) = (f32x4){v[4 * i] * beta, v[4 * i + 1] * beta, v[4 * i + 2] * beta, v[4 * i + 3] * beta};
            }
        }
        __syncthreads();
        {
            const int rb = wave & 3;
            bf16x8_t xf[4];
#pragma unroll
            for (int s4 = 0; s4 < 4; ++s4) xf[s4] = ldfrag(lds + O_KN + lds_off16(16 * rb + fr, 4 * s4 + fq));
#pragma unroll
            for (int cb = 0; cb < 4; ++cb) {
                f32x4 acc = {0.f, 0.f, 0.f, 0.f};
                const int yoff = (wave < 4) ? O_KN : O_QS;
#pragma unroll
                for (int s4 = 0; s4 < 4; ++s4) { const bf16x8_t yf = ldfrag(lds + yoff + lds_off16(16 * cb + fr, 4 * s4 + fq)); acc = __builtin_amdgcn_mfma_f32_16x16x32_bf16(xf[s4], yf, acc, 0, 0, 0); }
                const int xr0 = 16 * rb + 4 * fq, yr = 16 * cb + fr;
                const f32x4 gx = *(const LAS f32x4*)(GC + xr0); const float gy = GC[yr];
                if (wave < 4) {
                    const f32x4 bx = *(const LAS f32x4*)(GC + 64 + xr0);
                    f32x4 o;
#pragma unroll
                    for (int r = 0; r < 4; ++r) { const bool m = xr0 + r > yr; const float dec = __expf(m ? gx[r] - gy : 0.f); o[r] = m ? bx[r] * acc[r] * dec : 0.f; }
                    *(LAS f32x4*)(AM + ((xr0 >> 2) * 64 + yr) * 4) = o;
                } else {
                    float o[4];
#pragma unroll
                    for (int r = 0; r < 4; ++r) { const bool m = yr >= xr0 + r; const float dec = __expf(m ? gy - gx[r] : 0.f); o[r] = m ? acc[r] * dec : 0.f; }
                    u32x2_t w; w.x = pk2bf(o[0], o[1]); w.y = pk2bf(o[2], o[3]);
                    *(u32x2_t*)(DATT + (size_t)item * 4096 + yr * 64 + xr0) = w;
                }
            }
        }
        __syncthreads();
        if (tid < 256) {
            const int c = tid;
            float x[64];
#pragma unroll
            for (int blk = 0; blk < 16; ++blk) {
                float s0 = RHS[(4 * blk + 0) * 256 + c], s1 = RHS[(4 * blk + 1) * 256 + c], s2 = RHS[(4 * blk + 2) * 256 + c], s3 = RHS[(4 * blk + 3) * 256 + c];
#pragma unroll
                for (int j0 = 0; j0 < 4 * blk; j0 += 16) {
                    f32x4 a[16];
#pragma unroll
                    for (int q = 0; q < 16; ++q) if (j0 + q < 4 * blk) a[q] = *(const LAS f32x4*)(AM + (blk * 64 + j0 + q) * 4);
#pragma unroll
                    for (int q = 0; q < 16; ++q) if (j0 + q < 4 * blk) { const float xv = x[j0 + q]; s0 -= a[q][0] * xv; s1 -= a[q][1] * xv; s2 -= a[q][2] * xv; s3 -= a[q][3] * xv; }
                }
                const f32x4 t0 = *(const LAS f32x4*)(AM + (blk * 64 + 4 * blk) * 4), t1 = *(const LAS f32x4*)(AM + (blk * 64 + 4 * blk + 1) * 4), t2 = *(const LAS f32x4*)(AM + (blk * 64 + 4 * blk + 2) * 4);
                x[4 * blk] = s0;
                s1 -= t0[1] * s0; s2 -= t0[2] * s0; s3 -= t0[3] * s0;
                x[4 * blk + 1] = s1;
                s2 -= t1[2] * s1; s3 -= t1[3] * s1;
                x[4 * blk + 2] = s2;
                s3 -= t2[3] * s2;
                x[4 * blk + 3] = s3;
            }
            if (c < 128) {
#pragma unroll
                for (int i = 0; i < 64; ++i) DU[(size_t)item * 8192 + i * 128 + c] = x[i];
            } else {
#pragma unroll
                for (int i = 0; i < 64; ++i) DW[(size_t)item * 8192 + i * 128 + (c - 128)] = (bf16)f2bf(x[i]);
            }
        } else {
            const int tt = tid - 256, d = tt >> 1, c0 = (tt & 1) * 32;
            unsigned w[16];
#pragma unroll
            for (int i = 0; i < 16; ++i) w[i] = (unsigned)KD[(c0 + 2 * i) * 136 + d] | ((unsigned)KD[(c0 + 2 * i + 1) * 136 + d] << 16);
            bf16* dst = DKDT + (size_t)item * 8192 + d * 64 + c0;
#pragma unroll
            for (int i = 0; i < 4; ++i) *(u32x4_t*)(dst + 8 * i) = (u32x4_t){w[4 * i], w[4 * i + 1], w[4 * i + 2], w[4 * i + 3]};
        }
        __syncthreads();
    }
}

__device__ void ph_dnscan(int wv, const Params& p, LAS unsigned char* lds, int sbid, int nsb) {
    const int tid = opaque_tid(), lane = tid & 63, wave = wv, fr = lane & 15, fq = lane >> 4;
    const bf16* DW = (const bf16*)(p.ws + WS_DW); const bf16* DQG = (const bf16*)(p.ws + WS_DQG); const bf16* DKDT = (const bf16*)(p.ws + WS_DKDT); const bf16* DATT = (const bf16*)(p.ws + WS_DATT);
    const float* DU = (const float*)(p.ws + WS_DU); const float* DEGL = (const float*)(p.ws + WS_DEGL);
    float* ORAW = (float*)(p.ws + WS_ORAW);
    constexpr int BUF = 57344, O_W = 0, O_QG = 16384, O_KDT = 32768, O_ATT = 49152, O_SB = 114688, O_VNT = 131072;
    const int cb = wave >> 1, eb = wave & 1;
    for (int it = sbid; it < 128; it += nsb) {
        const int bh = (it & 7) * 4 + (it >> 5), es = (it >> 3) & 3, b = bh >> 2, h = bh & 3, e0 = es * 32, item0 = bh * 32;
        f32x4 st[2] = {{0.f, 0.f, 0.f, 0.f}, {0.f, 0.f, 0.f, 0.f}};
        *(LAS u32x4_t*)(lds + O_SB + tid * 16) = (u32x4_t){0u, 0u, 0u, 0u};
        u32x4_t rg[7]; float un[4]; float egl_n;
#define DN_LOAD(itm) do { const size_t _o = (size_t)(itm) * 8192; \
            rg[0] = *(const u32x4_t*)(DW + _o + (size_t)tid * 8); rg[1] = *(const u32x4_t*)(DW + _o + (size_t)(tid + 512) * 8); \
            rg[2] = *(const u32x4_t*)(DQG + _o + (size_t)tid * 8); rg[3] = *(const u32x4_t*)(DQG + _o + (size_t)(tid + 512) * 8); \
            rg[4] = *(const u32x4_t*)(DKDT + _o + (size_t)tid * 8); rg[5] = *(const u32x4_t*)(DKDT + _o + (size_t)(tid + 512) * 8); \
            rg[6] = *(const u32x4_t*)(DATT + (size_t)(itm) * 4096 + (size_t)tid * 8); \
            _Pragma("unroll") for (int _r = 0; _r < 4; ++_r) un[_r] = DU[_o + (size_t)(16 * cb + 4 * fq + _r) * 128 + e0 + 16 * eb + fr]; \
            egl_n = DEGL[(itm)]; } while (0)
#define DN_STORE(bufo) do { LAS unsigned char* _b = lds + (bufo); \
            *(LAS u32x4_t*)(_b + O_W + lds_off16(tid >> 4, tid & 15)) = rg[0]; *(LAS u32x4_t*)(_b + O_W + lds_off16((tid + 512) >> 4, tid & 15)) = rg[1]; \
            *(LAS u32x4_t*)(_b + O_QG + lds_off16(tid >> 4, tid & 15)) = rg[2]; *(LAS u32x4_t*)(_b + O_QG + lds_off16((tid + 512) >> 4, tid & 15)) = rg[3]; \
            *(LAS u32x4_t*)(_b + O_KDT + lds_off8(tid >> 3, tid & 7)) = rg[4]; *(LAS u32x4_t*)(_b + O_KDT + lds_off8((tid + 512) >> 3, tid & 7)) = rg[5]; \
            *(LAS u32x4_t*)(_b + O_ATT + lds_off8(tid >> 3, tid & 7)) = rg[6]; } while (0)
        DN_LOAD(item0);
        DN_STORE(0);
        float u[4] = {un[0], un[1], un[2], un[3]}; float egl = egl_n;
        __syncthreads();
        for (int n = 0; n < 32; ++n) {
            const int bufo = (n & 1) * BUF, sbo = O_SB + (n & 1) * 8192, sbn = O_SB + ((n + 1) & 1) * 8192;
            if (n < 31) DN_LOAD(item0 + n + 1);
            f32x4 acc = {0.f, 0.f, 0.f, 0.f};
            bf16x8_t sf[4];
#pragma unroll
            for (int s4 = 0; s4 < 4; ++s4) sf[s4] = ldfrag(lds + sbo + lds_off16(16 * eb + fr, 4 * s4 + fq));
#pragma unroll
            for (int s4 = 0; s4 < 4; ++s4) acc = __builtin_amdgcn_mfma_f32_16x16x32_bf16(ldfrag(lds + bufo + O_W + lds_off16(16 * cb + fr, 4 * s4 + fq)), sf[s4], acc, 0, 0, 0);
            {
                const float v0 = u[0] - acc[0], v1 = u[1] - acc[1], v2 = u[2] - acc[2], v3 = u[3] - acc[3];
                u32x2_t w; w.x = pk2bf(v0, v1); w.y = pk2bf(v2, v3);
                *(LAS u32x2_t*)(lds + O_VNT + lds_off8(16 * eb + fr, 2 * cb + (fq >> 1)) + 8 * (fq & 1)) = w;
            }
            __syncthreads();
            f32x4 oacc = {0.f, 0.f, 0.f, 0.f};
#pragma unroll
            for (int s4 = 0; s4 < 4; ++s4) oacc = __builtin_amdgcn_mfma_f32_16x16x32_bf16(ldfrag(lds + bufo + O_QG + lds_off16(16 * cb + fr, 4 * s4 + fq)), sf[s4], oacc, 0, 0, 0);
            bf16x8_t vf[2][2];
#pragma unroll
            for (int e2 = 0; e2 < 2; ++e2)
#pragma unroll
                for (int s2 = 0; s2 < 2; ++s2) vf[e2][s2] = ldfrag(lds + O_VNT + lds_off8(16 * e2 + fr, 4 * s2 + fq));
#pragma unroll
            for (int s2 = 0; s2 < 2; ++s2) oacc = __builtin_amdgcn_mfma_f32_16x16x32_bf16(ldfrag(lds + bufo + O_ATT + lds_off8(16 * cb + fr, 4 * s2 + fq)), ldfrag(lds + O_VNT + lds_off8(16 * eb + fr, 4 * s2 + fq)), oacc, 0, 0, 0);
            {
                const size_t t0 = (size_t)b * NS_ + n * 64;
#pragma unroll
                for (int r = 0; r < 4; ++r) ORAW[(t0 + 16 * cb + 4 * fq + r) * 512 + h * 128 + e0 + 16 * eb + fr] = oacc[r];
            }
#pragma unroll
            for (int e2 = 0; e2 < 2; ++e2) {
                st[e2] = st[e2] * egl;
#pragma unroll
                for (int s2 = 0; s2 < 2; ++s2) st[e2] = __builtin_amdgcn_mfma_f32_16x16x32_bf16(ldfrag(lds + bufo + O_KDT + lds_off8(16 * wave + fr, 4 * s2 + fq)), vf[e2][s2], st[e2], 0, 0, 0);
                u32x2_t w; w.x = pk2bf(st[e2][0], st[e2][1]); w.y = pk2bf(st[e2][2], st[e2][3]);
                *(LAS u32x2_t*)(lds + sbn + lds_off16(16 * e2 + fr, 2 * wave + (fq >> 1)) + 8 * (fq & 1)) = w;
            }
            if (n < 31) { DN_STORE(((n + 1) & 1) * BUF); u[0] = un[0]; u[1] = un[1]; u[2] = un[2]; u[3] = un[3]; egl = egl_n; }
            __syncthreads();
        }
#undef DN_LOAD
#undef DN_STORE
        {
            unsigned* flag = (unsigned*)(p.ws + WS_CTL) + CW_DNF + 64 * bh;
            asm volatile("s_waitcnt vmcnt(0)" ::: "memory");
            __syncthreads();
            if (tid == 0) {
                __builtin_amdgcn_fence(__ATOMIC_RELEASE, "agent");
                asm volatile("s_waitcnt vmcnt(0)" ::: "memory");
                __hip_atomic_fetch_add(flag, 1u, __ATOMIC_RELAXED, __HIP_MEMORY_SCOPE_AGENT);
                unsigned sp = 0;
                while (__hip_atomic_load(flag, __ATOMIC_RELAXED, __HIP_MEMORY_SCOPE_AGENT) < 4u) { __builtin_amdgcn_s_sleep(2); if (++sp > (1u << 22)) break; }
                __builtin_amdgcn_fence(__ATOMIC_ACQUIRE, "agent");
                asm volatile("s_waitcnt vmcnt(0)" ::: "memory");
            }
            __syncthreads();
            const bf16* PROJ = (const bf16*)(p.ws + WS_PROJ); bf16* MIXED = (bf16*)(p.ws + WS_MIXED);
            const int g4 = lane >> 4, c8 = (lane & 15) * 8;
            const f32x4 nw0 = *(const f32x4*)(p.in[10] + c8), nw1 = *(const f32x4*)(p.in[10] + c8 + 4);
            const int tq0 = b * NS_ + es * 512 + (tid >> 6) * 64;
#pragma unroll 1
            for (int i0 = 0; i0 < 64; i0 += 32) {
                f32x4 oa[8], ob[8]; u32x4_t zz[8];
#pragma unroll
                for (int q = 0; q < 8; ++q) { const size_t t = (size_t)(tq0 + i0 + 4 * q + g4);
                    oa[q] = *(const f32x4*)(ORAW + t * 512 + h * 128 + c8); ob[q] = *(const f32x4*)(ORAW + t * 512 + h * 128 + c8 + 4);
                    zz[q] = *(const u32x4_t*)(PROJ + t * PJ + 1536 + h * 128 + c8); }
                asm volatile("" : "+v"(oa[0]), "+v"(oa[1]), "+v"(oa[2]), "+v"(oa[3]), "+v"(oa[4]), "+v"(oa[5]), "+v"(oa[6]), "+v"(oa[7]));
                asm volatile("" : "+v"(ob[0]), "+v"(ob[1]), "+v"(ob[2]), "+v"(ob[3]), "+v"(ob[4]), "+v"(ob[5]), "+v"(ob[6]), "+v"(ob[7]));
                asm volatile("" : "+v"(zz[0]), "+v"(zz[1]), "+v"(zz[2]), "+v"(zz[3]), "+v"(zz[4]), "+v"(zz[5]), "+v"(zz[6]), "+v"(zz[7]));
#pragma unroll
                for (int q = 0; q < 8; ++q) {
                    const f32x4 a = oa[q], c = ob[q];
                    float ss = (a[0] * a[0] + a[1] * a[1]) + (a[2] * a[2] + a[3] * a[3]) + (c[0] * c[0] + c[1] * c[1]) + (c[2] * c[2] + c[3] * c[3]);
                    ss += dpp_f<0xB1, 0xF>(ss); ss += dpp_f<0x4E, 0xF>(ss); ss += dpp_f<0x141, 0xF>(ss); ss += dpp_f<0x140, 0xF>(ss);
                    const float r = rsqrtf(ss * (1.f / 128.f) + EPS);
                    const unsigned zw[4] = {zz[q].x, zz[q].y, zz[q].z, zz[q].w};
                    float m[8];
#pragma unroll
                    for (int i = 0; i < 4; ++i) { m[i] = a[i] * r * nw0[i] * siluf_(bf2f(i & 1 ? zw[i >> 1] >> 16 : zw[i >> 1] & 0xffffu)); m[4 + i] = c[i] * r * nw1[i] * siluf_(bf2f(i & 1 ? zw[2 + (i >> 1)] >> 16 : zw[2 + (i >> 1)] & 0xffffu)); }
                    u32x4_t w; w.x = pk2bf(m[0], m[1]); w.y = pk2bf(m[2], m[3]); w.z = pk2bf(m[4], m[5]); w.w = pk2bf(m[6], m[7]);
                    *(u32x4_t*)(MIXED + (size_t)(tq0 + i0 + 4 * q + g4) * D_ + h * 128 + c8) = w;
                }
            }
        }
    }
}

__device__ void ph_cf(int wv, const Params& p, LAS float* lds, int bid, int nb) {
    const int tid = opaque_tid(), lane = tid & 63, wave = tid >> 6;
    const bf16* PROJ = (const bf16*)(p.ws + WS_PROJ);
    const float* pwb = p.in[11]; const float* dww = p.in[12]; const float* dwb = p.in[13]; const float* lnw = p.in[14]; const float* lnb = p.in[15];
    bf16* MIXED = (bf16*)(p.ws + WS_MIXED);
    constexpr int TT = 32;
    const int c = tid;
    float w[CFK];
#pragma unroll
    for (int j = 0; j < CFK; ++j) w[j] = dww[j * CFW + c];
    const float ba = pwb[c], bg = pwb[512 + c], cb = dwb[c];
    for (int it = bid; it < T_ / TT; it += nb) {
        const int t0 = it * TT, tl0 = t0 % NS_;
        float xg[TT + CFK - 1];
#pragma unroll
        for (int i0 = 0; i0 < TT + CFK - 1; i0 += 16) {
            unsigned ra[16], rg[16];
#pragma unroll
            for (int q = 0; q < 16; ++q) if (i0 + q < TT + CFK - 1) {
                const int tl = tl0 - (CFK - 1) + i0 + q;
                const size_t row = (size_t)(t0 - (CFK - 1) + i0 + q + (tl < 0 ? -tl : 0));
                ra[q] = PROJ[row * PJ + 2048 + c]; rg[q] = PROJ[row * PJ + 2560 + c];
            } else { ra[q] = 0; rg[q] = 0; }
            asm volatile("" : "+v"(ra[0]), "+v"(ra[1]), "+v"(ra[2]), "+v"(ra[3]), "+v"(ra[4]), "+v"(ra[5]), "+v"(ra[6]), "+v"(ra[7]), "+v"(ra[8]), "+v"(ra[9]), "+v"(ra[10]), "+v"(ra[11]), "+v"(ra[12]), "+v"(ra[13]), "+v"(ra[14]), "+v"(ra[15]));
            asm volatile("" : "+v"(rg[0]), "+v"(rg[1]), "+v"(rg[2]), "+v"(rg[3]), "+v"(rg[4]), "+v"(rg[5]), "+v"(rg[6]), "+v"(rg[7]), "+v"(rg[8]), "+v"(rg[9]), "+v"(rg[10]), "+v"(rg[11]), "+v"(rg[12]), "+v"(rg[13]), "+v"(rg[14]), "+v"(rg[15]));
#pragma unroll
            for (int q = 0; q < 16; ++q) if (i0 + q < TT + CFK - 1) {
                const int tl = tl0 - (CFK - 1) + i0 + q;
                const float a = bf2f(ra[q]) + ba, gt = bf2f(rg[q]) + bg;
                xg[i0 + q] = tl >= 0 ? a * sigmoidf_(gt) : 0.f;
            }
        }
        __syncthreads();
#pragma unroll
        for (int r = 0; r < TT; ++r) {
            float s = cb;
#pragma unroll
            for (int j = 0; j < CFK; ++j) s += w[j] * xg[r + j];
            lds[r * 512 + c] = s;
        }
        __syncthreads();
#pragma unroll
        for (int rr = 0; rr < 4; ++rr) {
            const int r = wave * 4 + rr;
            float v[8]; float s = 0.f;
#pragma unroll
            for (int j = 0; j < 8; ++j) { v[j] = lds[r * 512 + lane + 64 * j]; s += v[j]; }
            const float mu = wave_sum(s) * (1.f / 512.f);
            float q = 0.f;
#pragma unroll
            for (int j = 0; j < 8; ++j) { v[j] -= mu; q += v[j] * v[j]; }
            const float rstd = rsqrtf(wave_sum(q) * (1.f / 512.f) + EPS);
#pragma unroll
            for (int j = 0; j < 8; ++j) { const int cc = lane + 64 * j; const float y = v[j] * rstd * lnw[cc] + lnb[cc]; MIXED[(size_t)(t0 + r) * D_ + 512 + cc] = (bf16)f2bf(siluf_(y)); }
        }
    }
}

__device__ __forceinline__ void ph_outproj(int wv, const Params& p, LAS unsigned char* lds, int bid, int nb) {
    pg8::DenseSched S; S.init(p.ws + WS_MIXED, p.ws + WS_WOUTT, T_, D_, D_, nb, bid);
    pg8::EpiBf16 E{(bf16*)(p.ws + WS_HMIX), D_};
    pg8::gemm_phase(wv, lds, S, E);
}

struct Row2Par { f32x4 g1n[4], a2[4], b2[4]; };
__device__ __forceinline__ void row2_front(const Params& p, LAS unsigned char* lds, int t, int lr, int lane, const f32x4 (&hm)[4], const f32x4 (&xv)[4], const Row2Par& P) {
    bf16* H2 = (bf16*)(p.ws + WS_H);
    float ss = 0.f;
#pragma unroll
    for (int j = 0; j < 4; ++j) ss += hm[j][0] * hm[j][0] + hm[j][1] * hm[j][1] + hm[j][2] * hm[j][2] + hm[j][3] * hm[j][3];
    ss = wave_sum(ss);
    const float r1 = rsqrtf(ss * (1.f / D_) + EPS);
    f32x4 x1[4]; float s2 = 0.f;
#pragma unroll
    for (int j = 0; j < 4; ++j) {
        const int c0 = 4 * lane + 256 * j;
        x1[j] = xv[j] + P.g1n[j] * (hm[j] * r1);
        s2 += x1[j][0] * x1[j][0] + x1[j][1] * x1[j][1] + x1[j][2] * x1[j][2] + x1[j][3] * x1[j][3];
        *(f32x4*)(p.out + (size_t)t * D_ + c0) = x1[j];
    }
    s2 = wave_sum(s2);
    const float r2 = rsqrtf(s2 * (1.f / D_) + EPS);
#pragma unroll
    for (int j = 0; j < 4; ++j) {
        const int c0 = 4 * lane + 256 * j;
        const f32x4 h = x1[j] * r2 * P.a2[j] + P.b2[j];
        unsigned hi[4]; float lo[4];
#pragma unroll
        for (int i = 0; i < 4; ++i) { hi[i] = f2bf(h[i]); lo[i] = h[i] - bf2f(hi[i]); }
        u32x2_t wh; wh.x = hi[0] | (hi[1] << 16); wh.y = hi[2] | (hi[3] << 16);
        u32x2_t wl; wl.x = pk2bf(lo[0], lo[1]); wl.y = pk2bf(lo[2], lo[3]);
        *(u32x2_t*)(H2 + (size_t)t * D_ + c0) = wh;
        const int ch = c0 >> 3, off = lr * 2048 + ((ch ^ (lr & 15)) << 4) + (c0 & 7) * 2;
        *(LAS u32x2_t*)(lds + off) = wh; *(LAS u32x2_t*)(lds + 65536 + off) = wl;
    }
}
__device__ void ph_row2(int wv, const Params& p, LAS unsigned char* lds, int chunk0) {
    const int tid = opaque_tid(), lane = tid & 63, wave = __builtin_amdgcn_readfirstlane(tid >> 6), fr = lane & 15, fq = lane >> 4;
    const float* x = p.in[0]; const float* brg = p.in[20]; const float* bre = p.in[22];
    const bf16* HMIX = (const bf16*)(p.ws + WS_HMIX);
    const bf16* WRTH = (const bf16*)(p.ws + WS_WRTH); const bf16* WRTL = (const bf16*)(p.ws + WS_WRTL);
    int* ROUTE = (int*)(p.ws + WS_ROUTE); int* POS = (int*)(p.ws + WS_POS); int* TOKL = (int*)(p.ws + WS_TOKL); float* WL = (float*)(p.ws + WS_WL);
    unsigned* cnt = (unsigned*)(p.ws + WS_CTL) + CW_CNT;
    LAS float* PART = (LAS float*)lds;
    LAS float* LOG = (LAS float*)(lds + 131072);
    LAS int* rte = (LAS int*)(lds + 131072 + 10240); LAS int* rtr = rte + 128; LAS float* rtw = (LAS float*)(rtr + 128); LAS int* lcnt = (LAS int*)(rtw + 128); LAS int* lbase = lcnt + 64;
    if (tid < 64) lcnt[tid] = 0;
    __syncthreads();
    for (int chunk = chunk0; chunk < chunk0 + 1; ++chunk) {
#pragma unroll 1
        for (int pass = 0; pass < 2; ++pass) {
            Row2Par P;
            { int lo_ = lane; asm volatile("" : "+v"(lo_));
              const float* mod = (const float*)(p.ws + WS_MOD) + ((chunk * 64) / NS_) * 6144;
#pragma unroll
              for (int j = 0; j < 4; ++j) { const int c0 = 4 * lo_ + 256 * j;
                  P.g1n[j] = *(const f32x4*)(mod + 2048 + c0) * *(const f32x4*)(p.in[5] + c0);
                  P.a2[j] = *(const f32x4*)(p.in[17] + c0) * (*(const f32x4*)(mod + 4096 + c0) + 1.f);
                  P.b2[j] = *(const f32x4*)(mod + 3072 + c0); } }
            const int tb = chunk * 64 + pass * 32 + wave * 4;
            f32x4 hmA[4], xvA[4], hmB[4], xvB[4];
#define R2_LOAD(hm, xv, t) do { _Pragma("unroll") for (int j = 0; j < 4; ++j) { const u32x2_t _h = *(const u32x2_t*)(HMIX + (size_t)(t) * D_ + 4 * lane + 256 * j); hm[j] = (f32x4){bf2f(_h.x & 0xffffu), bf2f(_h.x >> 16), bf2f(_h.y & 0xffffu), bf2f(_h.y >> 16)}; xv[j] = *(const f32x4*)(x + (size_t)(t) * D_ + 4 * lane + 256 * j); } } while (0)
            R2_LOAD(hmA, xvA, tb); R2_LOAD(hmB, xvB, tb + 1);
            row2_front(p, lds, tb, wave * 4, lane, hmA, xvA, P);
            R2_LOAD(hmA, xvA, tb + 2);
            row2_front(p, lds, tb + 1, wave * 4 + 1, lane, hmB, xvB, P);
            R2_LOAD(hmB, xvB, tb + 3);
            row2_front(p, lds, tb + 2, wave * 4 + 2, lane, hmA, xvA, P);
            row2_front(p, lds, tb + 3, wave * 4 + 3, lane, hmB, xvB, P);
#undef R2_LOAD
            __syncthreads();
            f32x4 acc[2][5];
#pragma unroll
            for (int mb = 0; mb < 2; ++mb)
#pragma unroll
                for (int n5 = 0; n5 < 5; ++n5) acc[mb][n5] = (f32x4){0.f, 0.f, 0.f, 0.f};
            bf16x8_t bh[1][5], bl[1][5];
#define R2_BLOAD(buf, s4) do { const int _ks = wave * 4 + (s4); _Pragma("unroll") for (int n5 = 0; n5 < 5; ++n5) { \
                bh[buf][n5] = *(const bf16x8_t*)(WRTH + (size_t)(16 * n5 + fr) * 1024 + _ks * 32 + fq * 8); bl[buf][n5] = *(const bf16x8_t*)(WRTL + (size_t)(16 * n5 + fr) * 1024 + _ks * 32 + fq * 8); } } while (0)
#define R2_BFORCE(buf) do { asm volatile("" : "+v"(bh[buf][0]), "+v"(bh[buf][1]), "+v"(bh[buf][2]), "+v"(bh[buf][3]), "+v"(bh[buf][4]), "+v"(bl[buf][0]), "+v"(bl[buf][1]), "+v"(bl[buf][2]), "+v"(bl[buf][3]), "+v"(bl[buf][4])); } while (0)
#pragma unroll
            for (int s4 = 0; s4 < 4; ++s4) {
                const int ks = wave * 4 + s4;
                R2_BLOAD(0, s4);
                bf16x8_t ah[2], al[2];
#pragma unroll
                for (int mb = 0; mb < 2; ++mb) { const int r = 16 * mb + fr, off = r * 2048 + (((4 * ks + fq) ^ (r & 15)) << 4); ah[mb] = ldfrag(lds + off); al[mb] = ldfrag(lds + 65536 + off); }
                R2_BFORCE(0);
#pragma unroll
                for (int n5 = 0; n5 < 5; ++n5) {
#pragma unroll
                    for (int mb = 0; mb < 2; ++mb) {
                        acc[mb][n5] = __builtin_amdgcn_mfma_f32_16x16x32_bf16(ah[mb], bh[0][n5], acc[mb][n5], 0, 0, 0);
                        acc[mb][n5] = __builtin_amdgcn_mfma_f32_16x16x32_bf16(al[mb], bh[0][n5], acc[mb][n5], 0, 0, 0);
                        acc[mb][n5] = __builtin_amdgcn_mfma_f32_16x16x32_bf16(ah[mb], bl[0][n5], acc[mb][n5], 0, 0, 0);
                    }
                }
            }
#undef R2_BLOAD
#undef R2_BFORCE
            __syncthreads();
            { const int l2 = lane_id_v(), fq2 = l2 >> 4, fr2 = l2 & 15;
#pragma unroll
            for (int mb = 0; mb < 2; ++mb)
#pragma unroll
                for (int n5 = 0; n5 < 5; ++n5)
#pragma unroll
                    for (int r = 0; r < 4; ++r) PART[(wave * 32 + 16 * mb + 4 * fq2 + r) * 80 + 16 * n5 + fr2] = acc[mb][n5][r]; }
            __syncthreads();
            const int tid3 = opaque_tid();
            for (int i = tid3; i < 2560; i += NTHR) { float a = 0.f;
#pragma unroll
                for (int w = 0; w < 8; ++w) a += PART[w * 2560 + i];
                LOG[i] = a; }
            __syncthreads();
            if (tid3 < 32) {
                const LAS float* lg = LOG + tid3 * 80;
                float gmax = -3.0e38f; int gi = 0; float gl[8];
#pragma unroll
                for (int o = 0; o < 8; ++o) { gl[o] = lg[o] + brg[o]; if (gl[o] > gmax) { gmax = gl[o]; gi = o; } }
                float gden = 0.f;
#pragma unroll
                for (int o = 0; o < 8; ++o) gden += __expf(gl[o] - gmax);
                const float gp = 1.f / gden;
                float m1 = -3.0e38f, m2 = -3.0e38f; int i1 = 0, i2 = 0; float el[8];
#pragma unroll
                for (int o = 0; o < 8; ++o) el[o] = lg[16 + gi * 8 + o] + bre[gi * 8 + o];
#pragma unroll
                for (int o = 0; o < 8; ++o) { if (el[o] > m1) { m1 = el[o]; i1 = o; } }
#pragma unroll
                for (int o = 0; o < 8; ++o) { if (o != i1 && el[o] > m2) { m2 = el[o]; i2 = o; } }
                const float e2 = __expf(m2 - m1);
                const int lr = pass * 32 + tid3, ea = gi * 8 + i1, eb = gi * 8 + i2;
                rte[2 * lr] = ea; rte[2 * lr + 1] = eb;
                rtw[2 * lr] = gp * (1.f / (1.f + e2)); rtw[2 * lr + 1] = gp * (e2 / (1.f + e2));
                rtr[2 * lr] = __hip_atomic_fetch_add(lcnt + ea, 1, __ATOMIC_RELAXED, __HIP_MEMORY_SCOPE_WORKGROUP); rtr[2 * lr + 1] = __hip_atomic_fetch_add(lcnt + eb, 1, __ATOMIC_RELAXED, __HIP_MEMORY_SCOPE_WORKGROUP);
            }
            __syncthreads();
        }
        const int tq = opaque_tid();
        if (tq < 64) { const int c = lcnt[tq]; lbase[tq] = c > 0 ? (int)atomicAdd(cnt + tq, (unsigned)c) : 0; }
        __syncthreads();
        if (tq < 128) {
            const int e = rte[tq], pos = lbase[e] + rtr[tq], t = chunk * 64 + (tq >> 1);
            ROUTE[(size_t)t * 4 + (tq & 1)] = e; POS[(size_t)t * 2 + (tq & 1)] = pos;
            TOKL[(size_t)e * T_ + pos] = t; WL[(size_t)e * T_ + pos] = rtw[tq];
        }
        __syncthreads();
        if (tq < 64) lcnt[tq] = 0;
        __syncthreads();
    }
}

struct MoeMap { LAS int* tstart; LAS int* cnt; int total_tiles; };
__device__ __forceinline__ MoeMap moe_map(int wv, const Params& p, LAS int* l) {
    const unsigned* cnt = (const unsigned*)(p.ws + WS_CTL) + CW_CNT;
    __syncthreads();
    if (wv == 0) {
        const int e = lane_id_v();
        const int c = (int)__hip_atomic_load(cnt + e, __ATOMIC_RELAXED, __HIP_MEMORY_SCOPE_AGENT);
        const int nt = (c + TM - 1) / TM; int incl = nt;
#pragma unroll
        for (int o = 1; o < 64; o <<= 1) { const int y = __shfl_up(incl, o); if (e >= o) incl += y; }
        l[e] = incl - nt; l[128 + e] = c; if (e == 63) l[NE] = incl;
    }
    __syncthreads();
    MoeMap m; m.tstart = l; m.cnt = l + 128; m.total_tiles = l[NE];
    return m;
}
__device__ __forceinline__ int moe_find(const MoeMap& m, int tile) { int e = 0; while (e < NE - 1 && m.tstart[e + 1] <= tile) ++e; return e; }

__device__ __forceinline__ void ph_moe_gu(int wv, const Params& p, LAS unsigned char* lds, int bid, int nb) {
    MoeMap mm = moe_map(wv, p, (LAS int*)(lds + pg8::STAGE_BYTES));
    pg8::GroupSched S{(const char*)(p.ws + WS_H), (const char*)(p.ws + WS_WGUT), D_, 4, (size_t)2 * DE * D_ * 2, mm.tstart, mm.cnt, mm.total_tiles, nb, bid, (const int*)(p.ws + WS_TOKL)};
    pg8::EpiGU E{(bf16*)(p.ws + WS_HID)};
    pg8::gemm_phase(wv, lds, S, E);
}
__device__ __forceinline__ void ph_moe_down(int wv, const Params& p, LAS unsigned char* lds, int bid, int nb) {
    MoeMap mm = moe_map(wv, p, (LAS int*)(lds + pg8::STAGE_BYTES));
    pg8::GroupSched S{(const char*)(p.ws + WS_HID), (const char*)(p.ws + WS_WDNT), DE, 4, (size_t)D_ * DE * 2, mm.tstart, mm.cnt, mm.total_tiles, nb, bid, nullptr};
    pg8::EpiDown E{(bf16*)(p.ws + WS_Y), (const float*)(p.ws + WS_WL), mm.cnt};
    pg8::gemm_phase(wv, lds, S, E);
}

__device__ void ph_final(int wv, const Params& p, LAS float* lds, int bid, int nb) {
    const int tid = opaque_tid(), lane = tid & 63, wave = tid >> 6;
    const float* npf = p.in[18]; const float* mod = (const float*)(p.ws + WS_MOD);
    const bf16* Y = (const bf16*)(p.ws + WS_Y); const int* ROUTE = (const int*)(p.ws + WS_ROUTE); const int* POS = (const int*)(p.ws + WS_POS);
    MoeMap mm = moe_map(wv, p, (LAS int*)lds);
    for (int t = bid * 8 + wave; t < T_; t += nb * 8) {
        const int b = t / NS_;
        const int ea = ROUTE[(size_t)t * 4], eb = ROUTE[(size_t)t * 4 + 1];
        const size_t ga = (size_t)mm.tstart[ea] * TM + POS[(size_t)t * 2], gb = (size_t)mm.tstart[eb] * TM + POS[(size_t)t * 2 + 1];
        float m[16]; float ss = 0.f;
#pragma unroll
        for (int j = 0; j < 4; ++j) {
            const uint2 a = *(const uint2*)(Y + ga * D_ + 4 * lane + 256 * j), bb = *(const uint2*)(Y + gb * D_ + 4 * lane + 256 * j);
            m[4 * j] = bf2f(a.x & 0xffffu) + bf2f(bb.x & 0xffffu); m[4 * j + 1] = bf2f(a.x >> 16) + bf2f(bb.x >> 16);
            m[4 * j + 2] = bf2f(a.y & 0xffffu) + bf2f(bb.y & 0xffffu); m[4 * j + 3] = bf2f(a.y >> 16) + bf2f(bb.y >> 16);
#pragma unroll
            for (int i = 0; i < 4; ++i) ss += m[4 * j + i] * m[4 * j + i];
        }
        ss = wave_sum(ss);
        const float r = rsqrtf(ss * (1.f / D_) + EPS);
#pragma unroll
        for (int j = 0; j < 4; ++j) {
            const int c0 = 4 * lane + 256 * j;
            float4 o = *(float4*)(p.out + (size_t)t * D_ + c0);
            o.x += mod[b * 6144 + 5120 + c0] * (m[4 * j] * r * npf[c0]);
            o.y += mod[b * 6144 + 5120 + c0 + 1] * (m[4 * j + 1] * r * npf[c0 + 1]);
            o.z += mod[b * 6144 + 5120 + c0 + 2] * (m[4 * j + 2] * r * npf[c0 + 2]);
            o.w += mod[b * 6144 + 5120 + c0 + 3] * (m[4 * j + 3] * r * npf[c0 + 3]);
            *(float4*)(p.out + (size_t)t * D_ + c0) = o;
        }
    }
}

constexpr int LDS_BYTES = 147456;
#define XB_TMO      128
#define XB_XCNT(j)  (256  + 64 * (j))
#define XB_XSUB(j)  (1280 + 64 * (j))
#define XB_XGEN(j)  (2304 + 64 * (j))
#define XB_TOP      3328
#define XB_TOPGEN   3392
#define XCD_BAR_WORDS 3456
#define XB_SPIN_CAP (1u << 22)
__device__ __forceinline__ unsigned xb_ld(unsigned* p)              { return __hip_atomic_load(p, __ATOMIC_RELAXED, __HIP_MEMORY_SCOPE_AGENT); }
__device__ __forceinline__ unsigned xb_add(unsigned* p, unsigned v) { return __hip_atomic_fetch_add(p, v, __ATOMIC_RELAXED, __HIP_MEMORY_SCOPE_AGENT); }
__device__ __forceinline__ unsigned xb_xcc_id() { return (unsigned)__builtin_amdgcn_s_getreg((3 << 11) | 20) & 0xFu; }
#define XB_SPIN(cond, bar) do { unsigned _sp = 0; while (cond) { __builtin_amdgcn_s_sleep(1); \
    if ((++_sp & 255u) == 0u) { if (xb_ld(&(bar)[XB_TMO])) break; if (_sp > XB_SPIN_CAP) { atomicAdd(&(bar)[XB_TMO], 1u); break; } } } } while (0)
struct XcdBarrier { unsigned* bar; unsigned x; volatile LAS unsigned* st; };
__device__ __forceinline__ XcdBarrier xcd_barrier_post(int wv, unsigned* bar, volatile LAS unsigned* st) {
    XcdBarrier b; b.bar = bar; b.x = xb_xcc_id(); b.st = st;
    if (wv == 0 && lane_id_v() == 0) (void)xb_add(&bar[XB_XCNT(b.x)], 1u);
    return b;
}
__device__ __forceinline__ void xcd_barrier_complete(unsigned* bar, unsigned x, unsigned& nloc, unsigned& nx) {
    const unsigned G = gridDim.x * gridDim.y * gridDim.z;
    unsigned sum, cnt, mine, sp = 0u;
    for (;;) {
        sum = 0u; cnt = 0u; mine = 0u;
#pragma unroll
        for (unsigned j = 0; j < 16; ++j) { const unsigned c = xb_ld(&bar[XB_XCNT(j)]); sum += c; cnt += (c > 0u) ? 1u : 0u; mine = (j == x) ? c : mine; }
        if (sum == G) break;
        __builtin_amdgcn_s_sleep(1);
        if ((++sp & 255u) == 0u) { if (xb_ld(&bar[XB_TMO])) break; if (sp > XB_SPIN_CAP) { atomicAdd(&bar[XB_TMO], 1u); break; } }
    }
    nloc = mine > 0u ? mine : 1u; nx = cnt > 0u ? cnt : 1u;
}
__device__ __forceinline__ void xcd_barrier(int wv, unsigned char* ws, volatile LAS unsigned* st) {
    XcdBarrier b; b.bar = (unsigned*)(ws + WS_CTL) + 4096; b.x = xb_xcc_id(); b.st = st;
    asm volatile("s_waitcnt vmcnt(0)" ::: "memory");
    __syncthreads();
    if (wv == 0 && lane_id_v() == 0) {
        unsigned* bar = b.bar;
        __builtin_amdgcn_s_waitcnt(0);
        unsigned nloc = b.st[0], nx = b.st[1];
        if (nloc == 0u) { xcd_barrier_complete(bar, b.x, nloc, nx); b.st[0] = nloc; b.st[1] = nx; }
        const unsigned old = xb_add(&bar[XB_XSUB(b.x)], 1u);
        const unsigned gen = old / nloc;
        if (old + 1u == (gen + 1u) * nloc) {
            __builtin_amdgcn_fence(__ATOMIC_RELEASE, "agent");
            asm volatile("s_waitcnt vmcnt(0)" ::: "memory");
            const unsigned og = xb_add(&bar[XB_TOP], 1u);
            const unsigned tg = og / nx;
            if (og + 1u == (tg + 1u) * nx) xb_add(&bar[XB_TOPGEN], 1u);
            else XB_SPIN(xb_ld(&bar[XB_TOPGEN]) == tg, bar);
            __builtin_amdgcn_fence(__ATOMIC_ACQUIRE, "agent");
            xb_add(&bar[XB_XGEN(b.x)], 1u);
            asm volatile("s_waitcnt vmcnt(0)" ::: "memory");
        } else {
            XB_SPIN(xb_ld(&bar[XB_XGEN(b.x)]) == gen, bar);
            __builtin_amdgcn_fence(__ATOMIC_ACQUIRE, "agent");
            asm volatile("s_waitcnt vmcnt(0)" ::: "memory");
        }
    }
    __syncthreads();
}
constexpr int CW_BAR = 4096;
constexpr int LDS_ST_OFF = LDS_BYTES - 64;

__global__ void __launch_bounds__(NTHR, 2) mk_all(Params p) {
    extern __shared__ __attribute__((aligned(16))) unsigned char lds_raw[];
    LAS float* lds = (LAS float*)lds_raw;
    const int bid = blockIdx.x, nb = gridDim.x;
    volatile LAS unsigned* st = (volatile LAS unsigned*)((LAS unsigned char*)lds_raw + LDS_ST_OFF);
    const int wv = __builtin_amdgcn_readfirstlane(threadIdx.x >> 6);
    if (threadIdx.x < 16) st[threadIdx.x] = 0u;
    __syncthreads();
    (void)xcd_barrier_post(wv, (unsigned*)(p.ws + WS_CTL) + CW_BAR, st);
#ifndef STAMP_SEL
#define STAMP_SEL -1
#endif
    unsigned long long t_prev = 0, dt_sel = 0;
    if (STAMP_SEL >= 0) t_prev = __builtin_amdgcn_s_memrealtime();
#define STAMP(k) do { if (STAMP_SEL >= 0) { const unsigned long long now_ = __builtin_amdgcn_s_memrealtime(); if ((k) == STAMP_SEL && bid == 0) dt_sel = now_ - t_prev; t_prev = now_; } } while (0)
    ph_wprep(wv, p, lds, bid, nb); __syncthreads();
    ph_mod(wv, p, lds, bid, nb);            xcd_barrier(wv, p.ws, st); STAMP(0);
    int pan, qua; { pg8::DenseSched S0; S0.init(nullptr, nullptr, T_, D_, D_, nb, bid); pg8::Unit u0; S0.next(0, u0); pan = u0.pm; qua = u0.pn; }
    ph_h(wv, p, lds, pan * 256 + qua * 64);
    group_sync(wv, (unsigned*)(p.ws + WS_CTL) + CW_HF + 64 * pan, 4u); STAMP(1);
    ph_proj(wv, p, (LAS unsigned char*)lds_raw, bid, nb);           xcd_barrier(wv, p.ws, st); STAMP(2);
    ph_dnprep(wv, p, (LAS unsigned char*)lds_raw, bid, nb); __syncthreads();
    ph_cf(wv, p, lds, bid, nb);
    xcd_barrier(wv, p.ws, st); STAMP(3);
    {
        constexpr int CONV_ITEMS = NE * ((D_ / 64) * (2 * DE / 128) + (DE / 64) * (D_ / 128)), CONV_SPLIT = (CONV_ITEMS * 21 / 100) & ~7;
        if (bid < nb / 2) { ph_dnscan(wv, p, (LAS unsigned char*)lds_raw, bid, nb / 2); ph_wprep_experts(wv, p, bid, nb / 2, 0, CONV_SPLIT); }
        else ph_wprep_experts(wv, p, bid - nb / 2, nb - nb / 2, CONV_SPLIT, CONV_ITEMS);
    }
    if (STAMP_SEL == 40 && bid == 0) { const unsigned long long now_ = __builtin_amdgcn_s_memrealtime(); dt_sel = now_ - t_prev; }
    xcd_barrier(wv, p.ws, st); STAMP(4);
    ph_outproj(wv, p, (LAS unsigned char*)lds_raw, bid, nb);
    group_sync(wv, (unsigned*)(p.ws + WS_CTL) + CW_OF + 64 * pan, 4u); STAMP(6);
    ph_row2(wv, p, (LAS unsigned char*)lds_raw, pan * 4 + qua);           xcd_barrier(wv, p.ws, st); STAMP(7);
    ph_moe_gu(wv, p, (LAS unsigned char*)lds_raw, bid, nb);      xcd_barrier(wv, p.ws, st); STAMP(8);
    ph_moe_down(wv, p, (LAS unsigned char*)lds_raw, bid, nb);    xcd_barrier(wv, p.ws, st); STAMP(9);
    ph_final(wv, p, lds, bid, nb);
    if (STAMP_SEL >= 0) {
        __syncthreads(); STAMP(10);
        { const unsigned long long t0 = __builtin_amdgcn_s_memrealtime(); while (__builtin_amdgcn_s_memrealtime() - t0 < 8ull * dt_sel) __builtin_amdgcn_s_sleep(8); }
    }
}

extern "C" void kernel_launch(void* const* d_in, const int* in_sizes, int n_in, void* d_out, int out_size, void* d_ws, size_t ws_size, hipStream_t stream) {
    static int inited = 0;
    if (!inited) {
        if (n_in != 26 || out_size != T_ * D_ || ws_size < WS_END) { fprintf(stderr, "kernel_launch: unexpected shapes n_in %d out %d ws %zu\n", n_in, out_size, ws_size); inited = -1; return; }
        if (hipFuncSetAttribute((const void*)mk_all, hipFuncAttributeMaxDynamicSharedMemorySize, LDS_BYTES) != hipSuccess) { fprintf(stderr, "hipFuncSetAttribute failed\n"); inited = -1; return; }
        inited = 1;
    }
    if (inited < 0) return;
    (void)hipMemsetAsync((char*)d_ws + WS_CTL, 0, 1 * MiB, stream);
    Params p{};
    for (int i = 0; i < 26; ++i) p.in[i] = (const float*)d_in[i];
    p.out = (float*)d_out; p.ws = (unsigned char*)d_ws;
    hipLaunchKernelGGL(mk_all, dim3(256), dim3(NTHR), LDS_BYTES, stream, p);
}
```

```cpp
#include <hip/hip_runtime.h>
#include <cstdio>
#include <cstdint>

#define LAS __attribute__((address_space(3)))
typedef unsigned short bf16;
typedef float f32x4 __attribute__((ext_vector_type(4)));

constexpr int NB_ = 8, NS_ = 2048, D_ = 1024, T_ = NB_ * NS_;
constexpr int DNW = 512, NH = 4, HD = 128;
constexpr int CFW = 512, CFK = 31;
constexpr int INC = 3080;
constexpr int PJ = 3072;
constexpr int NE = 64, DE = 512;
constexpr int NTHR = 512;
constexpr float EPS = 1e-6f;
constexpr int TM = 256;
constexpr int MAXROWS = 2 * T_ + NE * TM;

constexpr size_t MiB = 1u << 20;
constexpr size_t WS_CTL = 0;
constexpr size_t WS_MOD = 1 * MiB;
constexpr size_t WS_SMALL = 1 * MiB + 512 * 1024;
constexpr size_t WS_ROUTE = 2 * MiB;
constexpr size_t WS_POS = 2 * MiB + 512 * 1024;
constexpr size_t WS_TOKL = 3 * MiB;
constexpr size_t WS_WL = 7 * MiB;
constexpr size_t WS_W8T = 11 * MiB;
constexpr size_t WS_WRTH = 12 * MiB;
constexpr size_t WS_WRTL = 12 * MiB + 256 * 1024;
constexpr size_t WS_WINT = 16 * MiB;
constexpr size_t WS_WOUTT = 22 * MiB;
constexpr size_t WS_WGUT = 24 * MiB;
constexpr size_t WS_WDNT = 152 * MiB;
constexpr size_t WS_H = 216 * MiB;
constexpr size_t WS_PROJ = 248 * MiB;
constexpr size_t WS_HMIX = 248 * MiB;
constexpr size_t WS_HID = 248 * MiB;
constexpr size_t WS_DW = 344 * MiB;
constexpr size_t WS_DQG = 360 * MiB;
constexpr size_t WS_DKDT = 376 * MiB;
constexpr size_t WS_DATT = 392 * MiB;
constexpr size_t WS_DU = 400 * MiB;
constexpr size_t WS_DEGL = 432 * MiB;
constexpr size_t WS_Y = 344 * MiB;
constexpr size_t WS_ORAW = 440 * MiB;
constexpr size_t WS_X1B = 440 * MiB;
constexpr size_t WS_MIXED = 472 * MiB;
constexpr size_t WS_END = 504 * MiB;
constexpr int CW_CNT = 1024;
constexpr int CW_DNF = 2048;
constexpr int CW_HF = 8192;
constexpr int CW_OF = 12288;
constexpr int CW_RDY = 16384;
constexpr int CTL_BYTES = (CW_RDY + 16 * 256) * 4;

__device__ __forceinline__ unsigned f2bf(float f) { unsigned u = __builtin_bit_cast(unsigned, f); return (u + 0x7fffu + ((u >> 16) & 1u)) >> 16; }
__device__ __forceinline__ float bf2f(unsigned b) { return __builtin_bit_cast(float, b << 16); }
typedef __bf16 hw_bf16x2 __attribute__((ext_vector_type(2)));
typedef float hw_f32x2 __attribute__((ext_vector_type(2)));
__device__ __forceinline__ unsigned pk2bf(float lo, float hi) { const hw_f32x2 v = {lo, hi}; const hw_bf16x2 b = __builtin_convertvector(v, hw_bf16x2); return __builtin_bit_cast(unsigned, b); }

template <int CTRL, int ROWMASK> __device__ __forceinline__ float dpp_f(float v) {
    return __builtin_bit_cast(float, __builtin_amdgcn_update_dpp(0, __builtin_bit_cast(int, v), CTRL, ROWMASK, 0xF, true));
}
__device__ __forceinline__ float wave_sum(float v) {
    v += dpp_f<0xB1, 0xF>(v);
    v += dpp_f<0x4E, 0xF>(v);
    v += dpp_f<0x141, 0xF>(v);
    v += dpp_f<0x140, 0xF>(v);
    v += dpp_f<0x142, 0xA>(v);
    v += dpp_f<0x143, 0xC>(v);
    return __builtin_bit_cast(float, __builtin_amdgcn_readlane(__builtin_bit_cast(int, v), 63));
}
__device__ __forceinline__ float sigmoidf_(float x) { return __builtin_amdgcn_rcpf(1.f + __expf(-x)); }
__device__ __forceinline__ float siluf_(float x) { return x * __builtin_amdgcn_rcpf(1.f + __expf(-x)); }

__device__ __forceinline__ int lane_id_v() { int l; asm volatile("v_mbcnt_lo_u32_b32 %0, -1, 0\n\tv_mbcnt_hi_u32_b32 %0, -1, %0" : "=v"(l)); return l; }
__device__ __forceinline__ int opaque_tid_w(int wv) { return (wv << 6) | lane_id_v(); }
#define opaque_tid() opaque_tid_w(wv)

__device__ __forceinline__ void group_sync(int wv, unsigned* flag, unsigned target) {
    asm volatile("s_waitcnt vmcnt(0)" ::: "memory");
    __syncthreads();
    if (wv == 0 && lane_id_v() == 0) {
        __builtin_amdgcn_fence(__ATOMIC_RELEASE, "agent");
        asm volatile("s_waitcnt vmcnt(0)" ::: "memory");
        __hip_atomic_fetch_add(flag, 1u, __ATOMIC_RELAXED, __HIP_MEMORY_SCOPE_AGENT);
        unsigned sp = 0;
        while (__hip_atomic_load(flag, __ATOMIC_RELAXED, __HIP_MEMORY_SCOPE_AGENT) < target) { __builtin_amdgcn_s_sleep(1); if (++sp > (1u << 22)) break; }
        __builtin_amdgcn_fence(__ATOMIC_ACQUIRE, "agent");
        asm volatile("s_waitcnt vmcnt(0)" ::: "memory");
    }
    __syncthreads();
}

struct Params {
    const float* in[26];
    float* out;
    unsigned char* ws;
};


namespace pg8 {
#define PG8_LAS __attribute__((address_space(3)))
typedef unsigned short bf16_t;
typedef short bf16x8 __attribute__((ext_vector_type(8)));
typedef float f32x4 __attribute__((ext_vector_type(4)));
typedef unsigned u32x4 __attribute__((ext_vector_type(4)));
typedef unsigned u32x2 __attribute__((ext_vector_type(2)));
constexpr int BM = 256, BK = 64, HALF = 128, HTB = HALF * BK * 2, STAGE_BYTES = 8 * HTB, NXCD = 8, WGM = 8;
__host__ __device__ __forceinline__ int lds_byte(int r, int c) { const int st = (r >> 4) * 2 + (c >> 5), rr = r & 15, cc = c & 31, ob = rr * 64 + cc * 2; return st * 1024 + (ob ^ (((ob >> 9) & 1) << 5)); }
__host__ __device__ __forceinline__ void stage_rc(int b, int& R, int& C) { const int st = b / 1024, sb = b % 1024, swz = sb ^ (((sb >> 9) & 1) << 5); R = (st >> 1) * 16 + swz / 64; C = (st & 1) * 32 + (swz % 64) / 2; }
__host__ __device__ __forceinline__ int perm32(int rho) { const int n = rho >> 4, i = rho & 15; return 8 * (i >> 2) + 4 * n + (i & 3); }
struct Unit { int pm, pn, e, r0; };
__device__ __forceinline__ void st_wt16(void* p, u32x4 v) { asm volatile("global_store_dwordx4 %0, %1, off sc1\n\ts_nop 1" :: "v"(p), "v"(v) : "memory"); }
__device__ __forceinline__ unsigned cvt_pk_bf16(float lo, float hi) { unsigned r; asm volatile("v_cvt_pk_bf16_f32 %0, %1, %2" : "=v"(r) : "v"(lo), "v"(hi)); return r; }

struct DenseSched {
    const char* A; const char* Bt; int K; int nM, nN, nwg, G, c;
    __device__ void init(const void* A_, const void* Bt_, int M, int N, int K_, int G_, int c_) { A = (const char*)A_; Bt = (const char*)Bt_; K = K_; nM = M / BM; nN = N / BM; nwg = nM * nN; G = G_; c = c_; }
    __device__ bool next(int i, Unit& u) const {
        const long L = (long)i * G + c; if (L >= nwg) return false;
        int wgid = (int)L; { const int q = nwg / NXCD, r = nwg % NXCD, xcd = wgid % NXCD, off = wgid / NXCD; wgid = (xcd < r ? xcd * (q + 1) : r * (q + 1) + (xcd - r) * q) + off; }
        const int nig = WGM * nN, gid = wgid / nig, fm = gid * WGM, gsz = (nM - fm) < WGM ? (nM - fm) : WGM;
        u.pm = fm + ((wgid % nig) % gsz); u.pn = (wgid % nig) / gsz; u.e = 0; u.r0 = 0; return true;
    }
    __device__ __forceinline__ const char* a_base() const { return A; }
    __device__ __forceinline__ void a_ready(const Unit&, int) const {}
    __device__ __forceinline__ void done(const Unit&, int) const {}
    __device__ __forceinline__ const char* b_ptr(const Unit& u) const { return Bt + (size_t)u.pn * BM * K * 2; }
    __device__ __forceinline__ void a_off(const Unit& u, const int (&R)[2], const int (&C)[2], unsigned (&v)[2][2]) const {
#pragma unroll
        for (int h = 0; h < 2; ++h)
#pragma unroll
            for (int i = 0; i < 2; ++i) v[h][i] = (unsigned)(((u.pm * BM + h * HALF + R[i]) * K + C[i]) * 2);
    }
};

template <class Fin>
struct DenseSchedFin : DenseSched {
    Fin fin;
    __device__ __forceinline__ void a_ready(const Unit&, int) const { fin(); }
};
struct EpiBf16 {
    static constexpr bool PERM = true;
    bf16_t* O; int ldc;
    __device__ __forceinline__ void operator()(const f32x4 (&acc)[2][2][4][2], const Unit& u, int wr, int wc, int fr, int fq) const {
        const int row0 = u.pm * BM + wr * 64 + fr, col0 = u.pn * BM + wc * 32 + 8 * fq;
#pragma unroll
        for (int ai = 0; ai < 2; ++ai)
#pragma unroll
            for (int m = 0; m < 4; ++m) { bf16_t* rowp = O + (size_t)(row0 + ai * HALF + m * 16) * ldc + col0;
#pragma unroll
                for (int bj = 0; bj < 2; ++bj) { const f32x4 v0 = acc[ai][bj][m][0], v1 = acc[ai][bj][m][1];
                    u32x4 w; w.x = cvt_pk_bf16(v0[0], v0[1]); w.y = cvt_pk_bf16(v0[2], v0[3]); w.z = cvt_pk_bf16(v1[0], v1[1]); w.w = cvt_pk_bf16(v1[2], v1[3]);
                    st_wt16(rowp + bj * HALF, w); } }
    }
};
struct EpiF32 {
    static constexpr bool PERM = false;
    float* C; int ldc;
    __device__ __forceinline__ void operator()(const f32x4 (&acc)[2][2][4][2], const Unit& u, int wr, int wc, int fr, int fq) const {
        const int row0 = u.pm * BM + wr * 64 + fr, col0 = u.pn * BM + wc * 32 + 4 * fq;
#pragma unroll
        for (int ai = 0; ai < 2; ++ai)
#pragma unroll
            for (int m = 0; m < 4; ++m) { float* rowp = C + (size_t)(row0 + ai * HALF + m * 16) * ldc + col0;
#pragma unroll
                for (int bj = 0; bj < 2; ++bj)
#pragma unroll
                    for (int n = 0; n < 2; ++n) *(f32x4*)(rowp + bj * HALF + n * 16) = acc[ai][bj][m][n]; }
    }
};

template <int MODE>
struct GroupSched {
    const char* A; const char* Bt; int K; int nN; size_t bstride; LAS int* tstart; LAS int* cnt; int total; int G, c; const int* tokl; unsigned* ready;
    __device__ __forceinline__ bool next(int i, Unit& u) const {
        const int U = total * nN, x = c & 7, lo = (U * x) >> 3, hi = (U * (x + 1)) >> 3;
        const int GB = G >> 3, pos = MODE == 2 ? GB - 1 - (c >> 3) : (c >> 3);
        const int cu = (hi - lo - pos + GB - 1) / GB; if (i >= cu) return false;
        int j = i;
        if constexpr (MODE == 1) { if (cu >= 3) j = (i == 0) ? cu - 1 : i - 1; }
        if constexpr (MODE == 2) { j = (i == 0) ? 0 : cu - i; }
        const int uu = lo + pos + GB * j; if (uu >= hi) return false;
        int e = 0;
#pragma unroll
        for (int sft = NE / 2; sft >= 1; sft >>= 1) { if (tstart[e + sft] * nN <= uu) e += sft; }
        const int w = uu - tstart[e] * nN, rt = w / nN, pn = w - rt * nN;
        u.pn = pn; u.e = e; u.pm = tstart[e] + rt; u.r0 = rt * BM; return true;
    }
    __device__ __forceinline__ const char* a_base() const { return A; }
    __device__ __forceinline__ void a_ready(const Unit& u, int wid) const {
        if constexpr (MODE == 2) {
            if (wid == 0) {
                unsigned sp = 0;
                while ((unsigned)__builtin_amdgcn_readfirstlane(__hip_atomic_load(ready + 16 * u.pm, __ATOMIC_RELAXED, __HIP_MEMORY_SCOPE_AGENT)) < 32u) { __builtin_amdgcn_s_sleep(1); if (++sp > (1u << 18)) break; }
                __builtin_amdgcn_fence(__ATOMIC_ACQUIRE, "agent");
                asm volatile("s_waitcnt vmcnt(0)" ::: "memory");
            }
            asm volatile("" ::: "memory"); __builtin_amdgcn_s_barrier(); asm volatile("" ::: "memory");
        }
    }
    __device__ __forceinline__ void done(const Unit& u, int lane) const {
        if constexpr (MODE == 1) {
            asm volatile("s_waitcnt vmcnt(0)" ::: "memory");
            if (lane == 0) __hip_atomic_fetch_add(ready + 16 * u.pm, 1u, __ATOMIC_RELAXED, __HIP_MEMORY_SCOPE_AGENT);
        }
    }
    __device__ __forceinline__ const char* b_ptr(const Unit& u) const { return Bt + (size_t)u.e * bstride + (size_t)u.pn * BM * K * 2; }
    __device__ __forceinline__ void a_off(const Unit& u, const int (&R)[2], const int (&C)[2], unsigned (&v)[2][2]) const {
        const int ce = cnt[u.e];
        if (tokl) {
            const int* tl = tokl + (size_t)u.e * T_ + u.r0;
            int t4[2][2];
#pragma unroll
            for (int h = 0; h < 2; ++h)
#pragma unroll
                for (int i = 0; i < 2; ++i) t4[h][i] = tl[h * HALF + R[i]];
            asm volatile("" : "+v"(t4[0][0]), "+v"(t4[0][1]), "+v"(t4[1][0]), "+v"(t4[1][1]));
#pragma unroll
            for (int h = 0; h < 2; ++h)
#pragma unroll
                for (int i = 0; i < 2; ++i) { const int grow = (u.r0 + h * HALF + R[i] < ce) ? t4[h][i] : 0; v[h][i] = (unsigned)((grow * K + C[i]) * 2); }
        } else {
#pragma unroll
            for (int h = 0; h < 2; ++h)
#pragma unroll
                for (int i = 0; i < 2; ++i) v[h][i] = (unsigned)(((u.pm * BM + h * HALF + R[i]) * K + C[i]) * 2);
        }
    }
};
struct EpiGU {
    static constexpr bool PERM = true;
    bf16_t* HID;
    __device__ __forceinline__ void operator()(const f32x4 (&acc)[2][2][4][2], const Unit& u, int wr, int wc, int fr, int fq) const {
        const int row0 = u.pm * BM + wr * 64 + fr, col0 = u.pn * HALF + wc * 32 + 8 * fq;
#pragma unroll
        for (int ai = 0; ai < 2; ++ai)
#pragma unroll
            for (int m = 0; m < 4; ++m) { bf16_t* rowp = HID + (size_t)(row0 + ai * HALF + m * 16) * DE + col0;
                float h[8];
#pragma unroll
                for (int n = 0; n < 2; ++n) { const f32x4 g = acc[ai][0][m][n], up = acc[ai][1][m][n];
#pragma unroll
                    for (int i = 0; i < 4; ++i) h[4 * n + i] = g[i] * __builtin_amdgcn_rcpf(1.f + __expf(-g[i])) * up[i]; }
                u32x4 w; w.x = cvt_pk_bf16(h[0], h[1]); w.y = cvt_pk_bf16(h[2], h[3]); w.z = cvt_pk_bf16(h[4], h[5]); w.w = cvt_pk_bf16(h[6], h[7]);
                st_wt16(rowp, w); }
    }
};
struct EpiDown {
    static constexpr bool PERM = true;
    bf16_t* Y; const float* wl; LAS int* cnt;
    __device__ __forceinline__ void operator()(const f32x4 (&acc)[2][2][4][2], const Unit& u, int wr, int wc, int fr, int fq) const {
        const int rloc = wr * 64 + fr, col0 = u.pn * BM + wc * 32 + 8 * fq, ce = cnt[u.e];
#pragma unroll
        for (int ai = 0; ai < 2; ++ai) {
            float w4[4];
#pragma unroll
            for (int m = 0; m < 4; ++m) { const int r = u.r0 + rloc + ai * HALF + m * 16; w4[m] = wl[(size_t)u.e * T_ + (r < ce ? r : 0)]; }
            asm volatile("" : "+v"(w4[0]), "+v"(w4[1]), "+v"(w4[2]), "+v"(w4[3]));
#pragma unroll
            for (int m = 0; m < 4; ++m) { const int r = u.r0 + rloc + ai * HALF + m * 16;
                if (r < ce) {
                    const float w = w4[m];
                    bf16_t* rowp = Y + (size_t)(u.pm * BM + rloc + ai * HALF + m * 16) * D_ + col0;
#pragma unroll
                    for (int bj = 0; bj < 2; ++bj) { const f32x4 v0 = acc[ai][bj][m][0] * w, v1 = acc[ai][bj][m][1] * w;
                        u32x4 o; o.x = cvt_pk_bf16(v0[0], v0[1]); o.y = cvt_pk_bf16(v0[2], v0[3]); o.z = cvt_pk_bf16(v1[0], v1[1]); o.w = cvt_pk_bf16(v1[2], v1[3]);
                        *(u32x4*)(rowp + bj * HALF) = o; } } }
        }
    }
};

template <class Epi, class Sched>
__device__ __forceinline__ void gemm_phase(int wv, PG8_LAS unsigned char* lds, const Sched& S, const Epi& E) {
    int tid_ = opaque_tid();
    const int tid = tid_, wid = __builtin_amdgcn_readfirstlane(tid >> 6), lane = tid & 63, wr = wid >> 2, wc = wid & 3, fr = lane & 15, fq = lane >> 4;
    const int K = S.K, nt = K / BK;
    int sR[2], sC[2]; unsigned voffB[2];
#pragma unroll
    for (int i = 0; i < 2; ++i) { int R, C; stage_rc(tid * 16 + i * 8192, R, C); sR[i] = R; sC[i] = C; const int Rb = Epi::PERM ? ((R & ~31) + perm32(R & 31)) : R; voffB[i] = (unsigned)(Rb * K + C) * 2u; }
    const size_t kstep = (size_t)(BK * 2);
    const size_t hstep = (size_t)HALF * K * 2;
    const unsigned ldsw = (unsigned)wid * 1024u;
    const int aoff = lds_byte(wr * 64 + fr, fq * 8), boff = lds_byte(wc * 32 + fr, fq * 8);
#define PG8_SA(b, h) (((b) * 2 + (h)) * HTB)
#define PG8_SB(b, h) ((4 + (b) * 2 + (h)) * HTB)
#define PG8_STAGE(bufoff, gbase, voff) do { _Pragma("unroll") for (int _i = 0; _i < 2; ++_i) \
        __builtin_amdgcn_global_load_lds((const unsigned*)((const char*)(gbase) + (voff)[_i]), (PG8_LAS unsigned*)(lds + (bufoff) + ldsw + _i * 8192), 16, 0, 0); } while (0)
#define PG8_LDA(dst, b, h) do { _Pragma("unroll") for (int m = 0; m < 4; ++m) _Pragma("unroll") for (int k = 0; k < 2; ++k) dst[m][k] = *(const PG8_LAS bf16x8*)(lds + PG8_SA(b, h) + aoff + m * 2048 + k * 1024); } while (0)
#define PG8_LDB(dst, b, h) do { _Pragma("unroll") for (int n = 0; n < 2; ++n) _Pragma("unroll") for (int k = 0; k < 2; ++k) dst[n][k] = *(const PG8_LAS bf16x8*)(lds + PG8_SB(b, h) + boff + n * 2048 + k * 1024); } while (0)
#define PG8_MMA(ai, bj, At, Bt) do { __builtin_amdgcn_s_setprio(1); _Pragma("unroll") for (int m = 0; m < 4; ++m) _Pragma("unroll") for (int n = 0; n < 2; ++n) _Pragma("unroll") for (int k = 0; k < 2; ++k) \
        acc[ai][bj][m][n] = __builtin_amdgcn_mfma_f32_16x16x32_bf16(Bt[n][k], At[m][k], acc[ai][bj][m][n], 0, 0, 0); __builtin_amdgcn_s_setprio(0); } while (0)
#define PG8_WAIT_V(n) asm volatile("s_waitcnt vmcnt(" #n ")" ::: "memory")
#define PG8_WAIT_L(n) asm volatile("s_waitcnt lgkmcnt(" #n ")" ::: "memory")
#define PG8_BAR __builtin_amdgcn_s_barrier()
#define PG8_SCHED __builtin_amdgcn_sched_barrier(0)
    Unit cur, nxt; int ui = 0;
    if (!S.next(0, cur)) return;
    f32x4 acc[2][2][4][2];
#pragma unroll
    for (int a = 0; a < 2; ++a)
#pragma unroll
        for (int b = 0; b < 2; ++b)
#pragma unroll
            for (int m = 0; m < 4; ++m)
#pragma unroll
                for (int n = 0; n < 2; ++n) acc[a][b][m][n] = (f32x4){0.f, 0.f, 0.f, 0.f};
    bf16x8 At[4][2], B0[2][2], B1[2][2];
    const char* const gA = S.a_base();
    unsigned vC[2][2];
    S.a_off(cur, sR, sC, vC);
    const char* cB = S.b_ptr(cur);
    PG8_STAGE(PG8_SB(0, 0), cB, voffB); PG8_STAGE(PG8_SB(0, 1), cB + hstep, voffB);
    S.a_ready(cur, wid);
    PG8_STAGE(PG8_SA(0, 0), gA, vC[0]); PG8_STAGE(PG8_SA(0, 1), gA, vC[1]);
    if (wr == 1) PG8_BAR;
    PG8_WAIT_V(2); PG8_BAR;
    PG8_STAGE(PG8_SB(1, 0), cB + kstep, voffB); PG8_STAGE(PG8_SA(1, 0), gA + kstep, vC[0]); PG8_STAGE(PG8_SB(1, 1), cB + hstep + kstep, voffB);
    PG8_WAIT_V(6); PG8_BAR;
    for (;;) {
        const bool has_next = S.next(ui + 1, nxt);
        const char* nB = has_next ? S.b_ptr(nxt) : cB;
        for (int t = 0; t < nt; t += 2) {
            const bool last = (t == nt - 2);
            const char* a1 = gA + (size_t)(t + 1) * kstep;
            const char* a2 = last ? gA : gA + (size_t)(t + 2) * kstep; const char* b2 = last ? nB : cB + (size_t)(t + 2) * kstep;
            const char* a3 = a2 + kstep; const char* b3 = b2 + kstep;
            PG8_LDB(B0, 0, 0); PG8_LDB(B1, 0, 1); PG8_SCHED; PG8_LDA(At, 0, 0); PG8_STAGE(PG8_SA(1, 1), a1, vC[1]);
            PG8_WAIT_V(8); PG8_WAIT_L(0); PG8_BAR; PG8_MMA(0, 0, At, B0); PG8_MMA(0, 1, At, B1); PG8_BAR; PG8_SCHED;
            if (last && has_next) { S.a_ready(nxt, wid); S.a_off(nxt, sR, sC, vC); }
            PG8_LDA(At, 0, 1); PG8_STAGE(PG8_SB(0, 0), b2, voffB); PG8_STAGE(PG8_SB(0, 1), b2 + hstep, voffB); PG8_STAGE(PG8_SA(0, 0), a2, vC[0]);
            PG8_WAIT_V(8); PG8_WAIT_L(0); PG8_BAR; PG8_MMA(1, 0, At, B0); PG8_MMA(1, 1, At, B1); PG8_BAR; PG8_SCHED;
            PG8_LDB(B0, 1, 0); PG8_LDB(B1, 1, 1); PG8_SCHED; PG8_LDA(At, 1, 0); PG8_STAGE(PG8_SA(0, 1), a2, vC[1]);
            PG8_WAIT_V(8); PG8_WAIT_L(0); PG8_BAR; PG8_MMA(0, 0, At, B0); PG8_MMA(0, 1, At, B1); PG8_BAR; PG8_SCHED;
            PG8_LDA(At, 1, 1); PG8_STAGE(PG8_SB(1, 0), b3, voffB); PG8_STAGE(PG8_SB(1, 1), b3 + hstep, voffB); PG8_STAGE(PG8_SA(1, 0), a3, vC[0]);
            PG8_WAIT_V(8); PG8_WAIT_L(0); PG8_BAR; PG8_MMA(1, 0, At, B0); PG8_MMA(1, 1, At, B1); PG8_BAR; PG8_SCHED;
        }
        if (wr == 0) PG8_BAR;
        E(acc, cur, wr, wc, fr, fq);
        S.done(cur, lane);
        if (!has_next) break;
#pragma unroll
        for (int a = 0; a < 2; ++a)
#pragma unroll
            for (int b = 0; b < 2; ++b)
#pragma unroll
                for (int m = 0; m < 4; ++m)
#pragma unroll
                    for (int n = 0; n < 2; ++n) acc[a][b][m][n] = (f32x4){0.f, 0.f, 0.f, 0.f};
        cur = nxt; cB = nB; ++ui;
        if (wr == 1) PG8_BAR;
    }
    PG8_WAIT_V(0);
    PG8_BAR;
#undef PG8_SA
#undef PG8_SB
#undef PG8_STAGE
#undef PG8_LDA
#undef PG8_LDB
#undef PG8_MMA
#undef PG8_WAIT_V
#undef PG8_WAIT_L
#undef PG8_BAR
#undef PG8_SCHED
}
}

template <class CM>
__device__ __forceinline__ void transpose_item(const float* W, int ldw, int K, bf16* WT, LAS float* scr, int k0, int n0, int lane, const CM& cmap) {
    const int kb = lane >> 3, ng = lane & 7;
    const float* src = W + cmap(n0 + 4 * ng) + (size_t)(k0 + 8 * kb) * ldw;
    f32x4 v[8];
#pragma unroll
    for (int i = 0; i < 8; ++i) v[i] = *(const f32x4*)(src + (size_t)i * ldw);
#pragma unroll
    for (int q = 0; q < 4; ++q) {
        uint4 o; o.x = pk2bf(v[0][q], v[1][q]); o.y = pk2bf(v[2][q], v[3][q]); o.z = pk2bf(v[4][q], v[5][q]); o.w = pk2bf(v[6][q], v[7][q]);
        *(uint4*)(WT + (size_t)(n0 + 4 * ng + q) * K + k0 + 8 * kb) = o;
    }
}
__device__ void ph_wprep(int wv, const Params& p, LAS float* lds, int bid, int nb) {
    const int tid = opaque_tid(), lane = tid & 63, wave = tid >> 6;
    LAS float* scr = lds + wave * 4096;
    bf16* WINT = (bf16*)(p.ws + WS_WINT); bf16* WOUTT = (bf16*)(p.ws + WS_WOUTT);
    constexpr int I_IN = (D_ / 64) * (PJ / 32), I_OUT = (D_ / 64) * (D_ / 32);
    for (int it = bid * 8 + wave; it < I_IN + I_OUT; it += nb * 8) {
        if (it < I_IN) { const int kb = it / (PJ / 32), nbk = it % (PJ / 32); transpose_item(p.in[6], INC, D_, WINT, scr, 64 * kb, 32 * nbk, lane, [](int n) { return n < 2048 ? n : n + 8; }); }
        else { const int r = it - I_IN, kb = r / (D_ / 32), nbk = r % (D_ / 32); transpose_item(p.in[16], D_, D_, WOUTT, scr, 64 * kb, 32 * nbk, lane, [](int n) { return n; }); }
    }
    float* W8T = (float*)(p.ws + WS_W8T); bf16* WRTH = (bf16*)(p.ws + WS_WRTH); bf16* WRTL = (bf16*)(p.ws + WS_WRTL);
    for (int i = bid * NTHR + tid; i < 8 * 1024 + 80 * 1024; i += nb * NTHR) {
        if (i < 8192) { const int j = i >> 10, c = i & 1023; W8T[i] = p.in[6][(size_t)c * INC + 2048 + j]; }
        else { const int q = i - 8192, n = q >> 10, c = q & 1023;
            const float w = n < 8 ? p.in[19][(size_t)c * 8 + n] : (n < 16 ? 0.f : p.in[21][(size_t)c * NE + (n - 16)]);
            const unsigned hi = f2bf(w); WRTH[q] = (bf16)hi; WRTL[q] = (bf16)f2bf(w - bf2f(hi)); }
    }
}
template <class CM>
__device__ __forceinline__ void transpose_item4(const float* W, int ldw, int K, bf16* WT, int k0, int n0, int lane, const CM& cmap) {
    const int kb = lane >> 3, ng = lane & 7;
    f32x4 v[4][8];
#pragma unroll
    for (int t = 0; t < 4; ++t) { const float* src = W + cmap(n0 + 32 * t + 4 * ng) + (size_t)(k0 + 8 * kb) * ldw;
#pragma unroll
        for (int i = 0; i < 8; ++i) v[t][i] = *(const f32x4*)(src + (size_t)i * ldw); }
#pragma unroll
    for (int t = 0; t < 4; ++t)
#pragma unroll
        for (int q = 0; q < 4; ++q) {
            uint4 o; o.x = pk2bf(v[t][0][q], v[t][1][q]); o.y = pk2bf(v[t][2][q], v[t][3][q]); o.z = pk2bf(v[t][4][q], v[t][5][q]); o.w = pk2bf(v[t][6][q], v[t][7][q]);
            *(uint4*)(WT + (size_t)(n0 + 32 * t + 4 * ng + q) * K + k0 + 8 * kb) = o;
        }
}
__device__ void ph_wprep_experts(int wv, const Params& p, int bid, int nb, int lo, int hi) {
    const int tid = opaque_tid(), lane = tid & 63, wave = tid >> 6;
    bf16* WGUT = (bf16*)(p.ws + WS_WGUT); bf16* WDNT = (bf16*)(p.ws + WS_WDNT);
    constexpr int I_GU = (D_ / 64) * (2 * DE / 128), I_DN = (DE / 64) * (D_ / 128);
    for (int it = lo + bid * 8 + wave; it < hi; it += nb * 8) {
        int r = it; const int e = r / (I_GU + I_DN); r -= e * (I_GU + I_DN);
        if (r < I_GU) { const int kb = r / (2 * DE / 128), nbk = r % (2 * DE / 128);
            const float* wg = p.in[23] + (size_t)e * D_ * DE; const long up_off = (long)(p.in[24] - p.in[23]);
            transpose_item4(wg, DE, D_, WGUT + (size_t)e * 2 * DE * D_, 64 * kb, 128 * nbk, lane, [up_off](int n) -> long { const int g = n >> 8, w = n & 255; return w < 128 ? (long)(128 * g + w) : up_off + (long)(128 * g + w - 128); }); }
        else { r -= I_GU; const int kb = r / (D_ / 128), nbk = r % (D_ / 128);
            transpose_item4(p.in[25] + (size_t)e * DE * D_, D_, DE, WDNT + (size_t)e * D_ * DE, 64 * kb, 128 * nbk, lane, [](int n) { return n; }); }
    }
}

__device__ void ph_mod(int wv, const Params& p, LAS float* lds, int bid, int nb) {
    const int tid = opaque_tid();
    const float* c = p.in[1]; const float* w_ada = p.in[2]; const float* b_ada = p.in[3];
    float* mod = (float*)(p.ws + WS_MOD);
    LAS float* cact = lds;
    LAS float* part = lds + 8192;
    for (int i = tid; i < 8192; i += NTHR) cact[i] = siluf_(c[i]);
    __syncthreads();
    for (int cg = bid; cg < 256; cg += nb) {
        const int n0 = cg * 24;
        const int kq = tid / 6, cq = tid % 6;
        float acc[8][4];
#pragma unroll
        for (int b = 0; b < 8; ++b) { acc[b][0] = acc[b][1] = acc[b][2] = acc[b][3] = 0.f; }
        if (kq < 85) {
            f32x4 wv4[13];
#pragma unroll
            for (int i = 0; i < 13; ++i) { const int k = kq + 85 * i; wv4[i] = *(const f32x4*)(w_ada + (size_t)(k < 1024 ? k : 0) * 6144 + n0 + 4 * cq); }
#pragma unroll
            for (int i = 0; i < 13; ++i) { const int k = kq + 85 * i; const bool ok = k < 1024; const int kk = ok ? k : 0;
#pragma unroll
                for (int b = 0; b < 8; ++b) { const float a = ok ? cact[b * 1024 + kk] : 0.f; acc[b][0] += a * wv4[i][0]; acc[b][1] += a * wv4[i][1]; acc[b][2] += a * wv4[i][2]; acc[b][3] += a * wv4[i][3]; } }
#pragma unroll
            for (int b = 0; b < 8; ++b)
#pragma unroll
                for (int j = 0; j < 4; ++j) part[(kq * 8 + b) * 24 + 4 * cq + j] = acc[b][j];
        }
        __syncthreads();
        if (tid < 192) {
            const int b = tid / 24, j = tid % 24; float s = 0.f, s1 = 0.f, s2 = 0.f, s3 = 0.f, s4 = 0.f;
#pragma unroll
            for (int q = 0; q < 85; q += 5) { s += part[(q * 8 + b) * 24 + j]; s1 += part[((q + 1) * 8 + b) * 24 + j]; s2 += part[((q + 2) * 8 + b) * 24 + j]; s3 += part[((q + 3) * 8 + b) * 24 + j]; s4 += part[((q + 4) * 8 + b) * 24 + j]; }
            s = ((s + s1) + (s2 + s3)) + s4;
            mod[b * 6144 + n0 + j] = s + b_ada[n0 + j];
        }
        __syncthreads();
    }
}

template <class Fin>
__device__ __forceinline__ void ph_h(int wv, const Params& p, LAS float* lds, int row0, Fin fin) {
    const int tid = opaque_tid(), lane = tid & 63, wave = tid >> 6;
    const float* x = p.in[0]; const float* npm = p.in[4];
    const float* mod = (const float*)(p.ws + WS_MOD); const float* W8T = (const float*)(p.ws + WS_W8T);
    bf16* H = (bf16*)(p.ws + WS_H); float* SM = (float*)(p.ws + WS_SMALL);
    const int tw0 = row0 + wave * 8, b = tw0 / NS_;
    f32x4 xv[4][4];
#pragma unroll
    for (int r = 0; r < 4; ++r)
#pragma unroll
        for (int j = 0; j < 4; ++j) xv[r][j] = *(const f32x4*)(x + (size_t)(tw0 + r) * D_ + 4 * lane + 256 * j);
    fin();
    for (int i = tid; i < 2048; i += NTHR) *(LAS f32x4*)(lds + 4 * i) = *(const f32x4*)(W8T + 4 * i);
    __syncthreads();
    {
        f32x4 nwv[4], shv[4];
#pragma unroll
        for (int j = 0; j < 4; ++j) { const int c0 = 4 * lane + 256 * j; nwv[j] = *(const f32x4*)(npm + c0) * (*(const f32x4*)(mod + b * 6144 + 1024 + c0) + 1.f); shv[j] = *(const f32x4*)(mod + b * 6144 + c0); }
#pragma unroll 1
        for (int r0 = 0; r0 < 8; r0 += 4) {
        if (r0 > 0) {
#pragma unroll
        for (int r = 0; r < 4; ++r)
#pragma unroll
            for (int j = 0; j < 4; ++j) xv[r][j] = *(const f32x4*)(x + (size_t)(tw0 + r0 + r) * D_ + 4 * lane + 256 * j);
        }
#pragma unroll
        for (int r = 0; r < 4; ++r) {
            const int t = tw0 + r0 + r;
            float ss = 0.f;
#pragma unroll
            for (int j = 0; j < 4; ++j) ss += xv[r][j][0] * xv[r][j][0] + xv[r][j][1] * xv[r][j][1] + xv[r][j][2] * xv[r][j][2] + xv[r][j][3] * xv[r][j][3];
            ss = wave_sum(ss);
            const float rstd = rsqrtf(ss * (1.f / D_) + EPS);
            float sm[8];
#pragma unroll
            for (int j = 0; j < 8; ++j) sm[j] = 0.f;
#pragma unroll
            for (int j = 0; j < 4; ++j) {
                const int c0 = 4 * lane + 256 * j;
                const f32x4 h = xv[r][j] * rstd * nwv[j] + shv[j];
                uint2 o; o.x = pk2bf(h[0], h[1]); o.y = pk2bf(h[2], h[3]);
                *(uint2*)(H + (size_t)t * D_ + c0) = o;
#pragma unroll
                for (int q = 0; q < 8; ++q) { const f32x4 w = *(const LAS f32x4*)(lds + q * 1024 + c0); sm[q] += h[0] * w[0] + h[1] * w[1] + h[2] * w[2] + h[3] * w[3]; }
            }
#pragma unroll
            for (int j = 0; j < 8; ++j) sm[j] = wave_sum(sm[j]);
            if (lane == 0) { *(float4*)(SM + (size_t)t * 8) = make_float4(sm[0], sm[1], sm[2], sm[3]); *(float4*)(SM + (size_t)t * 8 + 4) = make_float4(sm[4], sm[5], sm[6], sm[7]); }
        }
        }
    }
}

__device__ __forceinline__ void ph_proj(int wv, const Params& p, LAS unsigned char* lds, int bid, int nb) {
    pg8::DenseSched S; S.init(p.ws + WS_H, p.ws + WS_WINT, T_, PJ, D_, nb, bid);
    pg8::EpiBf16 E{(bf16*)(p.ws + WS_PROJ), PJ};
    pg8::gemm_phase(wv, lds, S, E);
}

typedef short bf16x8_t __attribute__((ext_vector_type(8)));
typedef unsigned u32x4_t __attribute__((ext_vector_type(4)));
typedef unsigned u32x2_t __attribute__((ext_vector_type(2)));
__device__ __forceinline__ int lds_off16(int row, int ch) { return row * 256 + ((ch ^ (row & 15)) << 4); }
__device__ __forceinline__ int lds_off8(int row, int ch) { return row * 128 + ((ch ^ ((row >> 1) & 7)) << 4); }
__device__ __forceinline__ bf16x8_t ldfrag(const LAS unsigned char* p) { return *(const LAS bf16x8_t*)p; }

__device__ __forceinline__ void dn_conv_row(const bf16* PROJ, const float* cw, int t0, int tl0, int h, int r, int seg, float (&qo)[16], float (&ko)[16], float (&vo)[16]) {
#pragma unroll
    for (int part = 0; part < 3; ++part) {
        float v[16];
        const int ch = part * 512 + h * 128 + seg * 16;
#pragma unroll
        for (int i = 0; i < 16; ++i) v[i] = 0.f;
#pragma unroll
        for (int j = 0; j < 4; ++j) {
            const bool ok = tl0 + r - 3 + j >= 0;
            const size_t srow = (size_t)(ok ? t0 + r - 3 + j : t0);
            const u32x4_t x0 = *(const u32x4_t*)(PROJ + srow * PJ + ch), x1 = *(const u32x4_t*)(PROJ + srow * PJ + ch + 8);
            const unsigned xs[8] = {x0.x, x0.y, x0.z, x0.w, x1.x, x1.y, x1.z, x1.w};
#pragma unroll
            for (int i = 0; i < 8; ++i) { float2 w = *(const float2*)(cw + j * 1536 + ch + 2 * i); if (!ok) { w.x = 0.f; w.y = 0.f; } v[2 * i] += w.x * bf2f(xs[i] & 0xffffu); v[2 * i + 1] += w.y * bf2f(xs[i] >> 16); }
        }
        asm volatile("" ::: "memory");
        float ss = 0.f;
#pragma unroll
        for (int i = 0; i < 16; ++i) { v[i] = siluf_(v[i]); ss += v[i] * v[i]; }
        if (part < 2) {
            ss += dpp_f<0xB1, 0xF>(ss); ss += dpp_f<0x4E, 0xF>(ss); ss += dpp_f<0x141, 0xF>(ss);
            const float rn = rsqrtf(ss + EPS);
#pragma unroll
            for (int i = 0; i < 16; ++i) v[i] *= rn;
        }
#pragma unroll
        for (int i = 0; i < 16; ++i) { if (part == 0) qo[i] = v[i]; else if (part == 1) ko[i] = v[i]; else vo[i] = v[i]; }
    }
}
__device__ __forceinline__ void dn_put_row(LAS unsigned char* lds, bf16* DQG, int item, int r, int seg, const LAS float* GC, const float (&q)[16], const float (&k)[16], const float (&v)[16]) {
    constexpr int O_KN = 0, O_QS = 16384, O_KD = 32768, O_RHS = 66560;
    LAS float* RHS = (LAS float*)(lds + O_RHS); LAS unsigned short* KD = (LAS unsigned short*)(lds + O_KD);
    const float beta = GC[64 + r], egc = GC[128 + r], edec = GC[192 + r];
    const float s = 0.08838834764831845f, sg = s * egc, bw = beta * egc;
    u32x4_t a0, a1, g0, g1;
    a0.x = pk2bf(q[0] * s, q[1] * s); a0.y = pk2bf(q[2] * s, q[3] * s); a0.z = pk2bf(q[4] * s, q[5] * s); a0.w = pk2bf(q[6] * s, q[7] * s);
    a1.x = pk2bf(q[8] * s, q[9] * s); a1.y = pk2bf(q[10] * s, q[11] * s); a1.z = pk2bf(q[12] * s, q[13] * s); a1.w = pk2bf(q[14] * s, q[15] * s);
    g0.x = pk2bf(q[0] * sg, q[1] * sg); g0.y = pk2bf(q[2] * sg, q[3] * sg); g0.z = pk2bf(q[4] * sg, q[5] * sg); g0.w = pk2bf(q[6] * sg, q[7] * sg);
    g1.x = pk2bf(q[8] * sg, q[9] * sg); g1.y = pk2bf(q[10] * sg, q[11] * sg); g1.z = pk2bf(q[12] * sg, q[13] * sg); g1.w = pk2bf(q[14] * sg, q[15] * sg);
    *(LAS u32x4_t*)(lds + O_QS + lds_off16(r, 2 * seg)) = a0; *(LAS u32x4_t*)(lds + O_QS + lds_off16(r, 2 * seg + 1)) = a1;
    bf16* dst = DQG + (size_t)item * 8192 + r * 128 + seg * 16; *(u32x4_t*)dst = g0; *(u32x4_t*)(dst + 8) = g1;
    a0.x = pk2bf(k[0], k[1]); a0.y = pk2bf(k[2], k[3]); a0.z = pk2bf(k[4], k[5]); a0.w = pk2bf(k[6], k[7]);
    a1.x = pk2bf(k[8], k[9]); a1.y = pk2bf(k[10], k[11]); a1.z = pk2bf(k[12], k[13]); a1.w = pk2bf(k[14], k[15]);
    *(LAS u32x4_t*)(lds + O_KN + lds_off16(r, 2 * seg)) = a0; *(LAS u32x4_t*)(lds + O_KN + lds_off16(r, 2 * seg + 1)) = a1;
    g0.x = pk2bf(k[0] * edec, k[1] * edec); g0.y = pk2bf(k[2] * edec, k[3] * edec); g0.z = pk2bf(k[4] * edec, k[5] * edec); g0.w = pk2bf(k[6] * edec, k[7] * edec);
    g1.x = pk2bf(k[8] * edec, k[9] * edec); g1.y = pk2bf(k[10] * edec, k[11] * edec); g1.z = pk2bf(k[12] * edec, k[13] * edec); g1.w = pk2bf(k[14] * edec, k[15] * edec);
    *(LAS u32x4_t*)(KD + r * 136 + seg * 16) = g0; *(LAS u32x4_t*)(KD + r * 136 + seg * 16 + 8) = g1;
#pragma unroll
    for (int i = 0; i < 4; ++i) {
        *(LAS f32x4*)(RHS + r * 256 + 128 + seg * 16 + 4 * i) = (f32x4){k[4 * i] * bw, k[4 * i + 1] * bw, k[4 * i + 2] * bw, k[4 * i + 3] * bw};
        *(LAS f32x4*)(RHS + r * 256 + seg * 16 + 4 * i) = (f32x4){v[4 * i] * beta, v[4 * i + 1] * beta, v[4 * i + 2] * beta, v[4 * i + 3] * beta};
    }
}
__device__ void ph_dnprep(int wv, const Params& p, LAS unsigned char* lds, int bid, int nb) {
    const int tid = opaque_tid(), lane = tid & 63, wave = wv, fr = lane & 15, fq = lane >> 4;
    const bf16* PROJ = (const bf16*)(p.ws + WS_PROJ); const float* cw = p.in[7]; const float* a_log = p.in[8]; const float* dt_bias = p.in[9];
    const float* SM = (const float*)(p.ws + WS_SMALL);
    bf16* DW = (bf16*)(p.ws + WS_DW); bf16* DQG = (bf16*)(p.ws + WS_DQG); bf16* DKDT = (bf16*)(p.ws + WS_DKDT); bf16* DATT = (bf16*)(p.ws + WS_DATT);
    bf16* DU = (bf16*)(p.ws + WS_DU); float* DEGL = (float*)(p.ws + WS_DEGL);
    constexpr int O_KN = 0, O_QS = 16384, O_KD = 32768, O_AM = 50176, O_RHS = 66560, O_GC = 132096;
    LAS float* AM = (LAS float*)(lds + O_AM); LAS float* RHS = (LAS float*)(lds + O_RHS); LAS float* GCALL = (LAS float*)(lds + O_GC);
    LAS unsigned short* KD = (LAS unsigned short*)(lds + O_KD);
    {
        const int item = bid + wave * nb;
        if (wave < 4 && item < 1024) {
            const int b = item >> 7, h = (item >> 5) & 3, n = item & 31, t = b * NS_ + n * 64 + lane;
            const float bl = SM[(size_t)t * 8 + h], al = SM[(size_t)t * 8 + 4 + h];
            const float beta = sigmoidf_(bl);
            const float xx = al + dt_bias[h];
            const float sp = xx > 20.f ? xx : log1pf(expf(xx));
            float gc = -expf(a_log[h]) * sp;
#pragma unroll
            for (int o = 1; o < 64; o <<= 1) { const float y = __shfl_up(gc, o); if (lane >= o) gc += y; }
            const float glast = __shfl(gc, 63);
            LAS float* G4 = GCALL + wave * 256;
            G4[lane] = gc; G4[64 + lane] = beta; G4[128 + lane] = expf(gc); G4[192 + lane] = expf(glast - gc);
            if (lane == 63) DEGL[item] = expf(gc);
        }
        __syncthreads();
    }
    const int tt = tid - 256, cseg = tt & 7, cr0 = tt >> 3;
    float qa[16], ka[16], va[16], qb[16], kb[16], vb[16];
#pragma unroll
    for (int i = 0; i < 16; ++i) { qa[i] = 0.f; ka[i] = 0.f; va[i] = 0.f; qb[i] = 0.f; kb[i] = 0.f; vb[i] = 0.f; }
    if (wave >= 4 && bid < 1024) {
        const int item = bid, b = item >> 7, h = (item >> 5) & 3, n = item & 31, t0 = b * NS_ + n * 64, tl0 = n * 64;
        dn_conv_row(PROJ, cw, t0, tl0, h, cr0, cseg, qa, ka, va);
        dn_conv_row(PROJ, cw, t0, tl0, h, cr0 + 32, cseg, qb, kb, vb);
        dn_put_row(lds, DQG, item, cr0, cseg, GCALL, qa, ka, va);
        dn_put_row(lds, DQG, item, cr0 + 32, cseg, GCALL, qb, kb, vb);
    }
    __syncthreads();
    int slot = 0;
#pragma unroll 1
    for (int item = bid; item < 1024; item += nb, ++slot) {
        const LAS float* GC = GCALL + slot * 256;
        {
            const int rb = wave & 3;
            bf16x8_t xf[4];
#pragma unroll
            for (int s4 = 0; s4 < 4; ++s4) xf[s4] = ldfrag(lds + O_KN + lds_off16(16 * rb + fr, 4 * s4 + fq));
#pragma unroll
            for (int cb = 0; cb < 4; ++cb) {
                f32x4 acc = {0.f, 0.f, 0.f, 0.f};
                const int yoff = (wave < 4) ? O_KN : O_QS;
#pragma unroll
                for (int s4 = 0; s4 < 4; ++s4) { const bf16x8_t yf = ldfrag(lds + yoff + lds_off16(16 * cb + fr, 4 * s4 + fq)); acc = __builtin_amdgcn_mfma_f32_16x16x32_bf16(xf[s4], yf, acc, 0, 0, 0); }
                const int xr0 = 16 * rb + 4 * fq, yr = 16 * cb + fr;
                const f32x4 gx = *(const LAS f32x4*)(GC + xr0); const float gy = GC[yr];
                if (wave < 4) {
                    const f32x4 bx = *(const LAS f32x4*)(GC + 64 + xr0);
                    f32x4 o;
#pragma unroll
                    for (int r = 0; r < 4; ++r) { const bool m = xr0 + r > yr; const float dec = __expf(m ? gx[r] - gy : 0.f); o[r] = m ? bx[r] * acc[r] * dec : 0.f; }
                    *(LAS f32x4*)(AM + ((xr0 >> 2) * 64 + yr) * 4) = o;
                } else {
                    float o[4];
#pragma unroll
                    for (int r = 0; r < 4; ++r) { const bool m = yr >= xr0 + r; const float dec = __expf(m ? gy - gx[r] : 0.f); o[r] = m ? acc[r] * dec : 0.f; }
                    u32x2_t w; w.x = pk2bf(o[0], o[1]); w.y = pk2bf(o[2], o[3]);
                    *(u32x2_t*)(DATT + (size_t)item * 4096 + yr * 64 + xr0) = w;
                }
            }
        }
        __syncthreads();
        const bool has_next = item + nb < 1024;
        if (wave < 4) {
            const int c = tid;
            float x[64];
#pragma unroll
            for (int blk = 0; blk < 16; ++blk) {
                float s0 = RHS[(4 * blk + 0) * 256 + c], s1 = RHS[(4 * blk + 1) * 256 + c], s2 = RHS[(4 * blk + 2) * 256 + c], s3 = RHS[(4 * blk + 3) * 256 + c];
#pragma unroll
                for (int j0 = 0; j0 < 4 * blk; j0 += 16) {
                    f32x4 a[16];
#pragma unroll
                    for (int q = 0; q < 16; ++q) if (j0 + q < 4 * blk) a[q] = *(const LAS f32x4*)(AM + (blk * 64 + j0 + q) * 4);
#pragma unroll
                    for (int q = 0; q < 16; ++q) if (j0 + q < 4 * blk) { const float xv = x[j0 + q]; s0 -= a[q][0] * xv; s1 -= a[q][1] * xv; s2 -= a[q][2] * xv; s3 -= a[q][3] * xv; }
                }
                const f32x4 t0 = *(const LAS f32x4*)(AM + (blk * 64 + 4 * blk) * 4), t1 = *(const LAS f32x4*)(AM + (blk * 64 + 4 * blk + 1) * 4), t2 = *(const LAS f32x4*)(AM + (blk * 64 + 4 * blk + 2) * 4);
                x[4 * blk] = s0;
                s1 -= t0[1] * s0; s2 -= t0[2] * s0; s3 -= t0[3] * s0;
                x[4 * blk + 1] = s1;
                s2 -= t1[2] * s1; s3 -= t1[3] * s1;
                x[4 * blk + 2] = s2;
                s3 -= t2[3] * s2;
                x[4 * blk + 3] = s3;
            }
            if (c < 128) {
#pragma unroll
                for (int i = 0; i < 64; ++i) DU[(size_t)item * 8192 + i * 128 + c] = (bf16)pk2bf(x[i], 0.f);
            } else {
#pragma unroll
                for (int i = 0; i < 64; ++i) DW[(size_t)item * 8192 + i * 128 + (c - 128)] = (bf16)pk2bf(x[i], 0.f);
            }
#pragma unroll
            for (int i = 0; i < 16; ++i) { qa[i] = 0.f; ka[i] = 0.f; va[i] = 0.f; qb[i] = 0.f; kb[i] = 0.f; vb[i] = 0.f; }
        } else {
            const int d = tt >> 1, c0 = (tt & 1) * 32;
            unsigned w[16];
#pragma unroll
            for (int i = 0; i < 16; ++i) w[i] = (unsigned)KD[(c0 + 2 * i) * 136 + d] | ((unsigned)KD[(c0 + 2 * i + 1) * 136 + d] << 16);
            bf16* dst = DKDT + (size_t)item * 8192 + d * 64 + c0;
#pragma unroll
            for (int i = 0; i < 4; ++i) *(u32x4_t*)(dst + 8 * i) = (u32x4_t){w[4 * i], w[4 * i + 1], w[4 * i + 2], w[4 * i + 3]};
            if (has_next) {
                const int itn = item + nb, b = itn >> 7, h = (itn >> 5) & 3, n = itn & 31, t0 = b * NS_ + n * 64, tl0 = n * 64;
                dn_conv_row(PROJ, cw, t0, tl0, h, cr0, cseg, qa, ka, va);
                dn_conv_row(PROJ, cw, t0, tl0, h, cr0 + 32, cseg, qb, kb, vb);
            }
        }
        __syncthreads();
        if (wave >= 4 && has_next) {
            dn_put_row(lds, DQG, item + nb, cr0, cseg, GCALL + (slot + 1) * 256, qa, ka, va);
            dn_put_row(lds, DQG, item + nb, cr0 + 32, cseg, GCALL + (slot + 1) * 256, qb, kb, vb);
        }
        __syncthreads();
    }
}

__device__ void ph_dnscan(int wv, const Params& p, LAS unsigned char* lds, int sbid, int nsb) {
    const int tid = opaque_tid(), lane = tid & 63, wave = wv, fr = lane & 15, fq = lane >> 4;
    const bf16* DW = (const bf16*)(p.ws + WS_DW); const bf16* DQG = (const bf16*)(p.ws + WS_DQG); const bf16* DKDT = (const bf16*)(p.ws + WS_DKDT); const bf16* DATT = (const bf16*)(p.ws + WS_DATT);
    const bf16* DU = (const bf16*)(p.ws + WS_DU); const float* DEGL = (const float*)(p.ws + WS_DEGL);
    bf16* ORAW = (bf16*)(p.ws + WS_ORAW);
    constexpr int BUF = 57344, O_W = 0, O_QG = 16384, O_KDT = 32768, O_ATT = 49152, O_SB = 114688, O_VNT = 131072;
    const int cb = wave >> 1, eb = wave & 1;
    for (int it = sbid; it < 128; it += nsb) {
        const int bh = (it & 7) * 4 + (it >> 5), es = (it >> 3) & 3, b = bh >> 2, h = bh & 3, e0 = es * 32, item0 = bh * 32;
        f32x4 st[2] = {{0.f, 0.f, 0.f, 0.f}, {0.f, 0.f, 0.f, 0.f}};
        *(LAS u32x4_t*)(lds + O_SB + tid * 16) = (u32x4_t){0u, 0u, 0u, 0u};
        u32x4_t rg[7]; float un[4]; float egl_n;
#define DN_LOAD(itm) do { const size_t _o = (size_t)(itm) * 8192; \
            rg[0] = *(const u32x4_t*)(DW + _o + (size_t)tid * 8); rg[1] = *(const u32x4_t*)(DW + _o + (size_t)(tid + 512) * 8); \
            rg[2] = *(const u32x4_t*)(DQG + _o + (size_t)tid * 8); rg[3] = *(const u32x4_t*)(DQG + _o + (size_t)(tid + 512) * 8); \
            rg[4] = *(const u32x4_t*)(DKDT + _o + (size_t)tid * 8); rg[5] = *(const u32x4_t*)(DKDT + _o + (size_t)(tid + 512) * 8); \
            rg[6] = *(const u32x4_t*)(DATT + (size_t)(itm) * 4096 + (size_t)tid * 8); \
            _Pragma("unroll") for (int _r = 0; _r < 4; ++_r) un[_r] = bf2f(DU[_o + (size_t)(16 * cb + 4 * fq + _r) * 128 + e0 + 16 * eb + fr]); \
            egl_n = DEGL[(itm)]; } while (0)
#define DN_STORE(bufo) do { LAS unsigned char* _b = lds + (bufo); \
            *(LAS u32x4_t*)(_b + O_W + lds_off16(tid >> 4, tid & 15)) = rg[0]; *(LAS u32x4_t*)(_b + O_W + lds_off16((tid + 512) >> 4, tid & 15)) = rg[1]; \
            *(LAS u32x4_t*)(_b + O_QG + lds_off16(tid >> 4, tid & 15)) = rg[2]; *(LAS u32x4_t*)(_b + O_QG + lds_off16((tid + 512) >> 4, tid & 15)) = rg[3]; \
            *(LAS u32x4_t*)(_b + O_KDT + lds_off8(tid >> 3, tid & 7)) = rg[4]; *(LAS u32x4_t*)(_b + O_KDT + lds_off8((tid + 512) >> 3, tid & 7)) = rg[5]; \
            *(LAS u32x4_t*)(_b + O_ATT + lds_off8(tid >> 3, tid & 7)) = rg[6]; } while (0)
        DN_LOAD(item0);
        DN_STORE(0);
        float u[4] = {un[0], un[1], un[2], un[3]}; float egl = egl_n;
        __syncthreads();
        for (int n = 0; n < 32; ++n) {
            const int bufo = (n & 1) * BUF, sbo = O_SB + (n & 1) * 8192, sbn = O_SB + ((n + 1) & 1) * 8192;
            if (n < 31) DN_LOAD(item0 + n + 1);
            f32x4 acc = {0.f, 0.f, 0.f, 0.f};
            bf16x8_t sf[4];
#pragma unroll
            for (int s4 = 0; s4 < 4; ++s4) sf[s4] = ldfrag(lds + sbo + lds_off16(16 * eb + fr, 4 * s4 + fq));
#pragma unroll
            for (int s4 = 0; s4 < 4; ++s4) acc = __builtin_amdgcn_mfma_f32_16x16x32_bf16(ldfrag(lds + bufo + O_W + lds_off16(16 * cb + fr, 4 * s4 + fq)), sf[s4], acc, 0, 0, 0);
            {
                const float v0 = u[0] - acc[0], v1 = u[1] - acc[1], v2 = u[2] - acc[2], v3 = u[3] - acc[3];
                u32x2_t w; w.x = pk2bf(v0, v1); w.y = pk2bf(v2, v3);
                *(LAS u32x2_t*)(lds + O_VNT + lds_off8(16 * eb + fr, 2 * cb + (fq >> 1)) + 8 * (fq & 1)) = w;
            }
            __syncthreads();
            f32x4 oacc = {0.f, 0.f, 0.f, 0.f};
#pragma unroll
            for (int s4 = 0; s4 < 4; ++s4) oacc = __builtin_amdgcn_mfma_f32_16x16x32_bf16(ldfrag(lds + bufo + O_QG + lds_off16(16 * cb + fr, 4 * s4 + fq)), sf[s4], oacc, 0, 0, 0);
            bf16x8_t vf[2][2];
#pragma unroll
            for (int e2 = 0; e2 < 2; ++e2)
#pragma unroll
                for (int s2 = 0; s2 < 2; ++s2) vf[e2][s2] = ldfrag(lds + O_VNT + lds_off8(16 * e2 + fr, 4 * s2 + fq));
#pragma unroll
            for (int s2 = 0; s2 < 2; ++s2) oacc = __builtin_amdgcn_mfma_f32_16x16x32_bf16(ldfrag(lds + bufo + O_ATT + lds_off8(16 * cb + fr, 4 * s2 + fq)), ldfrag(lds + O_VNT + lds_off8(16 * eb + fr, 4 * s2 + fq)), oacc, 0, 0, 0);
            {
                const size_t t0 = (size_t)b * NS_ + n * 64;
#pragma unroll
                for (int r = 0; r < 4; ++r) ORAW[(t0 + 16 * cb + 4 * fq + r) * 512 + h * 128 + e0 + 16 * eb + fr] = (bf16)pk2bf(oacc[r], 0.f);
            }
#pragma unroll
            for (int e2 = 0; e2 < 2; ++e2) {
                st[e2] = st[e2] * egl;
#pragma unroll
                for (int s2 = 0; s2 < 2; ++s2) st[e2] = __builtin_amdgcn_mfma_f32_16x16x32_bf16(ldfrag(lds + bufo + O_KDT + lds_off8(16 * wave + fr, 4 * s2 + fq)), vf[e2][s2], st[e2], 0, 0, 0);
                u32x2_t w; w.x = pk2bf(st[e2][0], st[e2][1]); w.y = pk2bf(st[e2][2], st[e2][3]);
                *(LAS u32x2_t*)(lds + sbn + lds_off16(16 * e2 + fr, 2 * wave + (fq >> 1)) + 8 * (fq & 1)) = w;
            }
            if (n < 31) { DN_STORE(((n + 1) & 1) * BUF); u[0] = un[0]; u[1] = un[1]; u[2] = un[2]; u[3] = un[3]; egl = egl_n; }
            __syncthreads();
        }
#undef DN_LOAD
#undef DN_STORE
        {
            unsigned* flag = (unsigned*)(p.ws + WS_CTL) + CW_DNF + 64 * bh;
            asm volatile("s_waitcnt vmcnt(0)" ::: "memory");
            __syncthreads();
            if (tid == 0) {
                __builtin_amdgcn_fence(__ATOMIC_RELEASE, "agent");
                asm volatile("s_waitcnt vmcnt(0)" ::: "memory");
                __hip_atomic_fetch_add(flag, 1u, __ATOMIC_RELAXED, __HIP_MEMORY_SCOPE_AGENT);
                unsigned sp = 0;
                while (__hip_atomic_load(flag, __ATOMIC_RELAXED, __HIP_MEMORY_SCOPE_AGENT) < 4u) { __builtin_amdgcn_s_sleep(1); if (++sp > (1u << 22)) break; }
                __builtin_amdgcn_fence(__ATOMIC_ACQUIRE, "agent");
                asm volatile("s_waitcnt vmcnt(0)" ::: "memory");
            }
            __syncthreads();
            const bf16* PROJ = (const bf16*)(p.ws + WS_PROJ); bf16* MIXED = (bf16*)(p.ws + WS_MIXED);
            const int g4 = lane >> 4, c8 = (lane & 15) * 8;
            const f32x4 nw0 = *(const f32x4*)(p.in[10] + c8), nw1 = *(const f32x4*)(p.in[10] + c8 + 4);
            const int tq0 = b * NS_ + es * 512 + (tid >> 6) * 64;
#pragma unroll 1
            for (int i0 = 0; i0 < 64; i0 += 32) {
                u32x4_t ow[8], zz[8];
#pragma unroll
                for (int q = 0; q < 8; ++q) { const size_t t = (size_t)(tq0 + i0 + 4 * q + g4);
                    ow[q] = *(const u32x4_t*)(ORAW + t * 512 + h * 128 + c8);
                    zz[q] = *(const u32x4_t*)(PROJ + t * PJ + 1536 + h * 128 + c8); }
                asm volatile("" : "+v"(ow[0]), "+v"(ow[1]), "+v"(ow[2]), "+v"(ow[3]), "+v"(ow[4]), "+v"(ow[5]), "+v"(ow[6]), "+v"(ow[7]));
                asm volatile("" : "+v"(zz[0]), "+v"(zz[1]), "+v"(zz[2]), "+v"(zz[3]), "+v"(zz[4]), "+v"(zz[5]), "+v"(zz[6]), "+v"(zz[7]));
#pragma unroll
                for (int q = 0; q < 8; ++q) {
                    const f32x4 a = {bf2f(ow[q].x & 0xffffu), bf2f(ow[q].x >> 16), bf2f(ow[q].y & 0xffffu), bf2f(ow[q].y >> 16)}, c = {bf2f(ow[q].z & 0xffffu), bf2f(ow[q].z >> 16), bf2f(ow[q].w & 0xffffu), bf2f(ow[q].w >> 16)};
                    float ss = (a[0] * a[0] + a[1] * a[1]) + (a[2] * a[2] + a[3] * a[3]) + (c[0] * c[0] + c[1] * c[1]) + (c[2] * c[2] + c[3] * c[3]);
                    ss += dpp_f<0xB1, 0xF>(ss); ss += dpp_f<0x4E, 0xF>(ss); ss += dpp_f<0x141, 0xF>(ss); ss += dpp_f<0x140, 0xF>(ss);
                    const float r = rsqrtf(ss * (1.f / 128.f) + EPS);
                    const unsigned zw[4] = {zz[q].x, zz[q].y, zz[q].z, zz[q].w};
                    float m[8];
#pragma unroll
                    for (int i = 0; i < 4; ++i) { m[i] = a[i] * r * nw0[i] * siluf_(bf2f(i & 1 ? zw[i >> 1] >> 16 : zw[i >> 1] & 0xffffu)); m[4 + i] = c[i] * r * nw1[i] * siluf_(bf2f(i & 1 ? zw[2 + (i >> 1)] >> 16 : zw[2 + (i >> 1)] & 0xffffu)); }
                    u32x4_t w; w.x = pk2bf(m[0], m[1]); w.y = pk2bf(m[2], m[3]); w.z = pk2bf(m[4], m[5]); w.w = pk2bf(m[6], m[7]);
                    *(u32x4_t*)(MIXED + (size_t)(tq0 + i0 + 4 * q + g4) * D_ + h * 128 + c8) = w;
                }
            }
        }
    }
}

__device__ void ph_cf(int wv, const Params& p, LAS float* lds, int bid, int nb) {
    const int tid = opaque_tid(), lane = tid & 63, wave = tid >> 6;
    const bf16* PROJ = (const bf16*)(p.ws + WS_PROJ);
    const float* pwb = p.in[11]; const float* dww = p.in[12]; const float* dwb = p.in[13]; const float* lnw = p.in[14]; const float* lnb = p.in[15];
    bf16* MIXED = (bf16*)(p.ws + WS_MIXED);
    constexpr int TT = 32;
    const int c = tid;
    float w[CFK];
#pragma unroll
    for (int j = 0; j < CFK; ++j) w[j] = dww[j * CFW + c];
    const float ba = pwb[c], bg = pwb[512 + c], cb = dwb[c];
    for (int it = bid; it < T_ / TT; it += nb) {
        const int t0 = it * TT, tl0 = t0 % NS_;
        float xg[TT + CFK - 1];
#pragma unroll
        for (int i0 = 0; i0 < TT + CFK - 1; i0 += 16) {
            unsigned ra[16], rg[16];
#pragma unroll
            for (int q = 0; q < 16; ++q) if (i0 + q < TT + CFK - 1) {
                const int tl = tl0 - (CFK - 1) + i0 + q;
                const size_t row = (size_t)(t0 - (CFK - 1) + i0 + q + (tl < 0 ? -tl : 0));
                ra[q] = PROJ[row * PJ + 2048 + c]; rg[q] = PROJ[row * PJ + 2560 + c];
            } else { ra[q] = 0; rg[q] = 0; }
            asm volatile("" : "+v"(ra[0]), "+v"(ra[1]), "+v"(ra[2]), "+v"(ra[3]), "+v"(ra[4]), "+v"(ra[5]), "+v"(ra[6]), "+v"(ra[7]), "+v"(ra[8]), "+v"(ra[9]), "+v"(ra[10]), "+v"(ra[11]), "+v"(ra[12]), "+v"(ra[13]), "+v"(ra[14]), "+v"(ra[15]));
            asm volatile("" : "+v"(rg[0]), "+v"(rg[1]), "+v"(rg[2]), "+v"(rg[3]), "+v"(rg[4]), "+v"(rg[5]), "+v"(rg[6]), "+v"(rg[7]), "+v"(rg[8]), "+v"(rg[9]), "+v"(rg[10]), "+v"(rg[11]), "+v"(rg[12]), "+v"(rg[13]), "+v"(rg[14]), "+v"(rg[15]));
#pragma unroll
            for (int q = 0; q < 16; ++q) if (i0 + q < TT + CFK - 1) {
                const int tl = tl0 - (CFK - 1) + i0 + q;
                const float a = bf2f(ra[q]) + ba, gt = bf2f(rg[q]) + bg;
                xg[i0 + q] = tl >= 0 ? a * sigmoidf_(gt) : 0.f;
            }
        }
        __syncthreads();
#pragma unroll
        for (int r = 0; r < TT; ++r) {
            float s = cb;
#pragma unroll
            for (int j = 0; j < CFK; ++j) s += w[j] * xg[r + j];
            lds[r * 512 + c] = s;
        }
        __syncthreads();
#pragma unroll
        for (int rr = 0; rr < 4; ++rr) {
            const int r = wave * 4 + rr;
            float v[8]; float s = 0.f;
#pragma unroll
            for (int j = 0; j < 8; ++j) { v[j] = lds[r * 512 + lane + 64 * j]; s += v[j]; }
            const float mu = wave_sum(s) * (1.f / 512.f);
            float q = 0.f;
#pragma unroll
            for (int j = 0; j < 8; ++j) { v[j] -= mu; q += v[j] * v[j]; }
            const float rstd = rsqrtf(wave_sum(q) * (1.f / 512.f) + EPS);
#pragma unroll
            for (int j = 0; j < 8; ++j) { const int cc = lane + 64 * j; const float y = v[j] * rstd * lnw[cc] + lnb[cc]; MIXED[(size_t)(t0 + r) * D_ + 512 + cc] = (bf16)pk2bf(siluf_(y), 0.f); }
        }
    }
}

template <class Fin>
__device__ __forceinline__ void ph_outproj(int wv, const Params& p, LAS unsigned char* lds, int bid, int nb, Fin fin) {
    pg8::DenseSchedFin<Fin> S{{}, fin}; S.init(p.ws + WS_MIXED, p.ws + WS_WOUTT, T_, D_, D_, nb, bid);
    pg8::EpiBf16 E{(bf16*)(p.ws + WS_HMIX), D_};
    pg8::gemm_phase(wv, lds, S, E);
}

struct Row2Par { f32x4 g1n[4], a2[4], b2[4]; };
__device__ __forceinline__ void row2_front(const Params& p, LAS unsigned char* lds, int t, int lr, int lane, const f32x4 (&hm)[4], const f32x4 (&xv)[4], const Row2Par& P) {
    bf16* H2 = (bf16*)(p.ws + WS_H);
    float ss = 0.f;
#pragma unroll
    for (int j = 0; j < 4; ++j) ss += hm[j][0] * hm[j][0] + hm[j][1] * hm[j][1] + hm[j][2] * hm[j][2] + hm[j][3] * hm[j][3];
    ss = wave_sum(ss);
    const float r1 = rsqrtf(ss * (1.f / D_) + EPS);
    f32x4 x1[4]; float s2 = 0.f;
#pragma unroll
    for (int j = 0; j < 4; ++j) {
        const int c0 = 4 * lane + 256 * j;
        x1[j] = xv[j] + P.g1n[j] * (hm[j] * r1);
        s2 += x1[j][0] * x1[j][0] + x1[j][1] * x1[j][1] + x1[j][2] * x1[j][2] + x1[j][3] * x1[j][3];
        { u32x2_t xb; xb.x = pk2bf(x1[j][0], x1[j][1]); xb.y = pk2bf(x1[j][2], x1[j][3]); *(u32x2_t*)((bf16*)(p.ws + WS_X1B) + (size_t)t * D_ + c0) = xb; }
    }
    s2 = wave_sum(s2);
    const float r2 = rsqrtf(s2 * (1.f / D_) + EPS);
#pragma unroll
    for (int j = 0; j < 4; ++j) {
        const int c0 = 4 * lane + 256 * j;
        const f32x4 h = x1[j] * r2 * P.a2[j] + P.b2[j];
        u32x2_t wh; wh.x = pk2bf(h[0], h[1]); wh.y = pk2bf(h[2], h[3]);
        float lo[4]; lo[0] = h[0] - bf2f(wh.x & 0xffffu); lo[1] = h[1] - __builtin_bit_cast(float, wh.x & 0xffff0000u); lo[2] = h[2] - bf2f(wh.y & 0xffffu); lo[3] = h[3] - __builtin_bit_cast(float, wh.y & 0xffff0000u);
        u32x2_t wl; wl.x = pk2bf(lo[0], lo[1]); wl.y = pk2bf(lo[2], lo[3]);
        *(u32x2_t*)(H2 + (size_t)t * D_ + c0) = wh;
        const int ch = c0 >> 3, off = lr * 2048 + ((ch ^ (lr & 15)) << 4) + (c0 & 7) * 2;
        *(LAS u32x2_t*)(lds + off) = wh; *(LAS u32x2_t*)(lds + 65536 + off) = wl;
    }
}
__device__ void ph_row2(int wv, const Params& p, LAS unsigned char* lds, int chunk0) {
    const int tid = opaque_tid(), lane = tid & 63, wave = __builtin_amdgcn_readfirstlane(tid >> 6), fr = lane & 15, fq = lane >> 4;
    const float* x = p.in[0]; const float* brg = p.in[20]; const float* bre = p.in[22];
    const bf16* HMIX = (const bf16*)(p.ws + WS_HMIX);
    const bf16* WRTH = (const bf16*)(p.ws + WS_WRTH); const bf16* WRTL = (const bf16*)(p.ws + WS_WRTL);
    int* ROUTE = (int*)(p.ws + WS_ROUTE); int* POS = (int*)(p.ws + WS_POS); int* TOKL = (int*)(p.ws + WS_TOKL); float* WL = (float*)(p.ws + WS_WL);
    unsigned* cnt = (unsigned*)(p.ws + WS_CTL) + CW_CNT;
    LAS float* PART = (LAS float*)lds;
    LAS float* LOG = (LAS float*)(lds + 131072);
    LAS int* rte = (LAS int*)(lds + 131072 + 10240); LAS int* rtr = rte + 128; LAS float* rtw = (LAS float*)(rtr + 128); LAS int* lcnt = (LAS int*)(rtw + 128); LAS int* lbase = lcnt + 64; LAS float* lbias = (LAS float*)(lbase + 64);
    if (tid < 64) lcnt[tid] = 0;
    if (tid < 72) lbias[tid] = tid < 8 ? brg[tid] : bre[tid - 8];
    __syncthreads();
    for (int chunk = chunk0; chunk < chunk0 + 1; ++chunk) {
#pragma unroll 1
        for (int pass = 0; pass < 2; ++pass) {
            Row2Par P;
            { int lo_ = lane; asm volatile("" : "+v"(lo_));
              const float* mod = (const float*)(p.ws + WS_MOD) + ((chunk * 64) / NS_) * 6144;
#pragma unroll
              for (int j = 0; j < 4; ++j) { const int c0 = 4 * lo_ + 256 * j;
                  P.g1n[j] = *(const f32x4*)(mod + 2048 + c0) * *(const f32x4*)(p.in[5] + c0);
                  P.a2[j] = *(const f32x4*)(p.in[17] + c0) * (*(const f32x4*)(mod + 4096 + c0) + 1.f);
                  P.b2[j] = *(const f32x4*)(mod + 3072 + c0); } }
            const int tb = chunk * 64 + pass * 32 + wave * 4;
            f32x4 hmA[4], xvA[4], hmB[4], xvB[4];
#define R2_LOAD(hm, xv, t) do { _Pragma("unroll") for (int j = 0; j < 4; ++j) { const u32x2_t _h = *(const u32x2_t*)(HMIX + (size_t)(t) * D_ + 4 * lane + 256 * j); hm[j] = (f32x4){bf2f(_h.x & 0xffffu), bf2f(_h.x >> 16), bf2f(_h.y & 0xffffu), bf2f(_h.y >> 16)}; xv[j] = *(const f32x4*)(x + (size_t)(t) * D_ + 4 * lane + 256 * j); } } while (0)
            R2_LOAD(hmA, xvA, tb); R2_LOAD(hmB, xvB, tb + 1);
            row2_front(p, lds, tb, wave * 4, lane, hmA, xvA, P);
            R2_LOAD(hmA, xvA, tb + 2);
            row2_front(p, lds, tb + 1, wave * 4 + 1, lane, hmB, xvB, P);
            R2_LOAD(hmB, xvB, tb + 3);
            row2_front(p, lds, tb + 2, wave * 4 + 2, lane, hmA, xvA, P);
            row2_front(p, lds, tb + 3, wave * 4 + 3, lane, hmB, xvB, P);
#undef R2_LOAD
            const int l3 = lane_id_v(), fr3 = l3 & 15, fq3 = l3 >> 4;
            bf16x8_t bh[2][5], bl[2][5];
#define R2_BLOAD(buf, s4) do { const int _ks = wave * 4 + (s4); _Pragma("unroll") for (int n5 = 0; n5 < 5; ++n5) { \
                bh[buf][n5] = *(const bf16x8_t*)(WRTH + (size_t)(16 * n5 + fr3) * 1024 + _ks * 32 + fq3 * 8); bl[buf][n5] = *(const bf16x8_t*)(WRTL + (size_t)(16 * n5 + fr3) * 1024 + _ks * 32 + fq3 * 8); } } while (0)
#define R2_BFORCE(buf) do { asm volatile("" : "+v"(bh[buf][0]), "+v"(bh[buf][1]), "+v"(bh[buf][2]), "+v"(bh[buf][3]), "+v"(bh[buf][4]), "+v"(bl[buf][0]), "+v"(bl[buf][1]), "+v"(bl[buf][2]), "+v"(bl[buf][3]), "+v"(bl[buf][4])); } while (0)
            R2_BLOAD(0, 0);
            __syncthreads();
            f32x4 acc[2][5];
#pragma unroll
            for (int mb = 0; mb < 2; ++mb)
#pragma unroll
                for (int n5 = 0; n5 < 5; ++n5) acc[mb][n5] = (f32x4){0.f, 0.f, 0.f, 0.f};
#pragma unroll
            for (int s4 = 0; s4 < 4; ++s4) {
                const int ks = wave * 4 + s4;
                if (s4 + 1 < 4) R2_BLOAD((s4 + 1) & 1, s4 + 1);
                bf16x8_t ah[2], al[2];
#pragma unroll
                for (int mb = 0; mb < 2; ++mb) { const int r = 16 * mb + fr3, off = r * 2048 + (((4 * ks + fq3) ^ (r & 15)) << 4); ah[mb] = ldfrag(lds + off); al[mb] = ldfrag(lds + 65536 + off); }
                R2_BFORCE(s4 & 1);
#pragma unroll
                for (int n5 = 0; n5 < 5; ++n5) {
#pragma unroll
                    for (int mb = 0; mb < 2; ++mb) {
                        acc[mb][n5] = __builtin_amdgcn_mfma_f32_16x16x32_bf16(ah[mb], bh[s4 & 1][n5], acc[mb][n5], 0, 0, 0);
                        acc[mb][n5] = __builtin_amdgcn_mfma_f32_16x16x32_bf16(al[mb], bh[s4 & 1][n5], acc[mb][n5], 0, 0, 0);
                        acc[mb][n5] = __builtin_amdgcn_mfma_f32_16x16x32_bf16(ah[mb], bl[s4 & 1][n5], acc[mb][n5], 0, 0, 0);
                    }
                }
            }
#undef R2_BLOAD
#undef R2_BFORCE
            __syncthreads();
            { const int l2 = lane_id_v(), fq2 = l2 >> 4, fr2 = l2 & 15;
#pragma unroll
            for (int mb = 0; mb < 2; ++mb)
#pragma unroll
                for (int n5 = 0; n5 < 5; ++n5)
#pragma unroll
                    for (int r = 0; r < 4; ++r) PART[(wave * 32 + 16 * mb + 4 * fq2 + r) * 80 + 16 * n5 + fr2] = acc[mb][n5][r]; }
            __syncthreads();
            const int tid3 = opaque_tid();
            for (int i = tid3; i < 2560; i += NTHR) { float a = 0.f;
#pragma unroll
                for (int w = 0; w < 8; ++w) a += PART[w * 2560 + i];
                LOG[i] = a; }
            __syncthreads();
            if (tid3 < 32) {
                const LAS float* lg = LOG + tid3 * 80;
                float gmax = -3.0e38f; int gi = 0; float gl[8];
#pragma unroll
                for (int o = 0; o < 8; ++o) { gl[o] = lg[o] + lbias[o]; if (gl[o] > gmax) { gmax = gl[o]; gi = o; } }
                float gden = 0.f;
#pragma unroll
                for (int o = 0; o < 8; ++o) gden += __expf(gl[o] - gmax);
                const float gp = 1.f / gden;
                float m1 = -3.0e38f, m2 = -3.0e38f; int i1 = 0, i2 = 0; float el[8];
#pragma unroll
                for (int o = 0; o < 8; ++o) el[o] = lg[16 + gi * 8 + o] + lbias[8 + gi * 8 + o];
#pragma unroll
                for (int o = 0; o < 8; ++o) { if (el[o] > m1) { m1 = el[o]; i1 = o; } }
#pragma unroll
                for (int o = 0; o < 8; ++o) { if (o != i1 && el[o] > m2) { m2 = el[o]; i2 = o; } }
                const float e2 = __expf(m2 - m1);
                const int lr = pass * 32 + tid3, ea = gi * 8 + i1, eb = gi * 8 + i2;
                rte[2 * lr] = ea; rte[2 * lr + 1] = eb;
                rtw[2 * lr] = gp * (1.f / (1.f + e2)); rtw[2 * lr + 1] = gp * (e2 / (1.f + e2));
                rtr[2 * lr] = __hip_atomic_fetch_add(lcnt + ea, 1, __ATOMIC_RELAXED, __HIP_MEMORY_SCOPE_WORKGROUP); rtr[2 * lr + 1] = __hip_atomic_fetch_add(lcnt + eb, 1, __ATOMIC_RELAXED, __HIP_MEMORY_SCOPE_WORKGROUP);
            }
            __syncthreads();
        }
        const int tq = opaque_tid();
        if (tq < 64) { const int c = lcnt[tq]; lbase[tq] = c > 0 ? (int)atomicAdd(cnt + tq, (unsigned)c) : 0; }
        __syncthreads();
        if (tq < 128) {
            const int e = rte[tq], pos = lbase[e] + rtr[tq], t = chunk * 64 + (tq >> 1);
            ROUTE[(size_t)t * 4 + (tq & 1)] = e; POS[(size_t)t * 2 + (tq & 1)] = pos;
            TOKL[(size_t)e * T_ + pos] = t; WL[(size_t)e * T_ + pos] = rtw[tq];
        }
        __syncthreads();
        if (tq < 64) lcnt[tq] = 0;
        __syncthreads();
    }
}

struct MoeMap { LAS int* tstart; LAS int* cnt; int total_tiles; };
__device__ __forceinline__ MoeMap moe_map(int wv, const Params& p, LAS int* l) {
    const unsigned* cnt = (const unsigned*)(p.ws + WS_CTL) + CW_CNT;
    __syncthreads();
    if (wv == 0) {
        const int e = lane_id_v();
        const int c = (int)__hip_atomic_load(cnt + e, __ATOMIC_RELAXED, __HIP_MEMORY_SCOPE_AGENT);
        const int nt = (c + TM - 1) / TM; int incl = nt;
#pragma unroll
        for (int o = 1; o < 64; o <<= 1) { const int y = __shfl_up(incl, o); if (e >= o) incl += y; }
        l[e] = incl - nt; l[128 + e] = c; if (e == 63) l[NE] = incl;
    }
    __syncthreads();
    MoeMap m; m.tstart = l; m.cnt = l + 128; m.total_tiles = l[NE];
    return m;
}
__device__ __forceinline__ int moe_find(const MoeMap& m, int tile) { int e = 0; while (e < NE - 1 && m.tstart[e + 1] <= tile) ++e; return e; }

__device__ __forceinline__ void ph_moe_gu(int wv, const Params& p, LAS unsigned char* lds, int bid, int nb) {
    MoeMap mm = moe_map(wv, p, (LAS int*)(lds + pg8::STAGE_BYTES));
    pg8::GroupSched<1> S{(const char*)(p.ws + WS_H), (const char*)(p.ws + WS_WGUT), D_, 4, (size_t)2 * DE * D_ * 2, mm.tstart, mm.cnt, mm.total_tiles, nb, bid, (const int*)(p.ws + WS_TOKL), (unsigned*)(p.ws + WS_CTL) + CW_RDY};
    pg8::EpiGU E{(bf16*)(p.ws + WS_HID)};
    pg8::gemm_phase(wv, lds, S, E);
}
__device__ __forceinline__ void ph_moe_down(int wv, const Params& p, LAS unsigned char* lds, int bid, int nb) {
    LAS int* l = (LAS int*)(lds + pg8::STAGE_BYTES);
    MoeMap mm; mm.tstart = l; mm.cnt = l + 128; mm.total_tiles = l[NE];
    pg8::GroupSched<2> S{(const char*)(p.ws + WS_HID), (const char*)(p.ws + WS_WDNT), DE, 4, (size_t)D_ * DE * 2, mm.tstart, mm.cnt, mm.total_tiles, nb, bid, nullptr, (unsigned*)(p.ws + WS_CTL) + CW_RDY};
    pg8::EpiDown E{(bf16*)(p.ws + WS_Y), (const float*)(p.ws + WS_WL), mm.cnt};
    pg8::gemm_phase(wv, lds, S, E);
}

template <class Fin>
__device__ __forceinline__ void ph_final(int wv, const Params& p, LAS float* lds, int bid, int nb, Fin fin) {
    const int tid = opaque_tid(), lane = tid & 63, wave = tid >> 6;
    const float* npf = p.in[18]; const float* mod = (const float*)(p.ws + WS_MOD);
    const bf16* Y = (const bf16*)(p.ws + WS_Y); const int* ROUTE = (const int*)(p.ws + WS_ROUTE); const int* POS = (const int*)(p.ws + WS_POS);
    LAS int* lm = (LAS int*)((LAS unsigned char*)lds + pg8::STAGE_BYTES);
    MoeMap mm; mm.tstart = lm; mm.cnt = lm + 128; mm.total_tiles = lm[NE];
    for (int chunk = bid; chunk < T_ / 64; chunk += nb) {
        const int tw0 = chunk * 64 + wave * 8, b = tw0 / NS_;
        f32x4 gn[4];
#pragma unroll
        for (int j = 0; j < 4; ++j) { const int c0 = 4 * lane + 256 * j; gn[j] = *(const f32x4*)(mod + b * 6144 + 5120 + c0) * *(const f32x4*)(npf + c0); }
        int e4[4][2], p4[4][2]; u32x2_t xr[4][4];
#define PF_LOAD(r0_) do { _Pragma("unroll") for (int r = 0; r < 4; ++r) { const int t = tw0 + (r0_) + r; e4[r][0] = ROUTE[(size_t)t * 4]; e4[r][1] = ROUTE[(size_t)t * 4 + 1]; p4[r][0] = POS[(size_t)t * 2]; p4[r][1] = POS[(size_t)t * 2 + 1]; \
            _Pragma("unroll") for (int j = 0; j < 4; ++j) xr[r][j] = *(const u32x2_t*)((const bf16*)(p.ws + WS_X1B) + (size_t)t * D_ + 4 * lane + 256 * j); } } while (0)
        PF_LOAD(0);
        fin();
#pragma unroll 1
        for (int r0 = 0; r0 < 8; r0 += 4) {
            if (r0 > 0) PF_LOAD(r0);
            size_t ga[4], gb[4];
#pragma unroll
            for (int r = 0; r < 4; ++r) { ga[r] = (size_t)mm.tstart[e4[r][0]] * TM + p4[r][0]; gb[r] = (size_t)mm.tstart[e4[r][1]] * TM + p4[r][1]; }
            u32x2_t ya[4][4], yb[4][4]; f32x4 ov[4][4];
#pragma unroll
            for (int r = 0; r < 4; ++r)
#pragma unroll
                for (int j = 0; j < 4; ++j) { ya[r][j] = *(const u32x2_t*)(Y + ga[r] * D_ + 4 * lane + 256 * j); yb[r][j] = *(const u32x2_t*)(Y + gb[r] * D_ + 4 * lane + 256 * j);
                    { const u32x2_t xb = xr[r][j]; ov[r][j] = (f32x4){bf2f(xb.x & 0xffffu), bf2f(xb.x >> 16), bf2f(xb.y & 0xffffu), bf2f(xb.y >> 16)}; } }
#pragma unroll
            for (int r = 0; r < 4; ++r) {
                f32x4 m[4]; float ss = 0.f;
#pragma unroll
                for (int j = 0; j < 4; ++j) {
                    m[j][0] = bf2f(ya[r][j].x & 0xffffu) + bf2f(yb[r][j].x & 0xffffu); m[j][1] = bf2f(ya[r][j].x >> 16) + bf2f(yb[r][j].x >> 16);
                    m[j][2] = bf2f(ya[r][j].y & 0xffffu) + bf2f(yb[r][j].y & 0xffffu); m[j][3] = bf2f(ya[r][j].y >> 16) + bf2f(yb[r][j].y >> 16);
                    ss += m[j][0] * m[j][0] + m[j][1] * m[j][1] + m[j][2] * m[j][2] + m[j][3] * m[j][3];
                }
                ss = wave_sum(ss);
                const float rr = rsqrtf(ss * (1.f / D_) + EPS);
#pragma unroll
                for (int j = 0; j < 4; ++j) *(f32x4*)(p.out + (size_t)(tw0 + r0 + r) * D_ + 4 * lane + 256 * j) = ov[r][j] + gn[j] * (m[j] * rr);
            }
        }
    }
}
#undef PF_LOAD

constexpr int LDS_BYTES = 147456;
#ifndef SCAN_CONV_PCT
#define SCAN_CONV_PCT 5
#endif
#define XB_TMO      128
#define XB_XCNT(j)  (256  + 64 * (j))
#define XB_XSUB(j)  (1280 + 64 * (j))
#define XB_XGEN(j)  (2304 + 64 * (j))
#define XB_TOP      3328
#define XB_TOPGEN   3392
#define XCD_BAR_WORDS 3456
#define XB_SPIN_CAP (1u << 22)
__device__ __forceinline__ unsigned xb_ld(unsigned* p)              { return __hip_atomic_load(p, __ATOMIC_RELAXED, __HIP_MEMORY_SCOPE_AGENT); }
__device__ __forceinline__ unsigned xb_add(unsigned* p, unsigned v) { return __hip_atomic_fetch_add(p, v, __ATOMIC_RELAXED, __HIP_MEMORY_SCOPE_AGENT); }
__device__ __forceinline__ unsigned xb_xcc_id() { return (unsigned)__builtin_amdgcn_s_getreg((3 << 11) | 20) & 0xFu; }
#define XB_SPIN(cond, bar) do { unsigned _sp = 0; while (cond) { __builtin_amdgcn_s_sleep(0); \
    if ((++_sp & 255u) == 0u) { if (xb_ld(&(bar)[XB_TMO])) break; if (_sp > XB_SPIN_CAP) { atomicAdd(&(bar)[XB_TMO], 1u); break; } } } } while (0)
struct XcdBarrier { unsigned* bar; unsigned x; volatile LAS unsigned* st; };
__device__ __forceinline__ XcdBarrier xcd_barrier_post(int wv, unsigned* bar, volatile LAS unsigned* st) {
    XcdBarrier b; b.bar = bar; b.x = xb_xcc_id(); b.st = st;
    if (wv == 0 && lane_id_v() == 0) (void)xb_add(&bar[XB_XCNT(b.x)], 1u);
    return b;
}
__device__ __forceinline__ void xcd_barrier_complete(unsigned* bar, unsigned x, unsigned& nloc, unsigned& nx) {
    const unsigned G = gridDim.x * gridDim.y * gridDim.z;
    unsigned sum, cnt, mine, sp = 0u;
    for (;;) {
        sum = 0u; cnt = 0u; mine = 0u;
#pragma unroll
        for (unsigned j = 0; j < 16; ++j) { const unsigned c = xb_ld(&bar[XB_XCNT(j)]); sum += c; cnt += (c > 0u) ? 1u : 0u; mine = (j == x) ? c : mine; }
        if (sum == G) break;
        __builtin_amdgcn_s_sleep(1);
        if ((++sp & 255u) == 0u) { if (xb_ld(&bar[XB_TMO])) break; if (sp > XB_SPIN_CAP) { atomicAdd(&bar[XB_TMO], 1u); break; } }
    }
    nloc = mine > 0u ? mine : 1u; nx = cnt > 0u ? cnt : 1u;
}
template <bool NOWAIT = false>
__device__ __forceinline__ void xcd_barrier(int wv, unsigned char* ws, volatile LAS unsigned* st) {
    XcdBarrier b; b.bar = (unsigned*)(ws + WS_CTL) + 4096; b.x = xb_xcc_id(); b.st = st;
    asm volatile("s_waitcnt vmcnt(0)" ::: "memory");
    __syncthreads();
    if (wv == 0 && lane_id_v() == 0) {
        unsigned* bar = b.bar;
        __builtin_amdgcn_s_waitcnt(0);
        unsigned nloc = b.st[0], nx = b.st[1];
        if (nloc == 0u) { xcd_barrier_complete(bar, b.x, nloc, nx); b.st[0] = nloc; b.st[1] = nx; }
        { const unsigned pend = b.st[2]; if (pend) { XB_SPIN(xb_ld(&bar[XB_XGEN(b.x)]) < pend, bar); b.st[2] = 0u; } }
        const unsigned old = xb_add(&bar[XB_XSUB(b.x)], 1u);
        const unsigned gen = old / nloc;
        if (old + 1u == (gen + 1u) * nloc) {
            __builtin_amdgcn_fence(__ATOMIC_RELEASE, "agent");
            asm volatile("s_waitcnt vmcnt(0)" ::: "memory");
            (void)xb_add(&bar[XB_TOP], 1u);
            XB_SPIN(xb_ld(&bar[XB_TOP]) < (gen + 1u) * nx, bar);
            xb_add(&bar[XB_XGEN(b.x)], 1u);
            __builtin_amdgcn_fence(__ATOMIC_ACQUIRE, "agent");
            asm volatile("s_waitcnt vmcnt(0)" ::: "memory");
        } else if constexpr (NOWAIT) {
            b.st[2] = gen + 1u;
        } else {
            XB_SPIN(xb_ld(&bar[XB_XGEN(b.x)]) == gen, bar);
            __builtin_amdgcn_fence(__ATOMIC_ACQUIRE, "agent");
            asm volatile("s_waitcnt vmcnt(0)" ::: "memory");
        }
    }
    __syncthreads();
}
__device__ __forceinline__ void xcd_barrier_finish(int wv, unsigned char* ws, volatile LAS unsigned* st) {
    if (wv == 0 && lane_id_v() == 0) {
        unsigned* bar = (unsigned*)(ws + WS_CTL) + 4096; const unsigned x = xb_xcc_id();
        const unsigned pend = st[2];
        if (pend) { XB_SPIN(xb_ld(&bar[XB_XGEN(x)]) < pend, bar); st[2] = 0u;
            __builtin_amdgcn_fence(__ATOMIC_ACQUIRE, "agent");
            asm volatile("s_waitcnt vmcnt(0)" ::: "memory"); }
    }
    __syncthreads();
}
constexpr int CW_BAR = 4096;
constexpr int LDS_ST_OFF = LDS_BYTES - 64;

__global__ void __launch_bounds__(NTHR, 2) mk_all(Params p) {
    extern __shared__ __attribute__((aligned(16))) unsigned char lds_raw[];
    LAS float* lds = (LAS float*)lds_raw;
    const int bid = blockIdx.x, nb = gridDim.x;
    volatile LAS unsigned* st = (volatile LAS unsigned*)((LAS unsigned char*)lds_raw + LDS_ST_OFF);
    const int wv = __builtin_amdgcn_readfirstlane(threadIdx.x >> 6);
    if (threadIdx.x < 16) st[threadIdx.x] = 0u;
    __syncthreads();
    (void)xcd_barrier_post(wv, (unsigned*)(p.ws + WS_CTL) + CW_BAR, st);
#ifndef STAMP_SEL
#define STAMP_SEL -1
#endif
    unsigned long long t_prev = 0, dt_sel = 0;
    if (STAMP_SEL >= 0) t_prev = __builtin_amdgcn_s_memrealtime();
#define STAMP(k) do { if (STAMP_SEL >= 0) { const unsigned long long now_ = __builtin_amdgcn_s_memrealtime(); if ((k) == STAMP_SEL && bid == 0) dt_sel = now_ - t_prev; t_prev = now_; } } while (0)
    ph_wprep(wv, p, lds, bid, nb); __syncthreads();
    ph_mod(wv, p, lds, bid, nb);            xcd_barrier<true>(wv, p.ws, st); STAMP(0);
    int pan, qua; { pg8::DenseSched S0; S0.init(nullptr, nullptr, T_, D_, D_, nb, bid); pg8::Unit u0; S0.next(0, u0); pan = u0.pm; qua = u0.pn; }
    ph_h(wv, p, lds, pan * 256 + qua * 64, [&]() { xcd_barrier_finish(wv, p.ws, st); });
    group_sync(wv, (unsigned*)(p.ws + WS_CTL) + CW_HF + 64 * pan, 4u); STAMP(1);
    ph_proj(wv, p, (LAS unsigned char*)lds_raw, bid, nb);           xcd_barrier(wv, p.ws, st); STAMP(2);
    ph_dnprep(wv, p, (LAS unsigned char*)lds_raw, bid, nb);
    xcd_barrier(wv, p.ws, st); STAMP(3);
    {
        constexpr int CONV_ITEMS = NE * ((D_ / 64) * (2 * DE / 128) + (DE / 64) * (D_ / 128)), CONV_SPLIT = (CONV_ITEMS * SCAN_CONV_PCT / 100) & ~7;
        if (bid < nb / 2) { ph_dnscan(wv, p, (LAS unsigned char*)lds_raw, bid, nb / 2); __syncthreads(); ph_cf(wv, p, lds, bid, nb / 2); ph_wprep_experts(wv, p, bid, nb / 2, 0, CONV_SPLIT); }
        else ph_wprep_experts(wv, p, bid - nb / 2, nb - nb / 2, CONV_SPLIT, CONV_ITEMS);
    }
    if (STAMP_SEL == 40 && bid == 0) { const unsigned long long now_ = __builtin_amdgcn_s_memrealtime(); dt_sel = now_ - t_prev; }
    xcd_barrier<true>(wv, p.ws, st); STAMP(4);
    ph_outproj(wv, p, (LAS unsigned char*)lds_raw, bid, nb, [&]() { xcd_barrier_finish(wv, p.ws, st); });
    group_sync(wv, (unsigned*)(p.ws + WS_CTL) + CW_OF + 64 * pan, 4u); STAMP(6);
    ph_row2(wv, p, (LAS unsigned char*)lds_raw, pan * 4 + qua);           xcd_barrier(wv, p.ws, st); STAMP(7);
    ph_moe_gu(wv, p, (LAS unsigned char*)lds_raw, bid, nb);      STAMP(8);
    ph_moe_down(wv, p, (LAS unsigned char*)lds_raw, bid, nb);    xcd_barrier<true>(wv, p.ws, st); STAMP(9);
    ph_final(wv, p, lds, bid, nb, [&]() { xcd_barrier_finish(wv, p.ws, st); });
    if (STAMP_SEL >= 0) {
        __syncthreads(); STAMP(10);
        { const unsigned long long t0 = __builtin_amdgcn_s_memrealtime(); while (__builtin_amdgcn_s_memrealtime() - t0 < 8ull * dt_sel) __builtin_amdgcn_s_sleep(8); }
    }
}

extern "C" void kernel_launch(void* const* d_in, const int* in_sizes, int n_in, void* d_out, int out_size, void* d_ws, size_t ws_size, hipStream_t stream) {
    static int inited = 0;
    if (!inited) {
        if (n_in != 26 || out_size != T_ * D_ || ws_size < WS_END) { fprintf(stderr, "kernel_launch: unexpected shapes n_in %d out %d ws %zu\n", n_in, out_size, ws_size); inited = -1; return; }
        if (hipFuncSetAttribute((const void*)mk_all, hipFuncAttributeMaxDynamicSharedMemorySize, LDS_BYTES) != hipSuccess) { fprintf(stderr, "hipFuncSetAttribute failed\n"); inited = -1; return; }
        inited = 1;
    }
    if (inited < 0) return;
    (void)hipMemsetAsync((char*)d_ws + WS_CTL, 0, CTL_BYTES, stream);
    Params p{};
    for (int i = 0; i < 26; ++i) p.in[i] = (const float*)d_in[i];
    p.out = (float*)d_out; p.ws = (unsigned char*)d_ws;
    hipLaunchKernelGGL(mk_all, dim3(256), dim3(NTHR), LDS_BYTES, stream, p);
}
```
